# Optimizing an MI355X kernel written in HIP

```python
import jax, jax.numpy as jnp
from jax import lax
import numpy as np

D_MODEL = 1024
BATCH = 32
SEQ = 2048
DEPTH = 2

MIX_WIDTH = D_MODEL
CONV_CH = MIX_WIDTH // 2
CONV_GROUPS = 8
CONV_WIDTH = 31
RWKV_HEAD = 64
RWKV_CH = MIX_WIDTH - CONV_CH
RWKV_HEADS = RWKV_CH // RWKV_HEAD
LORA_W = 32
LORA_A = 32
LORA_V = 32
LORA_G = 96
RWKV_IN = 3 * RWKV_CH + LORA_W + LORA_A + LORA_G
IN_COLS = 2 * CONV_CH + RWKV_IN
N_GROUPS = 4
EXPERTS_PER_GROUP = 8
N_EXPERTS = N_GROUPS * EXPERTS_PER_GROUP
TOP_K = 2
EXPERT_FF = 512
MOE_BLOCK = 512
PLE_DIM = 256
NORM_EPS = 1e-6
LN_EPS = 1e-5
GN_EPS = 64e-5

kernel_name = "hymba_conformer_rwkv7_hmoe"


def rms_norm(x, g):
    x32 = x.astype(jnp.float32)
    y = x32 * lax.rsqrt(jnp.mean(x32 * x32, axis=-1, keepdims=True) + NORM_EPS)
    return (y * g.astype(jnp.float32)).astype(x.dtype)


def token_shift(z):
    return jnp.pad(z, ((0, 0), (1, 0), (0, 0)))[:, :-1, :]


def conformer_conv(z, conv_w, conv_b, ln_g, ln_b):
    val, gate = jnp.split(z, 2, axis=-1)
    u = val * jax.nn.sigmoid(gate)
    u = lax.conv_general_dilated(
        u, conv_w[:, None, :].astype(u.dtype), window_strides=(1,),
        padding=[(CONV_WIDTH - 1, 0)],
        dimension_numbers=('NWC', 'WIO', 'NWC'),
        feature_group_count=CONV_CH) + conv_b
    u32 = u.astype(jnp.float32)
    mean = jnp.mean(u32, axis=-1, keepdims=True)
    var = jnp.mean(jnp.square(u32 - mean), axis=-1, keepdims=True)
    un = (u32 - mean) * lax.rsqrt(var + LN_EPS) * ln_g.astype(jnp.float32) + ln_b.astype(jnp.float32)
    return jax.nn.silu(un).astype(z.dtype)


def rwkv7_scan(r, w, k, v, a_vec, b_vec):
    Bb, Ss, H, N = r.shape

    def step(state, inp):
        r_t, w_t, k_t, v_t, a_t, b_t = inp
        sa = jnp.einsum('bhvk,bhk->bhv', state, a_t)
        state = (state * w_t[:, :, None, :]
                 + sa[..., None] * b_t[:, :, None, :]
                 + v_t[..., None] * k_t[:, :, None, :])
        y_t = jnp.einsum('bhvk,bhk->bhv', state, r_t)
        return state, y_t

    xs = tuple(jnp.moveaxis(t, 1, 0) for t in (r, w, k, v, a_vec, b_vec))
    s0 = jnp.zeros((Bb, H, N, N), jnp.float32)
    _, ys = lax.scan(step, s0, xs)
    return jnp.moveaxis(ys, 0, 1)


def rwkv7_time_mix(z, v_first, mu, w0, w2, a0, a2, g2, k_k, k_a, r_k, gn_g, gn_b, vres):
    Bb, Ss, _ = z.shape
    f32 = jnp.float32
    zs = z + (token_shift(z) - z) * mu
    r, k, v, w_lo, a_lo, g_lo = jnp.split(
        zs, [RWKV_CH, 2 * RWKV_CH, 3 * RWKV_CH, 3 * RWKV_CH + LORA_W,
             3 * RWKV_CH + LORA_W + LORA_A], axis=-1)
    w = -jax.nn.softplus(-(w0 + jnp.tanh(w_lo) @ w2)) - 0.5
    decay = jnp.exp(-jnp.exp(w.astype(f32)))
    if vres is None:
        v_first = v
    else:
        v0, v1, v2 = vres
        v = v + (v_first - v) * jax.nn.sigmoid(v0 + (v @ v1) @ v2)
    a = jax.nn.sigmoid(a0 + a_lo @ a2)
    g = jax.nn.sigmoid(g_lo) @ g2
    hs = (Bb, Ss, RWKV_HEADS, RWKV_HEAD)
    kk = (k * k_k).astype(f32).reshape(hs)
    kk = kk / jnp.maximum(jnp.sqrt(jnp.sum(kk * kk, axis=-1, keepdims=True)), 1e-12)
    k = k * (1.0 + (a - 1.0) * k_a)
    r_h = r.astype(f32).reshape(hs)
    k_h = k.astype(f32).reshape(hs)
    v_h = v.astype(f32).reshape(hs)
    a_h = a.astype(f32).reshape(hs)
    y = rwkv7_scan(r_h, decay.reshape(hs), k_h, v_h, -kk, kk * a_h)
    mean = jnp.mean(y, axis=-1, keepdims=True)
    var = jnp.mean(jnp.square(y - mean), axis=-1, keepdims=True)
    y = (y - mean) * lax.rsqrt(var + GN_EPS)
    y = y * gn_g.astype(f32).reshape(RWKV_HEADS, RWKV_HEAD) + gn_b.astype(f32).reshape(RWKV_HEADS, RWKV_HEAD)
    y = y + jnp.sum(r_h * k_h * r_k.astype(f32), axis=-1, keepdims=True) * v_h
    y = y.reshape(Bb, Ss, RWKV_CH).astype(z.dtype) * g
    return y, v_first


def hierarchical_moe(u, wg, bg, we, be, w_gate, w_up, w_down):
    Bb, Ss, D = u.shape
    t = u.reshape(-1, D)
    T = t.shape[0]
    glog = (t @ wg).astype(jnp.float32) + bg.astype(jnp.float32)
    gprob = jax.nn.softmax(glog, axis=-1)
    g_idx = jnp.argmax(glog, axis=-1)
    g_p = jnp.take_along_axis(gprob, g_idx[:, None], axis=1)[:, 0]
    elog_all = jnp.einsum('td,gde->tge', t, we).astype(jnp.float32) + be.astype(jnp.float32)
    elog = jnp.take_along_axis(elog_all, g_idx[:, None, None], axis=1)[:, 0]
    top_v, top_i = lax.top_k(elog, TOP_K)
    gate_w = jax.nn.softmax(top_v, axis=-1) * g_p[:, None]
    e_idx = g_idx[:, None].astype(jnp.int32) * EXPERTS_PER_GROUP + top_i.astype(jnp.int32)

    A = T * TOP_K
    n_blocks = -(-A // MOE_BLOCK) + N_EXPERTS
    P = n_blocks * MOE_BLOCK
    flat_e = e_idx.reshape(-1)
    order = jnp.argsort(flat_e)
    se = flat_e[order]
    tok = (order // TOP_K).astype(jnp.int32)
    gate = gate_w.reshape(-1)[order]
    counts = jnp.zeros((N_EXPERTS,), jnp.int32).at[flat_e].add(1)
    starts = jnp.cumsum(counts) - counts
    pcounts = (counts + MOE_BLOCK - 1) // MOE_BLOCK * MOE_BLOCK
    pend = jnp.cumsum(pcounts)
    pstarts = pend - pcounts
    dest = pstarts[se] + (jnp.arange(A, dtype=jnp.int32) - starts[se])
    buf_tok = jnp.full((P,), T, jnp.int32).at[dest].set(tok)
    buf_gate = jnp.zeros((P,), jnp.float32).at[dest].set(gate)
    blk_e = jnp.minimum(
        jnp.searchsorted(pend, jnp.arange(n_blocks, dtype=jnp.int32) * MOE_BLOCK, side='right'),
        N_EXPERTS - 1)
    t_pad = jnp.concatenate([t, jnp.zeros((1, D), t.dtype)], axis=0)
    xbuf = t_pad[buf_tok].reshape(n_blocks, MOE_BLOCK, D)

    def run_block(args):
        xb, e = args
        hid = jax.nn.silu(xb @ w_gate[e]) * (xb @ w_up[e])
        return hid @ w_down[e]

    ybuf = lax.map(run_block, (xbuf, blk_e)).reshape(P, D)
    ybuf = ybuf * buf_gate[:, None].astype(ybuf.dtype)
    out = jnp.zeros((T + 1, D), t.dtype).at[buf_tok].add(ybuf)[:T]
    return out.reshape(Bb, Ss, D)


def setup_inputs(seed: int = 0) -> dict:
    key = jax.random.key(seed)
    ks = iter(jax.random.split(key, 48))

    def nrm(shape, scale):
        return jax.random.normal(next(ks), shape, jnp.float32) * scale

    def gain(shape):
        return 1.0 + nrm(shape, 0.02)

    L = DEPTH
    Lv = DEPTH - 1
    return {
        "x": nrm((BATCH, SEQ, D_MODEL), 1.0),
        "p": nrm((DEPTH, BATCH, SEQ, PLE_DIM), 1.0),
        "mix_norm": gain((L, D_MODEL)),
        "w_in": nrm((L, D_MODEL, IN_COLS), D_MODEL ** -0.5),
        "conv_w": nrm((L, CONV_WIDTH, CONV_CH), CONV_WIDTH ** -0.5),
        "conv_b": nrm((L, CONV_CH), 0.01),
        "conv_ln_g": gain((L, CONV_CH)),
        "conv_ln_b": nrm((L, CONV_CH), 0.01),
        "rwkv_mu": jax.random.uniform(next(ks), (L, RWKV_IN), jnp.float32),
        "rwkv_w0": -1.5 + nrm((L, RWKV_CH), 0.5),
        "rwkv_w2": nrm((L, LORA_W, RWKV_CH), 0.1),
        "rwkv_a0": nrm((L, RWKV_CH), 0.1),
        "rwkv_a2": nrm((L, LORA_A, RWKV_CH), 0.1),
        "rwkv_g2": nrm((L, LORA_G, RWKV_CH), LORA_G ** -0.5),
        "rwkv_kk": 0.85 + nrm((L, RWKV_CH), 0.02),
        "rwkv_ka": 1.0 + nrm((L, RWKV_CH), 0.02),
        "rwkv_rk": nrm((L, RWKV_HEADS, RWKV_HEAD), 0.1),
        "rwkv_gn_g": gain((L, RWKV_CH)),
        "rwkv_gn_b": nrm((L, RWKV_CH), 0.01),
        "rwkv_v0": nrm((Lv, RWKV_CH), 0.1),
        "rwkv_v1": nrm((Lv, RWKV_CH, LORA_V), RWKV_CH ** -0.5),
        "rwkv_v2": nrm((Lv, LORA_V, RWKV_CH), 0.1),
        "w_out": nrm((L, MIX_WIDTH, D_MODEL), MIX_WIDTH ** -0.5),
        "ffn_norm": gain((L, D_MODEL)),
        "router_group_w": nrm((L, D_MODEL, N_GROUPS), D_MODEL ** -0.5),
        "router_group_b": nrm((L, N_GROUPS), 0.01),
        "router_expert_w": nrm((L, N_GROUPS, D_MODEL, EXPERTS_PER_GROUP), D_MODEL ** -0.5),
        "router_expert_b": nrm((L, N_GROUPS, EXPERTS_PER_GROUP), 0.01),
        "expert_w_gate": nrm((L, N_EXPERTS, D_MODEL, EXPERT_FF), D_MODEL ** -0.5),
        "expert_w_up": nrm((L, N_EXPERTS, D_MODEL, EXPERT_FF), D_MODEL ** -0.5),
        "expert_w_down": nrm((L, N_EXPERTS, EXPERT_FF, D_MODEL), EXPERT_FF ** -0.5),
        "ple_norm": gain((L, D_MODEL)),
        "ple_gate_w": nrm((L, D_MODEL, D_MODEL), D_MODEL ** -0.5),
        "ple_proj_w": nrm((L, PLE_DIM, D_MODEL), PLE_DIM ** -0.5),
        "final_norm": gain((D_MODEL,)),
    }


def reference(x, p, mix_norm, w_in, conv_w, conv_b, conv_ln_g, conv_ln_b,
              rwkv_mu, rwkv_w0, rwkv_w2, rwkv_a0, rwkv_a2, rwkv_g2, rwkv_kk, rwkv_ka,
              rwkv_rk, rwkv_gn_g, rwkv_gn_b, rwkv_v0, rwkv_v1, rwkv_v2, w_out,
              ffn_norm, router_group_w, router_group_b, router_expert_w, router_expert_b,
              expert_w_gate, expert_w_up, expert_w_down, ple_norm, ple_gate_w, ple_proj_w,
              final_norm):
    h = x
    v_first = None
    for i in range(DEPTH):
        u = rms_norm(h, mix_norm[i])
        z = u @ w_in[i]
        z_conv = z[..., :2 * CONV_CH]
        z_rwkv = z[..., 2 * CONV_CH:]
        y_conv = conformer_conv(z_conv, conv_w[i], conv_b[i], conv_ln_g[i], conv_ln_b[i])
        vres = None if i == 0 else (rwkv_v0[i - 1], rwkv_v1[i - 1], rwkv_v2[i - 1])
        y_rwkv, v_first = rwkv7_time_mix(
            z_rwkv, v_first, rwkv_mu[i], rwkv_w0[i], rwkv_w2[i], rwkv_a0[i], rwkv_a2[i],
            rwkv_g2[i], rwkv_kk[i], rwkv_ka[i], rwkv_rk[i], rwkv_gn_g[i], rwkv_gn_b[i], vres)
        h = h + jnp.concatenate([y_conv, y_rwkv], axis=-1) @ w_out[i]
        h = h + hierarchical_moe(rms_norm(h, ffn_norm[i]), router_group_w[i], router_group_b[i],
                                 router_expert_w[i], router_expert_b[i], expert_w_gate[i],
                                 expert_w_up[i], expert_w_down[i])
        gate = jax.nn.sigmoid(rms_norm(h, ple_norm[i]) @ ple_gate_w[i])
        h = h + gate * (p[i] @ ple_proj_w[i])
    return rms_norm(h, final_norm)
```

```cpp
#include <hip/hip_runtime.h>
#include <hip/hip_cooperative_groups.h>
#include <cstdio>
#include <cstdint>
namespace cg = cooperative_groups;

#define LAS __attribute__((address_space(3)))
typedef unsigned short bf16_t;
typedef short bf16x8 __attribute__((ext_vector_type(8)));
typedef float f32x4 __attribute__((ext_vector_type(4)));
typedef float f32x2 __attribute__((ext_vector_type(2)));
typedef unsigned u32x4 __attribute__((ext_vector_type(4)));
typedef unsigned u32x2 __attribute__((ext_vector_type(2)));

#ifndef PREP_REP
#define PREP_REP 1
#endif
#ifndef P2_MASK
#define P2_MASK 15
#endif
#ifndef RT_STOP
#define RT_STOP 1
#endif
#ifndef RT_TR
#define RT_TR 63
#endif
#ifndef TR_MASK
#define TR_MASK 63
#endif
#ifndef PREP_MASK
#define PREP_MASK 7
#endif
#define BLK_LO 0
#define BLK_HI 0
#define DBG_FIN 1
#ifndef PH_STOP
#define PH_STOP 99
#endif
#ifndef PH_MASK
#define PH_MASK 0xFFFF
#endif
#define PH_ON(k) ((PH_MASK >> (k)) & 1)
#ifndef MK_N_LAUNCHES
#define MK_N_LAUNCHES 1
#endif

constexpr int BATCH = 32, SEQ = 2048, M = BATCH * SEQ, D = 1024, DEPTH = 2;
constexpr int CONVC = 512, CONVW = 31, RC = 512, NH = 8, HS = 64;
constexpr int LW = 32, LA = 32, LV = 32, LG = 96;
constexpr int RWKV_IN = 3 * RC + LW + LA + LG;
constexpr int IN_COLS = 2 * CONVC + RWKV_IN;
constexpr int ZC = 2816;
constexpr int ZC_R = 1024, ZC_K = 1536, ZC_V = 2048, ZC_WLO = 2560, ZC_ALO = 2592, ZC_GLO = 2624, ZC_EA = 2720, ZC_EB = 2752;
constexpr int NG = 4, EPG = 8, NE = 32, FF = 512, PLE = 256, NRT = 36;
constexpr int LCAP = 65536;
constexpr int MAXSLOT = 2 * M + NE * 256;
constexpr int NPART = 16;

constexpr size_t MiB = 1u << 20;
constexpr size_t WS_CTL = 0;
constexpr size_t CTL_BYTES = 1 * MiB;
constexpr size_t WS_WR = 1 * MiB;
constexpr size_t WS_PART = 2 * MiB;
constexpr size_t WS_RSF = 6 * MiB;
constexpr size_t WS_RSP = 6 * MiB + 512 * 1024;
constexpr size_t WS_TSLOT = 7 * MiB;
constexpr size_t WS_GLIST = 8 * MiB;
constexpr size_t WS_TLIST = 16 * MiB;
constexpr size_t WS_W = 24 * MiB;
constexpr size_t W_LAYER = 107 * MiB;
constexpr size_t WO_IN = 0;
constexpr size_t WO_OUT = 6 * MiB;
constexpr size_t WO_GU = 8 * MiB;
constexpr size_t WO_D = 72 * MiB;
constexpr size_t WO_PG = 104 * MiB;
constexpr size_t WO_PP = 106 * MiB;
constexpr size_t WS_HB = 238 * MiB;
constexpr size_t WS_VF = 366 * MiB;
constexpr size_t WS_PB = 430 * MiB;
constexpr size_t WS_R = 494 * MiB;
constexpr size_t WS_Z = WS_R;
constexpr size_t WS_Y = WS_R + 352 * MiB;
constexpr size_t WS_HID = WS_R;
constexpr size_t WS_YS = WS_R + 144 * MiB;
constexpr size_t WS_PP = WS_R;
constexpr size_t WS_END = 974 * MiB;
static_assert(WS_W + 2 * W_LAYER <= WS_HB && WS_YS + (size_t)MAXSLOT * D * 2 <= WS_END && WS_HID + (size_t)MAXSLOT * FF * 2 <= WS_YS, "ws map");

constexpr int LDS_BYTES = 150 * 1024;
constexpr int LDS_MISC = 131072;

__device__ __forceinline__ float bf2f(bf16_t b) { return __uint_as_float(((unsigned)b) << 16); }
__device__ __forceinline__ unsigned f2bf(float f) { unsigned u = __float_as_uint(f); return (u + 0x7fffu + ((u >> 16) & 1u)) >> 16; }
__device__ __forceinline__ unsigned pk2(float lo, float hi) { return f2bf(lo) | (f2bf(hi) << 16); }
__device__ __forceinline__ unsigned cvt_pk_bf16(float lo, float hi) { unsigned r; asm volatile("v_cvt_pk_bf16_f32 %0, %1, %2" : "=v"(r) : "v"(lo), "v"(hi)); return r; }
__device__ __forceinline__ float sigmoidf_(float x) { return __builtin_amdgcn_rcpf(1.0f + __expf(-x)); }
__device__ __forceinline__ float tanhf_(float x) { return 1.0f - 2.0f * __builtin_amdgcn_rcpf(1.0f + __expf(2.0f * x)); }
__device__ __forceinline__ float wave_sum(float v) {
#pragma unroll
    for (int o = 1; o < 64; o <<= 1) v += __shfl_xor(v, o);
    return v;
}
__device__ __forceinline__ float red16(float v) {
#pragma unroll
    for (int o = 1; o < 16; o <<= 1) v += __shfl_xor(v, o);
    return v;
}
__device__ __forceinline__ float red8(float v) {
#pragma unroll
    for (int o = 1; o < 8; o <<= 1) v += __shfl_xor(v, o);
    return v;
}

namespace pg8 {
constexpr int BM = 256, BK = 64, HALF = 128, HTB = HALF * BK * 2, STAGE_BYTES = 8 * HTB, NXCD = 8, WGM = 8;
__host__ __device__ __forceinline__ int lds_byte(int r, int c) { const int st = (r >> 4) * 2 + (c >> 5), rr = r & 15, cc = c & 31, ob = rr * 64 + cc * 2; return st * 1024 + (ob ^ (((ob >> 9) & 1) << 5)); }
__host__ __device__ __forceinline__ void stage_rc(int b, int& R, int& C) { const int st = b / 1024, sb = b % 1024, swz = sb ^ (((sb >> 9) & 1) << 5); R = (st >> 1) * 16 + swz / 64; C = (st & 1) * 32 + (swz % 64) / 2; }
__host__ __device__ __forceinline__ int perm32(int rho) { const int n = rho >> 4, i = rho & 15; return 8 * (i >> 2) + 4 * n + (i & 3); }

struct Unit { int arow, brow, orow, ocol, e, mt; };

struct StaticOrder {
    static constexpr bool GATHER = false;
    int nM, nN, nwg, G, c;
    __device__ void init(int M_, int N_, int G_, int c_) { nM = M_ / BM; nN = N_ / BM; nwg = nM * nN; G = G_; c = c_; }
    __device__ bool next(int i, Unit& u) const {
        const long L = (long)i * G + c; if (L >= nwg) return false;
        int wgid = (int)L; { const int q = nwg / NXCD, r = nwg % NXCD, xcd = wgid % NXCD, off = wgid / NXCD; wgid = (xcd < r ? xcd * (q + 1) : r * (q + 1) + (xcd - r) * q) + off; }
        const int nig = WGM * nN, gid = wgid / nig, fm = gid * WGM, gsz = (nM - fm) < WGM ? (nM - fm) : WGM;
        const int pm = fm + ((wgid % nig) % gsz), pn = (wgid % nig) / gsz;
        u.arow = pm * BM; u.brow = pn * BM; u.orow = pm * BM; u.ocol = pn * BM; u.e = 0; u.mt = pm; return true;
    }
    __device__ __forceinline__ unsigned tok(const Unit&, int) const { return 0u; }
};

template <bool GATHER_> struct GroupedOrder {
    static constexpr bool GATHER = GATHER_;
    const LAS int* tprefix;
    const LAS int* pstart;
    const int* cnt;
    const int* tlist;
    int brows;
    int G, c;
    __device__ bool next(int i, Unit& u) const {
        const int q = c & 7, j = c >> 3;
        const int U = q * 32 + j;
        const int mtg = i * 64 + (U >> 2), nt = U & 3;
        const int total = tprefix[32];
        if (mtg >= total) return false;
        int e = 0;
#pragma unroll 1
        for (int s = 16; s >= 1; s >>= 1) { if (tprefix[e + s] <= mtg) e += s; }
        const int mt = mtg - tprefix[e];
        u.e = e; u.mt = mt; u.arow = pstart[e] + mt * BM; u.orow = u.arow; u.brow = e * brows + nt * BM; u.ocol = nt * BM; return true;
    }
    __device__ __forceinline__ unsigned tok(const Unit& u, int r) const {
        const int pos = u.mt * BM + r;
        return pos < cnt[u.e] ? (unsigned)tlist[u.e * LCAP + pos] : 0u;
    }
};

template <class Epi, class Sched>
__device__ __forceinline__ void gemm_phase(LAS unsigned char* lds, const bf16_t* Ag, const bf16_t* Btg, const int K, const Sched& S, const Epi& E) {
    int tid_ = threadIdx.x; asm volatile("" : "+v"(tid_));
    const int tid = tid_, wid = __builtin_amdgcn_readfirstlane(tid >> 6), lane = tid & 63, wr = wid >> 2, wc = wid & 3, fr = lane & 15, fq = lane >> 4;
    const int nt = K / BK;
    unsigned voffA[2], voffB[2]; int Rr[2], Cc[2];
#pragma unroll
    for (int i = 0; i < 2; ++i) { int R, C; stage_rc(tid * 16 + i * 8192, R, C); Rr[i] = R; Cc[i] = C; const int Rb = Epi::PERM ? ((R & ~31) + perm32(R & 31)) : R;
        voffA[i] = (unsigned)(R * K + C) * 2u; voffB[i] = (unsigned)(Rb * K + C) * 2u; }
    const size_t kstep = (size_t)(BK * 2);
    const size_t hstep = (size_t)HALF * K * 2;
    const size_t rowb = (size_t)K * 2;
    const unsigned ldsw = (unsigned)wid * 1024u;
    const int aoff = lds_byte(wr * 64 + fr, fq * 8), boff = lds_byte(wc * 32 + fr, fq * 8);
    unsigned gc[2][2], gn[2][2];
#pragma unroll
    for (int h = 0; h < 2; ++h)
#pragma unroll
        for (int i = 0; i < 2; ++i) { gc[h][i] = 0u; gn[h][i] = 0u; }
#define PG8_SA(b, h) (((b) * 2 + (h)) * HTB)
#define PG8_SB(b, h) ((4 + (b) * 2 + (h)) * HTB)
#define PG8_GLDS(src, bufoff, i) __builtin_amdgcn_global_load_lds((const unsigned*)(src), (LAS unsigned*)(lds + (bufoff) + ldsw + (i) * 8192), 16, 0, 0)
#define PG8_STAGE_B(bufoff, gbase) do { _Pragma("unroll") for (int _i = 0; _i < 2; ++_i) PG8_GLDS((const char*)(gbase) + voffB[_i], bufoff, _i); } while (0)
#define PG8_STAGE_A(bufoff, gbase, h, usenext) do { _Pragma("unroll") for (int _i = 0; _i < 2; ++_i) { \
        if constexpr (Sched::GATHER) { const unsigned _o = (usenext) ? gn[h][_i] : gc[h][_i]; PG8_GLDS((const char*)(gbase) + _o, bufoff, _i); } \
        else { PG8_GLDS((const char*)(gbase) + (h) * hstep + voffA[_i], bufoff, _i); } } } while (0)
#define PG8_LDA(dst, b, h) do { _Pragma("unroll") for (int m = 0; m < 4; ++m) _Pragma("unroll") for (int k = 0; k < 2; ++k) dst[m][k] = *(const LAS bf16x8*)(lds + PG8_SA(b, h) + aoff + m * 2048 + k * 1024); } while (0)
#define PG8_LDB(dst, b, h) do { _Pragma("unroll") for (int n = 0; n < 2; ++n) _Pragma("unroll") for (int k = 0; k < 2; ++k) dst[n][k] = *(const LAS bf16x8*)(lds + PG8_SB(b, h) + boff + n * 2048 + k * 1024); } while (0)
#define PG8_MMA(ai, bj, At, Bt) do { __builtin_amdgcn_s_setprio(1); _Pragma("unroll") for (int m = 0; m < 4; ++m) _Pragma("unroll") for (int n = 0; n < 2; ++n) _Pragma("unroll") for (int k = 0; k < 2; ++k) \
        acc[ai][bj][m][n] = __builtin_amdgcn_mfma_f32_16x16x32_bf16(Bt[n][k], At[m][k], acc[ai][bj][m][n], 0, 0, 0); __builtin_amdgcn_s_setprio(0); } while (0)
#define PG8_WAIT_V(n) asm volatile("s_waitcnt vmcnt(" #n ")" ::: "memory")
#define PG8_WAIT_L(n) asm volatile("s_waitcnt lgkmcnt(" #n ")" ::: "memory")
#define PG8_BAR __builtin_amdgcn_s_barrier()
#define PG8_SCHED __builtin_amdgcn_sched_barrier(0)
    Unit cur, nxt; int ui = 0;
    if (!S.next(0, cur)) return;
    f32x4 acc[2][2][4][2];
#pragma unroll
    for (int a = 0; a < 2; ++a)
#pragma unroll
        for (int b = 0; b < 2; ++b)
#pragma unroll
            for (int m = 0; m < 4; ++m)
#pragma unroll
                for (int n = 0; n < 2; ++n) acc[a][b][m][n] = (f32x4){0.f, 0.f, 0.f, 0.f};
    bf16x8 At[4][2], B0[2][2], B1[2][2];
    const char* cA; const char* cB = (const char*)Btg + (size_t)cur.brow * rowb;
    if constexpr (Sched::GATHER) {
        cA = (const char*)Ag;
#pragma unroll
        for (int h = 0; h < 2; ++h)
#pragma unroll
            for (int i = 0; i < 2; ++i) gc[h][i] = S.tok(cur, h * HALF + Rr[i]) * (unsigned)rowb + (unsigned)Cc[i] * 2u;
    } else cA = (const char*)Ag + (size_t)cur.arow * rowb;
    PG8_STAGE_B(PG8_SB(0, 0), cB); PG8_STAGE_A(PG8_SA(0, 0), cA, 0, false); PG8_STAGE_B(PG8_SB(0, 1), cB + hstep); PG8_STAGE_A(PG8_SA(0, 1), cA, 1, false);
    if (wr == 1) PG8_BAR;
    PG8_WAIT_V(4); PG8_BAR;
    PG8_STAGE_B(PG8_SB(1, 0), cB + kstep); PG8_STAGE_A(PG8_SA(1, 0), cA + kstep, 0, false); PG8_STAGE_B(PG8_SB(1, 1), cB + hstep + kstep);
    PG8_WAIT_V(6); PG8_BAR;
    for (;;) {
        const bool has_next = S.next(ui + 1, nxt);
        const char* nA; const char* nB = has_next ? (const char*)Btg + (size_t)nxt.brow * rowb : cB;
        if constexpr (Sched::GATHER) {
            nA = cA;
#pragma unroll
            for (int h = 0; h < 2; ++h)
#pragma unroll
                for (int i = 0; i < 2; ++i) gn[h][i] = has_next ? (S.tok(nxt, h * HALF + Rr[i]) * (unsigned)rowb + (unsigned)Cc[i] * 2u) : gc[h][i];
        } else nA = has_next ? (const char*)Ag + (size_t)nxt.arow * rowb : cA;
        for (int t = 0; t < nt; t += 2) {
            const bool last = (t == nt - 2);
            const char* a1 = cA + (size_t)(t + 1) * kstep;
            const char* a2 = last ? nA : cA + (size_t)(t + 2) * kstep; const char* b2 = last ? nB : cB + (size_t)(t + 2) * kstep;
            const char* a3 = a2 + kstep; const char* b3 = b2 + kstep;
            PG8_LDB(B0, 0, 0); PG8_SCHED; PG8_LDA(At, 0, 0); PG8_STAGE_A(PG8_SA(1, 1), a1, 1, false);
            PG8_WAIT_L(8); PG8_BAR; PG8_WAIT_L(0); PG8_MMA(0, 0, At, B0); PG8_BAR; PG8_SCHED;
            PG8_LDB(B1, 0, 1); PG8_STAGE_B(PG8_SB(0, 0), b2);
            PG8_BAR; PG8_WAIT_L(0); PG8_MMA(0, 1, At, B1); PG8_BAR;
            PG8_LDA(At, 0, 1); PG8_STAGE_A(PG8_SA(0, 0), a2, 0, last);
            PG8_BAR; PG8_WAIT_L(0); PG8_MMA(1, 0, At, B0); PG8_BAR; PG8_SCHED;
            PG8_STAGE_B(PG8_SB(0, 1), b2 + hstep);
            PG8_WAIT_V(6); PG8_BAR; PG8_MMA(1, 1, At, B1); PG8_BAR;
            PG8_LDB(B0, 1, 0); PG8_SCHED; PG8_LDA(At, 1, 0); PG8_STAGE_A(PG8_SA(0, 1), a2, 1, last);
            PG8_WAIT_L(8); PG8_BAR; PG8_WAIT_L(0); PG8_MMA(0, 0, At, B0); PG8_BAR; PG8_SCHED;
            PG8_LDB(B1, 1, 1); PG8_STAGE_B(PG8_SB(1, 0), b3);
            PG8_BAR; PG8_WAIT_L(0); PG8_MMA(0, 1, At, B1); PG8_BAR;
            PG8_LDA(At, 1, 1); PG8_STAGE_A(PG8_SA(1, 0), a3, 0, last);
            PG8_BAR; PG8_WAIT_L(0); PG8_MMA(1, 0, At, B0); PG8_BAR; PG8_SCHED;
            PG8_STAGE_B(PG8_SB(1, 1), b3 + hstep);
            PG8_WAIT_V(6); PG8_BAR; PG8_MMA(1, 1, At, B1); PG8_BAR;
        }
        E(acc, cur, S, wr, wc, fr, fq);
        if (!has_next) break;
#pragma unroll
        for (int a = 0; a < 2; ++a)
#pragma unroll
            for (int b = 0; b < 2; ++b)
#pragma unroll
                for (int m = 0; m < 4; ++m)
#pragma unroll
                    for (int n = 0; n < 2; ++n) acc[a][b][m][n] = (f32x4){0.f, 0.f, 0.f, 0.f};
        cur = nxt; cA = nA; cB = nB; ++ui;
        if constexpr (Sched::GATHER) {
#pragma unroll
            for (int h = 0; h < 2; ++h)
#pragma unroll
                for (int i = 0; i < 2; ++i) gc[h][i] = gn[h][i];
        }
    }
    PG8_WAIT_V(0);
    if (wr == 0) PG8_BAR;
    PG8_BAR;
#undef PG8_SA
#undef PG8_SB
#undef PG8_GLDS
#undef PG8_STAGE_A
#undef PG8_STAGE_B
#undef PG8_LDA
#undef PG8_LDB
#undef PG8_MMA
#undef PG8_WAIT_V
#undef PG8_WAIT_L
#undef PG8_BAR
#undef PG8_SCHED
}


struct EpiZ {
    static constexpr bool PERM = true;
    bf16_t* Z; const float* part; int npart;
    template <class S_> __device__ __forceinline__ void operator()(const f32x4 (&acc)[2][2][4][2], const Unit& u, const S_&, int wr, int wc, int fr, int fq) const {
        const int row0 = u.orow + wr * 64 + fr, col0 = u.ocol + wc * 32 + 8 * fq;
#pragma unroll
        for (int ai = 0; ai < 2; ++ai)
#pragma unroll
            for (int m = 0; m < 4; ++m) {
                const int row = row0 + ai * HALF + m * 16;
                float ss = 0.f;
                for (int p = 0; p < npart; ++p) ss += part[(size_t)p * M + row];
                const float rs = rsqrtf(ss * (1.0f / D) + 1e-6f);
                bf16_t* rowp = Z + (size_t)row * ZC + col0;
#pragma unroll
                for (int bj = 0; bj < 2; ++bj) { const f32x4 v0 = acc[ai][bj][m][0] * rs, v1 = acc[ai][bj][m][1] * rs;
                    u32x4 w; w.x = cvt_pk_bf16(v0[0], v0[1]); w.y = cvt_pk_bf16(v0[2], v0[3]); w.z = cvt_pk_bf16(v1[0], v1[1]); w.w = cvt_pk_bf16(v1[2], v1[3]);
                    *(u32x4*)(rowp + bj * HALF) = w; } }
    }
};
struct EpiRes {
    static constexpr bool PERM = true;
    const float* hin; float* hout; bf16_t* hb;
    template <class S_> __device__ __forceinline__ void operator()(const f32x4 (&acc)[2][2][4][2], const Unit& u, const S_&, int wr, int wc, int fr, int fq) const {
        const int row0 = u.orow + wr * 64 + fr, col0 = u.ocol + wc * 32 + 8 * fq;
#pragma unroll
        for (int ai = 0; ai < 2; ++ai)
#pragma unroll
            for (int m = 0; m < 4; ++m) {
                const size_t off = (size_t)(row0 + ai * HALF + m * 16) * D + col0;
#pragma unroll
                for (int bj = 0; bj < 2; ++bj) {
                    const f32x4 r0 = *(const f32x4*)(hin + off + bj * HALF), r1 = *(const f32x4*)(hin + off + bj * HALF + 4);
                    const f32x4 v0 = acc[ai][bj][m][0] + r0, v1 = acc[ai][bj][m][1] + r1;
                    *(f32x4*)(hout + off + bj * HALF) = v0; *(f32x4*)(hout + off + bj * HALF + 4) = v1;
                    u32x4 w; w.x = cvt_pk_bf16(v0[0], v0[1]); w.y = cvt_pk_bf16(v0[2], v0[3]); w.z = cvt_pk_bf16(v1[0], v1[1]); w.w = cvt_pk_bf16(v1[2], v1[3]);
                    *(u32x4*)(hb + off + bj * HALF) = w; }
                asm volatile("" ::: "memory"); }
    }
};
struct EpiGU {
    static constexpr bool PERM = true;
    bf16_t* hid; const float* rsf;
    template <class S_> __device__ __forceinline__ void operator()(const f32x4 (&acc)[2][2][4][2], const Unit& u, const S_& S, int wr, int wc, int fr, int fq) const {
        const int rl0 = wr * 64 + fr, col0 = (u.ocol >> 1) + wc * 32 + 8 * fq;
#pragma unroll
        for (int ai = 0; ai < 2; ++ai)
#pragma unroll
            for (int m = 0; m < 4; ++m) {
                const int rl = rl0 + ai * HALF + m * 16;
                const float rs = rsf[S.tok(u, rl)];
                const f32x4 g0 = acc[ai][0][m][0] * rs, g1 = acc[ai][0][m][1] * rs, u0 = acc[ai][1][m][0] * rs, u1 = acc[ai][1][m][1] * rs;
                float o[8];
#pragma unroll
                for (int j = 0; j < 4; ++j) { o[j] = g0[j] * sigmoidf_(g0[j]) * u0[j]; o[4 + j] = g1[j] * sigmoidf_(g1[j]) * u1[j]; }
                u32x4 w; w.x = cvt_pk_bf16(o[0], o[1]); w.y = cvt_pk_bf16(o[2], o[3]); w.z = cvt_pk_bf16(o[4], o[5]); w.w = cvt_pk_bf16(o[6], o[7]);
                *(u32x4*)(hid + (size_t)(u.orow + rl) * FF + col0) = w; }
    }
};
struct EpiDown {
    static constexpr bool PERM = true;
    bf16_t* ys; const float* glist; const int* cnt;
    template <class S_> __device__ __forceinline__ void operator()(const f32x4 (&acc)[2][2][4][2], const Unit& u, const S_&, int wr, int wc, int fr, int fq) const {
        const int rl0 = wr * 64 + fr, col0 = u.ocol + wc * 32 + 8 * fq; const int ce = cnt[u.e];
#pragma unroll
        for (int ai = 0; ai < 2; ++ai)
#pragma unroll
            for (int m = 0; m < 4; ++m) {
                const int rl = rl0 + ai * HALF + m * 16; const int pos = u.mt * BM + rl;
                const float g = pos < ce ? glist[u.e * LCAP + pos] : 0.f;
                bf16_t* rowp = ys + (size_t)(u.orow + rl) * D + col0;
#pragma unroll
                for (int bj = 0; bj < 2; ++bj) { const f32x4 v0 = acc[ai][bj][m][0] * g, v1 = acc[ai][bj][m][1] * g;
                    u32x4 w; w.x = cvt_pk_bf16(v0[0], v0[1]); w.y = cvt_pk_bf16(v0[2], v0[3]); w.z = cvt_pk_bf16(v1[0], v1[1]); w.w = cvt_pk_bf16(v1[2], v1[3]);
                    *(u32x4*)(rowp + bj * HALF) = w; } }
    }
};
struct EpiPP {
    static constexpr bool PERM = true;
    bf16_t* O;
    template <class S_> __device__ __forceinline__ void operator()(const f32x4 (&acc)[2][2][4][2], const Unit& u, const S_&, int wr, int wc, int fr, int fq) const {
        const int row0 = u.orow + wr * 64 + fr, col0 = u.ocol + wc * 32 + 8 * fq;
#pragma unroll
        for (int ai = 0; ai < 2; ++ai)
#pragma unroll
            for (int m = 0; m < 4; ++m) { bf16_t* rowp = O + (size_t)(row0 + ai * HALF + m * 16) * D + col0;
#pragma unroll
                for (int bj = 0; bj < 2; ++bj) { const f32x4 v0 = acc[ai][bj][m][0], v1 = acc[ai][bj][m][1];
                    u32x4 w; w.x = cvt_pk_bf16(v0[0], v0[1]); w.y = cvt_pk_bf16(v0[2], v0[3]); w.z = cvt_pk_bf16(v1[0], v1[1]); w.w = cvt_pk_bf16(v1[2], v1[3]);
                    *(u32x4*)(rowp + bj * HALF) = w; } }
    }
};
struct EpiPle {
    static constexpr bool PERM = true;
    float* h; bf16_t* hb; const bf16_t* pp; const float* rsp; float* part;
    template <class S_> __device__ __forceinline__ void operator()(const f32x4 (&acc)[2][2][4][2], const Unit& u, const S_&, int wr, int wc, int fr, int fq) const {
        const int row0 = u.orow + wr * 64 + fr, col0 = u.ocol + wc * 32 + 8 * fq;
        float* pout = part + (size_t)((u.ocol >> 8) * 4 + wc) * M;
#pragma unroll
        for (int ai = 0; ai < 2; ++ai)
#pragma unroll
            for (int m = 0; m < 4; ++m) {
                const int row = row0 + ai * HALF + m * 16; const size_t off = (size_t)row * D + col0;
                const float rs = rsp[row]; float ss = 0.f;
#pragma unroll
                for (int bj = 0; bj < 2; ++bj) {
                    const f32x4 r0 = *(const f32x4*)(h + off + bj * HALF), r1 = *(const f32x4*)(h + off + bj * HALF + 4);
                    const u32x4 pw = *(const u32x4*)(pp + off + bj * HALF);
                    float pv[8];
#pragma unroll
                    for (int j = 0; j < 4; ++j) { pv[2 * j] = __uint_as_float(pw[j] << 16); pv[2 * j + 1] = __uint_as_float(pw[j] & 0xffff0000u); }
                    f32x4 v0, v1;
#pragma unroll
                    for (int j = 0; j < 4; ++j) { v0[j] = r0[j] + sigmoidf_(acc[ai][bj][m][0][j] * rs) * pv[j]; v1[j] = r1[j] + sigmoidf_(acc[ai][bj][m][1][j] * rs) * pv[4 + j]; }
#pragma unroll
                    for (int j = 0; j < 4; ++j) ss += v0[j] * v0[j] + v1[j] * v1[j];
                    *(f32x4*)(h + off + bj * HALF) = v0; *(f32x4*)(h + off + bj * HALF + 4) = v1;
                    u32x4 w; w.x = cvt_pk_bf16(v0[0], v0[1]); w.y = cvt_pk_bf16(v0[2], v0[3]); w.z = cvt_pk_bf16(v1[0], v1[1]); w.w = cvt_pk_bf16(v1[2], v1[3]);
                    *(u32x4*)(hb + off + bj * HALF) = w; }
                ss += __shfl_xor(ss, 16); ss += __shfl_xor(ss, 32);
                if (fq == 0) pout[row] = ss;
                asm volatile("" ::: "memory"); }
    }
};
}

struct Params {
    const float* in[35];
    float* out;
    unsigned char* ws;
    int ph_lo, ph_hi;
};
enum { I_X = 0, I_P, I_MIXN, I_WIN, I_CONVW, I_CONVB, I_CLNG, I_CLNB, I_MU, I_W0, I_W2, I_A0, I_A2, I_G2, I_KK, I_KA, I_RK, I_GNG, I_GNB, I_V0, I_V1, I_V2,
       I_WOUT, I_FFNN, I_RGW, I_RGB, I_REW, I_REB, I_EWG, I_EWU, I_EWD, I_PLEN, I_PLEG, I_PLEP, I_FINN };

typedef const Params __attribute__((address_space(4)))* KP;
struct Ctx {
    LAS unsigned char* lds;
    int tid, lane, wave, vcu, G, bid;
};

__device__ __forceinline__ Ctx fresh(const Ctx& C0) { Ctx C = C0; int t = threadIdx.x; asm volatile("" : "+v"(t)); C.tid = t; C.lane = t & 63; C.wave = __builtin_amdgcn_readfirstlane(t >> 6);
    int bx = blockIdx.x; asm volatile("" : "+s"(bx)); C.bid = bx; C.vcu = (C.G % 8 == 0) ? (bx % 8) * (C.G / 8) + bx / 8 : bx; return C; }

__device__ __forceinline__ void tr_item(const float* W, int ldw, int k0, int n0, const float* gain, bf16_t* WT, int ldt, int drow0, LAS float* scr, int lane) {
#pragma unroll 8
    for (int i = 0; i < 32; ++i) { const int kk = 2 * i + (lane >> 5); float v = W[(size_t)(k0 + kk) * ldw + n0 + (lane & 31)]; if (gain) v *= gain[k0 + kk]; scr[kk * 33 + (lane & 31)] = v; }
    asm volatile("s_waitcnt lgkmcnt(0)" ::: "memory");
    const int c = lane & 7;
#pragma unroll
    for (int j = 0; j < 4; ++j) { const int n = (lane >> 3) + 8 * j; const LAS float* s = scr + (8 * c) * 33 + n;
        u32x4 o; o.x = pk2(s[0 * 33], s[1 * 33]); o.y = pk2(s[2 * 33], s[3 * 33]); o.z = pk2(s[4 * 33], s[5 * 33]); o.w = pk2(s[6 * 33], s[7 * 33]);
        *(u32x4*)(WT + (size_t)(drow0 + n) * ldt + k0 + 8 * c) = o; }
    asm volatile("s_waitcnt lgkmcnt(0)" ::: "memory");
}

__device__ __forceinline__ void phase_prep(KP P, const Ctx& C0, unsigned char* wsb, const int part) {
    const Ctx C = fresh(C0);
    LAS float* scr = (LAS float*)(C.lds + C.wave * 16384);
    const int gw = C.vcu * 8 + C.wave, NGW = C.G * 8;
    const int lane = C.lane;
    constexpr int IT_IN = 16 * 85, IT_OUT = 16 * 32, IT_GU = 2 * NE * 16 * 16, IT_D = NE * 8 * 32, IT_PG = 16 * 32, IT_PP = 4 * 32;
    constexpr int IT_LAYER = IT_IN + IT_OUT + IT_GU + IT_D + IT_PG + IT_PP;
    if (part == 0) for (int it = gw; it < DEPTH * IT_LAYER; it += NGW) {
        const int l = it / IT_LAYER; int r = it % IT_LAYER;
        unsigned char* wl = wsb + WS_W + (size_t)l * W_LAYER;
        const float* src; const float* gain = nullptr; bf16_t* dst; int ldw, ldt, k0, n0, drow, ty;
        if (r < IT_IN) { const int kb = r / 85, nb = r % 85;
            src = P->in[I_WIN] + (size_t)l * D * IN_COLS; ldw = IN_COLS; k0 = kb * 64; n0 = nb * 32; gain = P->in[I_MIXN] + l * D; dst = (bf16_t*)(wl + WO_IN); ldt = D; drow = n0; ty = 0;
        } else if (r < IT_IN + IT_OUT) { r -= IT_IN; const int kb = r / 32, nb = r % 32;
            src = P->in[I_WOUT] + (size_t)l * D * D; ldw = D; k0 = kb * 64; n0 = nb * 32; dst = (bf16_t*)(wl + WO_OUT); ldt = D; drow = n0; ty = 1;
        } else if (r < IT_IN + IT_OUT + IT_GU) { r -= IT_IN + IT_OUT; const int half = r / (NE * 256), r2 = r % (NE * 256), e = r2 / 256, kb = (r2 % 256) / 16, nb = r2 % 16;
            src = (half ? P->in[I_EWU] : P->in[I_EWG]) + ((size_t)l * NE + e) * D * FF; ldw = FF; k0 = kb * 64; n0 = nb * 32; gain = P->in[I_FFNN] + l * D; dst = (bf16_t*)(wl + WO_GU); ldt = D;
            drow = e * 1024 + (n0 >> 7) * 256 + half * 128 + (n0 & 127); ty = 2;
        } else if (r < IT_IN + IT_OUT + IT_GU + IT_D) { r -= IT_IN + IT_OUT + IT_GU; const int e = r / 256, kb = (r % 256) / 32, nb = r % 32;
            src = P->in[I_EWD] + ((size_t)l * NE + e) * FF * D; ldw = D; k0 = kb * 64; n0 = nb * 32; dst = (bf16_t*)(wl + WO_D); ldt = FF; drow = e * 1024 + n0; ty = 3;
        } else if (r < IT_IN + IT_OUT + IT_GU + IT_D + IT_PG) { r -= IT_IN + IT_OUT + IT_GU + IT_D; const int kb = r / 32, nb = r % 32;
            src = P->in[I_PLEG] + (size_t)l * D * D; ldw = D; k0 = kb * 64; n0 = nb * 32; gain = P->in[I_PLEN] + l * D; dst = (bf16_t*)(wl + WO_PG); ldt = D; drow = n0; ty = 4;
        } else { r -= IT_IN + IT_OUT + IT_GU + IT_D + IT_PG; const int kb = r / 32, nb = r % 32;
            src = P->in[I_PLEP] + (size_t)l * PLE * D; ldw = D; k0 = kb * 64; n0 = nb * 32; dst = (bf16_t*)(wl + WO_PP); ldt = PLE; drow = n0; ty = 5; }
        tr_item(src, ldw, k0, n0, gain, dst, ldt, drow, scr, lane);
    }
    if (part == 1) {
        const int gt = gw * 64 + lane, NGT = NGW * 64;
        bf16_t* w0 = (bf16_t*)(wsb + WS_W + WO_IN); bf16_t* w1 = (bf16_t*)(wsb + WS_W + W_LAYER + WO_IN);
        for (int i = gt; i < 96 * D / 8; i += NGT) *(u32x4*)(w0 + (size_t)IN_COLS * D + (size_t)i * 8) = (u32x4){0u, 0u, 0u, 0u};
        for (int i = gt; i < 32 * D / 8; i += NGT) *(u32x4*)(w1 + (size_t)(ZC_EB + 32) * D + (size_t)i * 8) = (u32x4){0u, 0u, 0u, 0u};
        const float* win1 = P->in[I_WIN] + (size_t)D * IN_COLS; const float* mu1 = P->in[I_MU] + RWKV_IN + 2 * RC; const float* v1 = P->in[I_V1]; const float* g1 = P->in[I_MIXN] + D;
        for (int k = gw; k < D; k += NGW) {
            const float* wr_ = win1 + (size_t)k * IN_COLS + ZC_V; float s = 0.f; const int j = lane & 31; const bool hi = lane >= 32;
            for (int c = 0; c < RC; ++c) { const float mu = mu1[c]; s += wr_[c] * (hi ? mu : 1.0f - mu) * v1[c * LV + j]; }
            w1[(size_t)(ZC_EA + lane) * D + k] = (bf16_t)f2bf(s * g1[k]);
        }
        float* wrt = (float*)(wsb + WS_WR);
        for (int i = gt; i < DEPTH * NRT * D; i += NGT) { const int l = i / (NRT * D), j = (i / D) % NRT, k = i % D; float v;
            if (j < NG) v = P->in[I_RGW][((size_t)l * D + k) * NG + j]; else { const int g = (j - NG) / EPG, e = (j - NG) % EPG; v = P->in[I_REW][(((size_t)l * NG + g) * D + k) * EPG + e]; }
            wrt[i] = v * P->in[I_FFNN][l * D + k]; }
        const f32x4* p4 = (const f32x4*)P->in[I_P]; u32x2* pb = (u32x2*)(wsb + WS_PB);
        for (size_t i = gt; i < (size_t)DEPTH * M * PLE / 4; i += NGT) { const f32x4 v = p4[i]; u32x2 w; w.x = pk2(v[0], v[1]); w.y = pk2(v[2], v[3]); pb[i] = w; }
    }
    if (part == 2) {
        bf16_t* hb = (bf16_t*)(wsb + WS_HB); float* part = (float*)(wsb + WS_PART);
        for (int m = gw; m < M; m += NGW) {
            const f32x4* xr = (const f32x4*)(P->in[I_X] + (size_t)m * D) + lane; u32x2* o = (u32x2*)(hb + (size_t)m * D) + lane; float s = 0.f;
#pragma unroll
            for (int j = 0; j < 4; ++j) { const f32x4 v = xr[64 * j]; s += (v[0] * v[0] + v[1] * v[1]) + (v[2] * v[2] + v[3] * v[3]); u32x2 w; w.x = pk2(v[0], v[1]); w.y = pk2(v[2], v[3]); o[64 * j] = w; }
            s = wave_sum(s);
            if (lane < NPART) part[(size_t)lane * M + m] = lane == 0 ? s : 0.f;
        }
    }
}

constexpr int SL_R = 0, SL_K = 8192, SL_V = 16384, SL_WD = 24576, SL_A = 32768, SL_B = 40960, SL_G = 49152, SL_Y = 57344;
constexpr int SL_LW = 65536, SL_LA = 69632, SL_LV = 73728, SL_LG = 77824;
constexpr int SL_W2 = 90112, SL_A2 = 98304, SL_V2 = 106496, SL_G2 = 114688;
constexpr int SL_BON = 139264;
static_assert(SL_G2 + 96 * 64 * 4 == SL_BON && SL_BON + 128 <= LDS_BYTES, "scan LDS map");

__device__ __forceinline__ void phase_mix(KP P, const Ctx& C0, unsigned char* wsb, int l) {
    const Ctx C = fresh(C0);
    const bf16_t* Z = (const bf16_t*)(wsb + WS_Z); bf16_t* Y = (bf16_t*)(wsb + WS_Y); bf16_t* VF = (bf16_t*)(wsb + WS_VF);
    const int tid = C.tid, lane = C.lane, wave = C.wave;
    {
        LAS float* co = (LAS float*)C.lds;
        const int c = tid;
        float cw[CONVW];
#pragma unroll
        for (int j = 0; j < CONVW; ++j) cw[j] = P->in[I_CONVW][((size_t)l * CONVW + j) * CONVC + c];
        const float cb = P->in[I_CONVB][l * CONVC + c];
        for (int item = C.bid; item < M / 32; item += C.G) {
            const int b = item >> 6, t0 = (item & 63) * 32;
            float u[62];
#pragma unroll
            for (int i = 0; i < 62; ++i) { const int t = t0 - 30 + i; float v = 0.f;
                if (t >= 0) { const bf16_t* zr = Z + (size_t)(b * SEQ + t) * ZC; v = bf2f(zr[c]) * sigmoidf_(bf2f(zr[CONVC + c])); }
                u[i] = v; }
#pragma unroll
            for (int tt = 0; tt < 32; ++tt) { float a = cb;
#pragma unroll
                for (int j = 0; j < CONVW; ++j) a += u[tt + j] * cw[j];
                co[tt * CONVC + c] = a; }
            __syncthreads();
#pragma unroll 1
            for (int q = 0; q < 4; ++q) { const int tt = wave * 4 + q;
                const f32x4 a0 = *(const LAS f32x4*)(co + tt * CONVC + lane * 8), a1 = *(const LAS f32x4*)(co + tt * CONVC + lane * 8 + 4);
                float s = (a0[0] + a0[1]) + (a0[2] + a0[3]) + (a1[0] + a1[1]) + (a1[2] + a1[3]);
                const float mean = wave_sum(s) * (1.0f / CONVC);
                float d[8]; float q2 = 0.f;
#pragma unroll
                for (int j = 0; j < 4; ++j) { d[j] = a0[j] - mean; d[4 + j] = a1[j] - mean; }
#pragma unroll
                for (int j = 0; j < 8; ++j) q2 += d[j] * d[j];
                const float rstd = rsqrtf(wave_sum(q2) * (1.0f / CONVC) + 1e-5f);
                const f32x4 g0 = *(const f32x4*)(P->in[I_CLNG] + l * CONVC + lane * 8), g1 = *(const f32x4*)(P->in[I_CLNG] + l * CONVC + lane * 8 + 4);
                const f32x4 b0 = *(const f32x4*)(P->in[I_CLNB] + l * CONVC + lane * 8), b1 = *(const f32x4*)(P->in[I_CLNB] + l * CONVC + lane * 8 + 4);
                float o[8];
#pragma unroll
                for (int j = 0; j < 4; ++j) { const float x0 = d[j] * rstd * g0[j] + b0[j], x1 = d[4 + j] * rstd * g1[j] + b1[j]; o[j] = x0 * sigmoidf_(x0); o[4 + j] = x1 * sigmoidf_(x1); }
                u32x4 w; w.x = pk2(o[0], o[1]); w.y = pk2(o[2], o[3]); w.z = pk2(o[4], o[5]); w.w = pk2(o[6], o[7]);
                *(u32x4*)(Y + (size_t)(b * SEQ + t0 + tt) * D + lane * 8) = w; }
            __syncthreads();
        }
    }
    {
        const int b = C.bid >> 3, h = C.bid & 7;
        LAS float* sR = (LAS float*)(C.lds + SL_R); LAS float* sK = (LAS float*)(C.lds + SL_K); LAS float* sV = (LAS float*)(C.lds + SL_V);
        LAS float* sWd = (LAS float*)(C.lds + SL_WD); LAS float* sA = (LAS float*)(C.lds + SL_A); LAS float* sB = (LAS float*)(C.lds + SL_B);
        LAS float* sG = (LAS float*)(C.lds + SL_G); LAS float* sY = (LAS float*)(C.lds + SL_Y);
        LAS float* sLW = (LAS float*)(C.lds + SL_LW); LAS float* sLA = (LAS float*)(C.lds + SL_LA); LAS float* sLV = (LAS float*)(C.lds + SL_LV); LAS float* sLG = (LAS float*)(C.lds + SL_LG);
        LAS float* sW2 = (LAS float*)(C.lds + SL_W2); LAS float* sA2 = (LAS float*)(C.lds + SL_A2); LAS float* sV2 = (LAS float*)(C.lds + SL_V2); LAS float* sG2 = (LAS float*)(C.lds + SL_G2);
        LAS float* sBon = (LAS float*)(C.lds + SL_BON);
        for (int i = tid; i < 32 * 64; i += 512) { const int k = i >> 6, cc = i & 63;
            sW2[i] = P->in[I_W2][((size_t)l * LW + k) * RC + h * HS + cc]; sA2[i] = P->in[I_A2][((size_t)l * LA + k) * RC + h * HS + cc];
            sV2[i] = (l > 0) ? P->in[I_V2][((size_t)(l - 1) * LV + k) * RC + h * HS + cc] : 0.f; }
        for (int i = tid; i < 96 * 64; i += 512) { const int k = i >> 6, cc = i & 63; sG2[i] = P->in[I_G2][((size_t)l * LG + k) * RC + h * HS + cc]; }
        const float* mu = P->in[I_MU] + (size_t)l * RWKV_IN;
        const int tokB = tid >> 4, cgB = tid & 15, hc = h * HS + cgB * 4;
        const f32x4 w0v = *(const f32x4*)(P->in[I_W0] + l * RC + hc), a0v = *(const f32x4*)(P->in[I_A0] + l * RC + hc);
        const f32x4 kkv = *(const f32x4*)(P->in[I_KK] + l * RC + hc), kav = *(const f32x4*)(P->in[I_KA] + l * RC + hc);
        const f32x4 rkv = *(const f32x4*)(P->in[I_RK] + l * RC + hc), gngv = *(const f32x4*)(P->in[I_GNG] + l * RC + hc), gnbv = *(const f32x4*)(P->in[I_GNB] + l * RC + hc);
        f32x4 v0v = (f32x4){0.f, 0.f, 0.f, 0.f}; if (l > 0) v0v = *(const f32x4*)(P->in[I_V0] + (l - 1) * RC + hc);
        const int vS = tid >> 3, kq = tid & 7;
        float S[8];
#pragma unroll
        for (int i = 0; i < 8; ++i) S[i] = 0.f;
        __syncthreads();
#pragma unroll 1
        for (int ch = 0; ch < SEQ / 32; ++ch) {
            const int t0 = ch * 32;
#pragma unroll 1
            for (int i = 0; i < 24; ++i) {
                const int idx = tid + 512 * i; const int tok = idx / 384, col = idx % 384; const int t = t0 + tok;
                int zc; if (col < 64) zc = ZC_R + h * HS + col; else if (col < 128) zc = ZC_K + h * HS + (col - 64); else if (col < 192) zc = ZC_V + h * HS + (col - 128); else zc = ZC_WLO + (col - 192);
                const bf16_t* zr = Z + (size_t)(b * SEQ + t) * ZC;
                if (col < 352) {
                    const float zc_ = bf2f(zr[zc]); const float zp = (t > 0) ? bf2f(zr[zc - ZC]) : 0.f;
                    const float zs = zc_ + (zp - zc_) * mu[zc - 1024];
                    if (col < 64) sR[tok * 64 + col] = zs; else if (col < 128) sK[tok * 64 + col - 64] = zs; else if (col < 192) sV[tok * 64 + col - 128] = zs;
                    else if (col < 224) sLW[tok * 32 + col - 192] = tanhf_(zs); else if (col < 256) sLA[tok * 32 + col - 224] = zs; else sLG[tok * 96 + col - 256] = sigmoidf_(zs);
                } else {
                    const int j = col - 352; float v = 0.f;
                    if (l > 0) { v = bf2f(zr[ZC_EA + j]); if (t > 0) v += bf2f(zr[ZC_EB + j - ZC]); }
                    sLV[tok * 32 + j] = v;
                }
            }
            __syncthreads();
            {
                const int tok = tokB; const int t = t0 + tok;
                f32x4 wv = w0v, av = a0v, gv = (f32x4){0.f, 0.f, 0.f, 0.f}, vg = v0v;
#pragma unroll 8
                for (int k = 0; k < 32; ++k) { const float lw = sLW[tok * 32 + k], la = sLA[tok * 32 + k];
                    wv += lw * *(const LAS f32x4*)(sW2 + k * 64 + cgB * 4); av += la * *(const LAS f32x4*)(sA2 + k * 64 + cgB * 4); }
#pragma unroll 8
                for (int k = 0; k < 96; ++k) gv += sLG[tok * 96 + k] * *(const LAS f32x4*)(sG2 + k * 64 + cgB * 4);
                if (l > 0) {
#pragma unroll 8
                    for (int k = 0; k < 32; ++k) vg += sLV[tok * 32 + k] * *(const LAS f32x4*)(sV2 + k * 64 + cgB * 4);
                }
                const f32x4 r4 = *(const LAS f32x4*)(sR + tok * 64 + cgB * 4), k4 = *(const LAS f32x4*)(sK + tok * 64 + cgB * 4); f32x4 v4 = *(const LAS f32x4*)(sV + tok * 64 + cgB * 4);
                bf16_t* vfp = VF + (size_t)(b * SEQ + t) * RC + hc;
                if (l == 0) { u32x2 w; w.x = pk2(v4[0], v4[1]); w.y = pk2(v4[2], v4[3]); *(u32x2*)vfp = w; }
                else { const u32x2 w = *(const u32x2*)vfp; const float f0 = __uint_as_float(w.x << 16), f1 = __uint_as_float(w.x & 0xffff0000u), f2 = __uint_as_float(w.y << 16), f3 = __uint_as_float(w.y & 0xffff0000u);
                    v4[0] += (f0 - v4[0]) * sigmoidf_(vg[0]); v4[1] += (f1 - v4[1]) * sigmoidf_(vg[1]); v4[2] += (f2 - v4[2]) * sigmoidf_(vg[2]); v4[3] += (f3 - v4[3]) * sigmoidf_(vg[3]); }
                f32x4 dec, a4, kk4, k2, bb; float ssq = 0.f, rk = 0.f;
#pragma unroll
                for (int j = 0; j < 4; ++j) { dec[j] = __expf(-0.60653066f * sigmoidf_(wv[j])); a4[j] = sigmoidf_(av[j]); kk4[j] = k4[j] * kkv[j]; ssq += kk4[j] * kk4[j]; k2[j] = k4[j] * (1.0f + (a4[j] - 1.0f) * kav[j]); rk += r4[j] * k2[j] * rkv[j]; }
                ssq = red16(ssq); rk = red16(rk);
                const float inv = 1.0f / fmaxf(sqrtf(ssq), 1e-12f);
#pragma unroll
                for (int j = 0; j < 4; ++j) { kk4[j] *= inv; bb[j] = kk4[j] * a4[j]; kk4[j] = -kk4[j]; }
                *(LAS f32x4*)(sK + tok * 64 + cgB * 4) = k2; *(LAS f32x4*)(sV + tok * 64 + cgB * 4) = v4; *(LAS f32x4*)(sWd + tok * 64 + cgB * 4) = dec;
                *(LAS f32x4*)(sA + tok * 64 + cgB * 4) = kk4; *(LAS f32x4*)(sB + tok * 64 + cgB * 4) = bb; *(LAS f32x4*)(sG + tok * 64 + cgB * 4) = gv;
                if (cgB == 0) sBon[tok] = rk;
            }
            __syncthreads();
#pragma unroll 2
            for (int t = 0; t < 32; ++t) {
                const f32x4 a_0 = *(const LAS f32x4*)(sA + t * 64 + kq * 8), a_1 = *(const LAS f32x4*)(sA + t * 64 + kq * 8 + 4);
                const f32x4 w_0 = *(const LAS f32x4*)(sWd + t * 64 + kq * 8), w_1 = *(const LAS f32x4*)(sWd + t * 64 + kq * 8 + 4);
                const f32x4 k_0 = *(const LAS f32x4*)(sK + t * 64 + kq * 8), k_1 = *(const LAS f32x4*)(sK + t * 64 + kq * 8 + 4);
                const f32x4 b_0 = *(const LAS f32x4*)(sB + t * 64 + kq * 8), b_1 = *(const LAS f32x4*)(sB + t * 64 + kq * 8 + 4);
                const f32x4 r_0 = *(const LAS f32x4*)(sR + t * 64 + kq * 8), r_1 = *(const LAS f32x4*)(sR + t * 64 + kq * 8 + 4);
                const float vv = sV[t * 64 + vS];
                float sa = 0.f;
#pragma unroll
                for (int i = 0; i < 4; ++i) sa += S[i] * a_0[i] + S[4 + i] * a_1[i];
                sa = red8(sa);
                float yy = 0.f;
#pragma unroll
                for (int i = 0; i < 4; ++i) { S[i] = S[i] * w_0[i] + sa * b_0[i] + vv * k_0[i]; S[4 + i] = S[4 + i] * w_1[i] + sa * b_1[i] + vv * k_1[i]; yy += S[i] * r_0[i] + S[4 + i] * r_1[i]; }
                yy = red8(yy);
                if (kq == 0) sY[t * 64 + vS] = yy;
            }
            __syncthreads();
            {
                const int tok = tokB; const int t = t0 + tok;
                const f32x4 y4 = *(const LAS f32x4*)(sY + tok * 64 + cgB * 4), v4 = *(const LAS f32x4*)(sV + tok * 64 + cgB * 4), g4 = *(const LAS f32x4*)(sG + tok * 64 + cgB * 4);
                const float mean = red16((y4[0] + y4[1]) + (y4[2] + y4[3])) * (1.0f / HS);
                f32x4 d = y4 - mean;
                const float var = red16((d[0] * d[0] + d[1] * d[1]) + (d[2] * d[2] + d[3] * d[3])) * (1.0f / HS);
                const float rstd = rsqrtf(var + 64e-5f); const float bon = sBon[tok];
                float o[4];
#pragma unroll
                for (int j = 0; j < 4; ++j) o[j] = (d[j] * rstd * gngv[j] + gnbv[j] + bon * v4[j]) * g4[j];
                u32x2 w; w.x = pk2(o[0], o[1]); w.y = pk2(o[2], o[3]);
                *(u32x2*)(Y + (size_t)(b * SEQ + t) * D + CONVC + hc) = w;
            }
            __syncthreads();
        }
    }
}

__device__ __forceinline__ void phase_router(KP P, const Ctx& C0, unsigned char* wsb, int l) {
    const Ctx C = fresh(C0);
    const float* h = P->out; const float* wr = (const float*)(wsb + WS_WR) + (size_t)l * NRT * D;
    float* rsf = (float*)(wsb + WS_RSF); int* cnt = (int*)(wsb + WS_CTL) + l * 64; int* tlist = (int*)(wsb + WS_TLIST); float* glist = (float*)(wsb + WS_GLIST); int* tslot = (int*)(wsb + WS_TSLOT);
    const int gw = C.vcu * 8 + C.wave, NGW = C.G * 8, lane = C.lane;
    float gb[NG];
#pragma unroll
    for (int j = 0; j < NG; ++j) gb[j] = P->in[I_RGB][l * NG + j];
    for (int grp = gw; grp < M / 4; grp += NGW) {
        f32x4 hv[4][4]; float rs[4];
#pragma unroll
        for (int q = 0; q < 4; ++q) { const f32x4* hr = (const f32x4*)(h + (size_t)(grp * 4 + q) * D) + lane; float s = 0.f;
#pragma unroll
            for (int j = 0; j < 4; ++j) { hv[q][j] = hr[64 * j]; s += (hv[q][j][0] * hv[q][j][0] + hv[q][j][1] * hv[q][j][1]) + (hv[q][j][2] * hv[q][j][2] + hv[q][j][3] * hv[q][j][3]); }
            rs[q] = rsqrtf(wave_sum(s) * (1.0f / D) + 1e-6f); }
        if (lane < 4) rsf[grp * 4 + lane] = lane == 0 ? rs[0] : lane == 1 ? rs[1] : lane == 2 ? rs[2] : rs[3];
        float gl[4][NG];
#pragma unroll
        for (int j = 0; j < NG; ++j) { const f32x4* w4 = (const f32x4*)(wr + (size_t)j * D) + lane; f32x4 wv[4];
#pragma unroll
            for (int jj = 0; jj < 4; ++jj) wv[jj] = w4[64 * jj];
#pragma unroll
            for (int q = 0; q < 4; ++q) { float s = 0.f;
#pragma unroll
                for (int jj = 0; jj < 4; ++jj) s += (hv[q][jj][0] * wv[jj][0] + hv[q][jj][1] * wv[jj][1]) + (hv[q][jj][2] * wv[jj][2] + hv[q][jj][3] * wv[jj][3]);
                gl[q][j] = wave_sum(s) * rs[q] + gb[j]; } }
#pragma unroll
        for (int q = 0; q < 4; ++q) {
            const int t = grp * 4 + q;
            int gi = 0; float gm = gl[q][0];
#pragma unroll
            for (int j = 1; j < NG; ++j) if (gl[q][j] > gm) { gm = gl[q][j]; gi = j; }
            float den = 0.f;
#pragma unroll
            for (int j = 0; j < NG; ++j) den += __expf(gl[q][j] - gm);
            const float gp = 1.0f / den;
            gi = __builtin_amdgcn_readfirstlane(gi);
            float el[EPG];
#pragma unroll
            for (int e = 0; e < EPG; ++e) { const f32x4* w4 = (const f32x4*)(wr + (size_t)(NG + gi * EPG + e) * D) + lane; float s = 0.f;
#pragma unroll
                for (int jj = 0; jj < 4; ++jj) { const f32x4 wv = w4[64 * jj]; s += (hv[q][jj][0] * wv[0] + hv[q][jj][1] * wv[1]) + (hv[q][jj][2] * wv[2] + hv[q][jj][3] * wv[3]); }
                el[e] = wave_sum(s) * rs[q] + P->in[I_REB][(l * NG + gi) * EPG + e]; }
            int i0 = 0; float m0 = el[0];
#pragma unroll
            for (int e = 1; e < EPG; ++e) if (el[e] > m0) { m0 = el[e]; i0 = e; }
            int i1 = (i0 == 0) ? 1 : 0; float m1 = -3.0e38f;
#pragma unroll
            for (int e = 0; e < EPG; ++e) if (e != i0 && el[e] > m1) { m1 = el[e]; i1 = e; }
            const float p1 = 1.0f / (1.0f + __expf(m0 - m1));
            const float w0 = (1.0f - p1) * gp, w1 = p1 * gp;
            if (lane == 0) {
                const int e0 = gi * EPG + i0, e1 = gi * EPG + i1;
                const int p0 = atomicAdd(&cnt[e0], 1); tlist[e0 * LCAP + p0] = t; glist[e0 * LCAP + p0] = w0; tslot[t * 2] = e0 * LCAP + p0;
                const int p1_ = atomicAdd(&cnt[e1], 1); tlist[e1 * LCAP + p1_] = t; glist[e1 * LCAP + p1_] = w1; tslot[t * 2 + 1] = e1 * LCAP + p1_;
            }
        }
    }
}

__device__ __forceinline__ void moe_prefix(KP P, const Ctx& C0, unsigned char* wsb, int l) {
    const Ctx C = fresh(C0);
    const int* cnt = (const int*)(wsb + WS_CTL) + l * 64;
    LAS int* tp = (LAS int*)(C.lds + LDS_MISC); LAS int* ps = (LAS int*)(C.lds + LDS_MISC + 256);
    if (C.tid == 0) { int a = 0; for (int e = 0; e < NE; ++e) { tp[e] = a; ps[e] = a * 256; a += (cnt[e] + 255) >> 8; } tp[NE] = a; ps[NE] = a * 256; }
    __syncthreads();
}

__device__ __forceinline__ void phase_combine(KP P, const Ctx& C0, unsigned char* wsb, int l) {
    const Ctx C = fresh(C0);
    float* h = P->out; bf16_t* hb = (bf16_t*)(wsb + WS_HB); const bf16_t* ys = (const bf16_t*)(wsb + WS_YS); const int* tslot = (const int*)(wsb + WS_TSLOT); float* rsp = (float*)(wsb + WS_RSP);
    const LAS int* ps = (const LAS int*)(C.lds + LDS_MISC + 256);
    const int gw = C.vcu * 8 + C.wave, NGW = C.G * 8, lane = C.lane;
    for (int m = gw; m < M; m += NGW) {
        const int s0 = tslot[m * 2], s1 = tslot[m * 2 + 1];
        const size_t r0 = (size_t)(ps[s0 >> 16] + (s0 & 0xffff)), r1 = (size_t)(ps[s1 >> 16] + (s1 & 0xffff));
        f32x4* hr = (f32x4*)(h + (size_t)m * D) + lane; const u32x2* y0 = (const u32x2*)(ys + r0 * D) + lane; const u32x2* y1 = (const u32x2*)(ys + r1 * D) + lane; u32x2* o = (u32x2*)(hb + (size_t)m * D) + lane;
        float s = 0.f;
#pragma unroll
        for (int j = 0; j < 4; ++j) { f32x4 v = hr[64 * j]; const u32x2 a = y0[64 * j], b = y1[64 * j];
            v[0] = (v[0] + __uint_as_float(a.x << 16)) + __uint_as_float(b.x << 16); v[1] = (v[1] + __uint_as_float(a.x & 0xffff0000u)) + __uint_as_float(b.x & 0xffff0000u);
            v[2] = (v[2] + __uint_as_float(a.y << 16)) + __uint_as_float(b.y << 16); v[3] = (v[3] + __uint_as_float(a.y & 0xffff0000u)) + __uint_as_float(b.y & 0xffff0000u);
            s += (v[0] * v[0] + v[1] * v[1]) + (v[2] * v[2] + v[3] * v[3]); hr[64 * j] = v; u32x2 w; w.x = pk2(v[0], v[1]); w.y = pk2(v[2], v[3]); o[64 * j] = w; }
        s = wave_sum(s);
        if (lane == 0) rsp[m] = rsqrtf(s * (1.0f / D) + 1e-6f);
    }
}

__device__ __forceinline__ void phase_final(KP P, const Ctx& C0, unsigned char* wsb) {
    const Ctx C = fresh(C0);
    float* h = P->out; const float* g = P->in[I_FINN];
    const int gw = C.vcu * 8 + C.wave, NGW = C.G * 8, lane = C.lane;
    f32x4 gv[4];
#pragma unroll
    for (int j = 0; j < 4; ++j) gv[j] = ((const f32x4*)g)[lane + 64 * j];
    for (int m = gw; m < M; m += NGW) {
        f32x4* hr = (f32x4*)(h + (size_t)m * D) + lane; f32x4 v[4]; float ss = 0.f;
#pragma unroll
        for (int j = 0; j < 4; ++j) { v[j] = hr[64 * j]; ss += (v[j][0] * v[j][0] + v[j][1] * v[j][1]) + (v[j][2] * v[j][2] + v[j][3] * v[j][3]); }
        const float rs = rsqrtf(wave_sum(ss) * (1.0f / D) + 1e-6f);
#pragma unroll
        for (int j = 0; j < 4; ++j) hr[64 * j] = v[j] * rs * gv[j];
    }
}

__device__ __forceinline__ float dbg_dot(const bf16_t* a, const bf16_t* b, int K, int lane) {
    float s = 0.f;
    for (int k = lane * 8; k < K; k += 512) { const u32x4 av = *(const u32x4*)(a + k), bv = *(const u32x4*)(b + k);
#pragma unroll
        for (int j = 0; j < 4; ++j) s += __uint_as_float(av[j] << 16) * __uint_as_float(bv[j] << 16) + __uint_as_float(av[j] & 0xffff0000u) * __uint_as_float(bv[j] & 0xffff0000u); }
    return wave_sum(s);
}
__device__ __forceinline__ void phase_dbg(KP P, const Ctx& C0, unsigned char* wsb, const int mode) {
    const Ctx C = fresh(C0);
    const int gw = C.vcu * 8 + C.wave, NGW = C.G * 8, lane = C.lane;
    const bf16_t* hb = (const bf16_t*)(wsb + WS_HB); const float* part = (const float*)(wsb + WS_PART);
    unsigned char* wl = wsb + WS_W;
    for (int m = gw; m < M; m += NGW) {
        bool ok = true;
        for (int q = 0; q < 4; ++q) {
            unsigned hsh = (unsigned)m * 2654435761u + (unsigned)q * 40503u; hsh ^= hsh >> 13;
            if (mode == 1) {
                const int n = hsh % IN_COLS;
                float ss = 0.f; for (int p = 0; p < NPART; ++p) ss += part[(size_t)p * M + m];
                const float ref = dbg_dot(hb + (size_t)m * D, (const bf16_t*)(wl + WO_IN) + (size_t)n * D, D, lane) * rsqrtf(ss * (1.0f / D) + 1e-6f);
                const float got = bf2f(((const bf16_t*)(wsb + WS_Z))[(size_t)m * ZC + n]);
                if (!(fabsf(got - ref) <= 0.02f * fabsf(ref) + 0.02f)) ok = false;
            } else if (mode == 2) {
                const int n = hsh % D;
                const float ref = P->in[I_X][(size_t)m * D + n] + dbg_dot((const bf16_t*)(wsb + WS_Y) + (size_t)m * D, (const bf16_t*)(wl + WO_OUT) + (size_t)n * D, D, lane);
                const float got = P->out[(size_t)m * D + n];
                if (!(fabsf(got - ref) <= 0.02f * fabsf(ref) + 0.02f)) ok = false;
            } else if (mode == 3) {
                const int n = hsh % IN_COLS; const int k = (hsh >> 8) % D;
                const float ref = P->in[I_WIN][(size_t)k * IN_COLS + n] * P->in[I_MIXN][k];
                const float got = bf2f(((const bf16_t*)(wl + WO_IN))[(size_t)n * D + k]);
                if (!(fabsf(got - ref) <= 0.01f * fabsf(ref) + 1e-4f)) ok = false;
            } else if (mode == 4) {
                const int n = hsh % D;
                const float ref = P->in[I_X][(size_t)m * D + n]; const float got = bf2f(hb[(size_t)m * D + n]);
                if (!(fabsf(got - ref) <= 0.01f * fabsf(ref) + 1e-4f)) ok = false;
            }
        }
        const f32x4* xr = (const f32x4*)(P->in[I_X] + (size_t)m * D) + lane; f32x4* o = (f32x4*)(P->out + (size_t)m * D) + lane;
#pragma unroll
        for (int j = 0; j < 4; ++j) o[64 * j] = ok ? xr[64 * j] : (f32x4){0.f, 0.f, 0.f, 0.f};
    }
}

constexpr int N_PREP = 3;
constexpr int N_PHASES = N_PREP + 1 + 8 * DEPTH;

__device__ __forceinline__ void run_layer_phase(const Ctx& C, const int l_, const int sub) {
    KP KPp = (KP)__builtin_amdgcn_kernarg_segment_ptr(); asm volatile("" : "+s"(KPp));
    unsigned char* ws = KPp->ws;
    int bid = blockIdx.x; asm volatile("" : "+s"(bid));
    int l = l_; asm volatile("" : "+s"(l));
    unsigned char* wl = ws + WS_W + (size_t)l * W_LAYER;
    bf16_t* hb = (bf16_t*)(ws + WS_HB);
    if (sub == 0) {
        pg8::StaticOrder S; S.init(M, ZC, C.G, bid);
        pg8::EpiZ E{(bf16_t*)(ws + WS_Z), (const float*)(ws + WS_PART), NPART};
        pg8::gemm_phase(C.lds, l == 0 ? (const bf16_t*)hb : (const bf16_t*)(ws + WS_Y), (const bf16_t*)(wl + WO_IN), D, S, E);
    } else if (sub == 1) {
        phase_mix(KPp, C, ws, l);
    } else if (sub == 2) {
        pg8::StaticOrder S; S.init(M, D, C.G, bid);
        pg8::EpiRes E{l == 0 ? KPp->in[I_X] : (const float*)KPp->out, KPp->out, hb};
        pg8::gemm_phase(C.lds, (const bf16_t*)(ws + WS_Y), (const bf16_t*)(wl + WO_OUT), D, S, E);
    } else if (sub == 3) {
        phase_router(KPp, C, ws, l);
    } else if (sub == 4) {
        moe_prefix(KPp, C, ws, l);
        pg8::GroupedOrder<true> S{(const LAS int*)(C.lds + LDS_MISC), (const LAS int*)(C.lds + LDS_MISC + 256), (const int*)(ws + WS_CTL) + l * 64, (const int*)(ws + WS_TLIST), 1024, C.G, bid};
        pg8::EpiGU E{(bf16_t*)(ws + WS_HID), (const float*)(ws + WS_RSF)};
        pg8::gemm_phase(C.lds, hb, (const bf16_t*)(wl + WO_GU), D, S, E);
    } else if (sub == 5) {
        moe_prefix(KPp, C, ws, l);
        pg8::GroupedOrder<false> S{(const LAS int*)(C.lds + LDS_MISC), (const LAS int*)(C.lds + LDS_MISC + 256), (const int*)(ws + WS_CTL) + l * 64, (const int*)(ws + WS_TLIST), 1024, C.G, bid};
        pg8::EpiDown E{(bf16_t*)(ws + WS_YS), (const float*)(ws + WS_GLIST), (const int*)(ws + WS_CTL) + l * 64};
        pg8::gemm_phase(C.lds, (const bf16_t*)(ws + WS_HID), (const bf16_t*)(wl + WO_D), FF, S, E);
    } else if (sub == 6) {
        moe_prefix(KPp, C, ws, l);
        phase_combine(KPp, C, ws, l);
        __syncthreads();
        pg8::StaticOrder S; S.init(M, D, C.G, bid);
        pg8::EpiPP E{(bf16_t*)(ws + WS_PP)};
        pg8::gemm_phase(C.lds, (const bf16_t*)(ws + WS_PB) + (size_t)l * M * PLE, (const bf16_t*)(wl + WO_PP), PLE, S, E);
    } else {
        pg8::StaticOrder S; S.init(M, D, C.G, bid);
        pg8::EpiPle E{KPp->out, (bf16_t*)(ws + WS_Y), (const bf16_t*)(ws + WS_PP), (const float*)(ws + WS_RSP), (float*)(ws + WS_PART)};
        pg8::gemm_phase(C.lds, hb, (const bf16_t*)(wl + WO_PG), D, S, E);
    }
}

__global__ void __launch_bounds__(512, 2) mega(Params P) {
    extern __shared__ __attribute__((aligned(16))) unsigned char lds_raw[];
    Ctx C; C.lds = (LAS unsigned char*)lds_raw; C.tid = threadIdx.x; C.lane = C.tid & 63; C.wave = __builtin_amdgcn_readfirstlane(C.tid >> 6);
    C.G = gridDim.x; C.vcu = 0; C.bid = 0;
    cg::grid_group grid = cg::this_grid();
    const int lo = P.ph_lo, hi = P.ph_hi & 0xffff; const bool fin = (P.ph_hi >> 16) != 0;
#define GSYNC() do { asm volatile("s_waitcnt vmcnt(0) lgkmcnt(0)" ::: "memory"); grid.sync(); asm volatile("s_waitcnt vmcnt(0) lgkmcnt(0)" ::: "memory"); } while (0)
#define PHASE(k, body) do { if (lo <= (k) && (k) < hi) { if ((k) > lo) GSYNC(); body; } } while (0)
#define PREP_PHASE(k) PHASE(k, { KP KPp = (KP)__builtin_amdgcn_kernarg_segment_ptr(); asm volatile("" : "+s"(KPp)); phase_prep(KPp, C, KPp->ws, k); })
    PREP_PHASE(0); PREP_PHASE(1); PREP_PHASE(2);
#define LAYER_PHASE(l, sub) PHASE(N_PREP + 8 * (l) + (sub), run_layer_phase(C, l, sub))
    LAYER_PHASE(0, 0); LAYER_PHASE(0, 1); LAYER_PHASE(0, 2); LAYER_PHASE(0, 3); LAYER_PHASE(0, 4); LAYER_PHASE(0, 5); LAYER_PHASE(0, 6); LAYER_PHASE(0, 7);
    LAYER_PHASE(1, 0); LAYER_PHASE(1, 1); LAYER_PHASE(1, 2); LAYER_PHASE(1, 3); LAYER_PHASE(1, 4); LAYER_PHASE(1, 5); LAYER_PHASE(1, 6); LAYER_PHASE(1, 7);
#ifdef DBG_MODE
    { GSYNC(); KP KPp = (KP)__builtin_amdgcn_kernarg_segment_ptr(); asm volatile("" : "+s"(KPp)); phase_dbg(KPp, C, KPp->ws, DBG_MODE); }
#endif
    if (fin || (lo <= N_PHASES - 1 && N_PHASES - 1 < hi)) { if (N_PHASES - 1 > lo) GSYNC(); { KP KPp = (KP)__builtin_amdgcn_kernarg_segment_ptr(); asm volatile("" : "+s"(KPp)); phase_final(KPp, C, KPp->ws); } }
}

extern "C" void kernel_launch(void* const* d_in, const int* in_sizes, int n_in, void* d_out, int out_size, void* d_ws, size_t ws_size, hipStream_t stream) {
    static int grid = 0;
    if (grid == 0) {
        if (n_in != 35 || out_size != M * D || ws_size < WS_END) { fprintf(stderr, "kernel_launch: unexpected shapes (n_in %d out %d ws %zu)\n", n_in, out_size, ws_size); grid = -1; return; }
        int dev = 0, cus = 0, per_cu = 0;
        hipGetDevice(&dev); hipDeviceGetAttribute(&cus, hipDeviceAttributeMultiprocessorCount, dev);
        hipFuncSetAttribute((const void*)mega, hipFuncAttributeMaxDynamicSharedMemorySize, LDS_BYTES);
        hipOccupancyMaxActiveBlocksPerMultiprocessor(&per_cu, (const void*)mega, 512, LDS_BYTES);
        (void)hipGetLastError();
        if (per_cu < 1 || cus != 256) { fprintf(stderr, "kernel_launch: occupancy %d per CU, %d CUs: unsupported\n", per_cu, cus); grid = -1; return; }
        grid = 256;
    }
    if (grid < 0) return;
    hipMemsetAsync((char*)d_ws + WS_CTL, 0, CTL_BYTES, stream);
    Params p{};
    for (int i = 0; i < 35; ++i) p.in[i] = (const float*)d_in[i];
    p.out = (float*)d_out; p.ws = (unsigned char*)d_ws;
#if MK_N_LAUNCHES == 1
    p.ph_lo = 0; p.ph_hi = (N_PHASES < PH_STOP ? N_PHASES : (PH_STOP | (DBG_FIN << 16)));
    { void* args[] = {&p}; hipLaunchCooperativeKernel((const void*)mega, dim3(grid), dim3(512), args, LDS_BYTES, stream); }
#else
    for (int ph = 0; ph < N_PHASES; ++ph) { p.ph_lo = ph; p.ph_hi = ph + 1; void* args[] = {&p}; hipLaunchCooperativeKernel((const void*)mega, dim3(grid), dim3(512), args, LDS_BYTES, stream); }
#endif
}
```

```cpp
#include <hip/hip_runtime.h>
#include <hip/hip_cooperative_groups.h>
#include <cstdio>
#include <cstdint>
namespace cg = cooperative_groups;

#define LAS __attribute__((address_space(3)))
typedef unsigned short bf16_t;
typedef short bf16x8 __attribute__((ext_vector_type(8)));
typedef float f32x4 __attribute__((ext_vector_type(4)));
typedef float f32x2 __attribute__((ext_vector_type(2)));
typedef unsigned u32x4 __attribute__((ext_vector_type(4)));
typedef unsigned u32x2 __attribute__((ext_vector_type(2)));

#ifndef PREP_REP
#define PREP_REP 1
#endif
#ifndef P2_MASK
#define P2_MASK 15
#endif
#ifndef RT_STOP
#define RT_STOP 1
#endif
#ifndef RT_TR
#define RT_TR 63
#endif
#ifndef TR_MASK
#define TR_MASK 63
#endif
#ifndef PREP_MASK
#define PREP_MASK 7
#endif
#define BLK_LO 0
#define BLK_HI 0
#define DBG_FIN 1
#define TIM_A0 5
#define TIM_A1 6
#define TIM_B0 6
#define TIM_B1 7
#ifndef PH_STOP
#define PH_STOP 99
#endif
#ifndef PH_MASK
#define PH_MASK 0xFFFF
#endif
#define PH_ON(k) ((PH_MASK >> (k)) & 1)
#ifndef MK_N_LAUNCHES
#define MK_N_LAUNCHES 1
#endif

constexpr int BATCH = 32, SEQ = 2048, M = BATCH * SEQ, D = 1024, DEPTH = 2;
constexpr int CONVC = 512, CONVW = 31, RC = 512, NH = 8, HS = 64;
constexpr int LW = 32, LA = 32, LV = 32, LG = 96;
constexpr int RWKV_IN = 3 * RC + LW + LA + LG;
constexpr int IN_COLS = 2 * CONVC + RWKV_IN;
constexpr int ZC = 2816;
constexpr int ZC_R = 1024, ZC_K = 1536, ZC_V = 2048, ZC_WLO = 2560, ZC_ALO = 2592, ZC_GLO = 2624, ZC_EA = 2720, ZC_EB = 2752;
constexpr int NG = 4, EPG = 8, NE = 32, FF = 512, PLE = 256, NRT = 36;
constexpr int LCAP = 65536;
constexpr int MAXSLOT = 2 * M + NE * 256;
constexpr int NPART = 16;

constexpr size_t MiB = 1u << 20;
constexpr size_t WS_CTL = 0;
constexpr size_t CTL_BYTES = 1 * MiB;
constexpr size_t WS_WR = 1 * MiB;
constexpr size_t WS_PART = 2 * MiB;
constexpr size_t WS_RSF = 6 * MiB;
constexpr size_t WS_RSP = 6 * MiB + 512 * 1024;
constexpr size_t WS_TSLOT = 7 * MiB;
constexpr size_t WS_GLIST = 8 * MiB;
constexpr size_t WS_TLIST = 16 * MiB;
constexpr size_t WS_RLIST = 976 * MiB;
constexpr size_t WS_W = 24 * MiB;
constexpr size_t W_LAYER = 107 * MiB;
constexpr size_t WO_IN = 0;
constexpr size_t WO_OUT = 6 * MiB;
constexpr size_t WO_GU = 8 * MiB;
constexpr size_t WO_D = 72 * MiB;
constexpr size_t WO_PG = 104 * MiB;
constexpr size_t WO_PP = 106 * MiB;
constexpr size_t WS_HB = 238 * MiB;
constexpr size_t WS_VF = 366 * MiB;
constexpr size_t WS_PB = 430 * MiB;
constexpr size_t WS_R = 494 * MiB;
constexpr size_t WS_Z = WS_R;
constexpr size_t WS_Y = WS_R + 352 * MiB;
constexpr size_t WS_HID = WS_R;
constexpr size_t WS_YS = WS_R + 144 * MiB;
constexpr size_t WS_PP = WS_R;
constexpr size_t WS_LR = 984 * MiB;
constexpr int LRC = 192;
constexpr size_t WS_END = 1008 * MiB;
static_assert(WS_W + 2 * W_LAYER <= WS_HB && WS_YS + (size_t)MAXSLOT * D * 2 <= WS_END && WS_HID + (size_t)MAXSLOT * FF * 2 <= WS_YS, "ws map");

constexpr int LDS_BYTES = 150 * 1024;
constexpr int LDS_MISC = 131072;

__device__ __forceinline__ float bf2f(bf16_t b) { return __uint_as_float(((unsigned)b) << 16); }
__device__ __forceinline__ unsigned f2bf(float f) { unsigned u = __float_as_uint(f); return (u + 0x7fffu + ((u >> 16) & 1u)) >> 16; }
typedef __bf16 bf16v2_t __attribute__((ext_vector_type(2)));
__device__ __forceinline__ unsigned cvtpk(float lo, float hi) { const f32x2 f = {lo, hi}; const bf16v2_t b = __builtin_convertvector(f, bf16v2_t); return __builtin_bit_cast(unsigned, b); }
__device__ __forceinline__ unsigned pk2(float lo, float hi) { return cvtpk(lo, hi); }
__device__ __forceinline__ unsigned cvt_pk_bf16(float lo, float hi) { unsigned r; asm volatile("v_cvt_pk_bf16_f32 %0, %1, %2" : "=v"(r) : "v"(lo), "v"(hi)); return r; }
__device__ __forceinline__ float sigmoidf_(float x) { return __builtin_amdgcn_rcpf(1.0f + __expf(-x)); }
__device__ __forceinline__ float tanhf_(float x) { return 1.0f - 2.0f * __builtin_amdgcn_rcpf(1.0f + __expf(2.0f * x)); }
__device__ __forceinline__ float wave_sum(float v) {
#pragma unroll
    for (int o = 1; o < 64; o <<= 1) v += __shfl_xor(v, o);
    return v;
}
__device__ __forceinline__ float red16(float v) {
#pragma unroll
    for (int o = 1; o < 16; o <<= 1) v += __shfl_xor(v, o);
    return v;
}
__device__ __forceinline__ float red8(float v) {
#pragma unroll
    for (int o = 1; o < 8; o <<= 1) v += __shfl_xor(v, o);
    return v;
}

__device__ __forceinline__ float dpp_add(float x, const int ctrl_sel) {
    int v = __builtin_bit_cast(int, x), r;
    if (ctrl_sel == 0) r = __builtin_amdgcn_update_dpp(v, v, 0xB1, 0xf, 0xf, true);
    else if (ctrl_sel == 1) r = __builtin_amdgcn_update_dpp(v, v, 0x4E, 0xf, 0xf, true);
    else if (ctrl_sel == 2) r = __builtin_amdgcn_update_dpp(v, v, 0x141, 0xf, 0xf, true);
    else r = __builtin_amdgcn_update_dpp(v, v, 0x140, 0xf, 0xf, true);
    return x + __builtin_bit_cast(float, r);
}
__device__ __forceinline__ float sum8(float x) { x = dpp_add(x, 0); x = dpp_add(x, 1); x = dpp_add(x, 2); return x; }
__device__ __forceinline__ float sum16(float x) { x = sum8(x); x = dpp_add(x, 3); return x; }


#ifndef PG8_SP2_MASK
#define PG8_SP2_MASK 0x2f
#endif
#ifndef PG8_SP2
#define PG8_SP2 true
#endif
namespace pg8 {
constexpr int BM = 256, BK = 64, HALF = 128, HTB = HALF * BK * 2, STAGE_BYTES = 8 * HTB, NXCD = 8, WGM = 8;
__host__ __device__ __forceinline__ int lds_byte(int r, int c) { const int st = (r >> 4) * 2 + (c >> 5), rr = r & 15, cc = c & 31, ob = rr * 64 + cc * 2; return st * 1024 + (ob ^ (((ob >> 9) & 1) << 5)); }
__host__ __device__ __forceinline__ void stage_rc(int b, int& R, int& C) { const int st = b / 1024, sb = b % 1024, swz = sb ^ (((sb >> 9) & 1) << 5); R = (st >> 1) * 16 + swz / 64; C = (st & 1) * 32 + (swz % 64) / 2; }
__host__ __device__ __forceinline__ int perm32(int rho) { const int n = rho >> 4, i = rho & 15; return 8 * (i >> 2) + 4 * n + (i & 3); }

struct Unit { int arow, brow, orow, ocol, e, mt; };

struct StaticOrder {
    static constexpr bool GATHER = false;
    int nM, nN, nwg, G, c;
    __device__ void init(int M_, int N_, int G_, int c_) { nM = M_ / BM; nN = N_ / BM; nwg = nM * nN; G = G_; c = c_; }
    __device__ bool next(int i, Unit& u) const { return at((long)i * G + c, u); }
    __device__ bool at(const long L, Unit& u) const {
        if (L >= nwg) return false;
        int wgid = (int)L; { const int q = nwg / NXCD, r = nwg % NXCD, xcd = wgid % NXCD, off = wgid / NXCD; wgid = (xcd < r ? xcd * (q + 1) : r * (q + 1) + (xcd - r) * q) + off; }
        const int nig = WGM * nN, gid = wgid / nig, fm = gid * WGM, gsz = (nM - fm) < WGM ? (nM - fm) : WGM;
        const int pm = fm + ((wgid % nig) % gsz), pn = (wgid % nig) / gsz;
        u.arow = pm * BM; u.brow = pn * BM; u.orow = pm * BM; u.ocol = pn * BM; u.e = 0; u.mt = pm; return true;
    }
    __device__ __forceinline__ unsigned tok(const Unit&, int) const { return 0u; }
};

struct SubsetOrder {
    static constexpr bool GATHER = false;
    StaticOrder B; int first, stride, count, limit;
    __device__ bool next(int i, Unit& u) const { if (i >= count) return false; const int L = first + i * stride; if (L >= limit) return false; return B.at(L, u); }
    __device__ __forceinline__ unsigned tok(const Unit&, int) const { return 0u; }
};

template <bool GATHER_> struct GroupedOrder {
    static constexpr bool GATHER = GATHER_;
    const LAS int* tprefix;
    const LAS int* pstart;
    const int* cnt;
    const int* tlist;
    int brows;
    int G, c;
    __device__ bool next(int i, Unit& u) const {
        const int q = c & 7, j = c >> 3;
        const int U = q * 32 + j;
        const int mtg = i * 64 + (U >> 2), nt = U & 3;
        const int total = tprefix[32];
        if (mtg >= total) return false;
        int e = 0;
#pragma unroll 1
        for (int s = 16; s >= 1; s >>= 1) { if (tprefix[e + s] <= mtg) e += s; }
        const int mt = mtg - tprefix[e];
        u.e = e; u.mt = mt; u.arow = pstart[e] + mt * BM; u.orow = u.arow; u.brow = e * brows + nt * BM; u.ocol = nt * BM; return true;
    }
    __device__ __forceinline__ unsigned tok(const Unit& u, int r) const {
        const int pos = u.mt * BM + r;
        const unsigned t = (unsigned)tlist[u.e * LCAP + pos]; const int c = cnt[u.e];
        return pos < c ? t : 0u;
    }
};

template <class Epi, class Sched>
__device__ __forceinline__ void gemm_phase(LAS unsigned char* lds, const bf16_t* Ag, const bf16_t* Btg, const int K, const Sched& S, const Epi& E) {
    int tid_ = threadIdx.x; asm volatile("" : "+v"(tid_));
    const int tid = tid_, wid = __builtin_amdgcn_readfirstlane(tid >> 6), lane = tid & 63, wr = wid >> 2, wc = wid & 3, fr = lane & 15, fq = lane >> 4;
    constexpr bool SP2 = PG8_SP2 && Epi::SP2;
    const int nt = K / BK;
    unsigned voffA[2], voffB[2]; int Rr[2], Cc[2];
#pragma unroll
    for (int i = 0; i < 2; ++i) { int R, C; stage_rc(tid * 16 + i * 8192, R, C); Rr[i] = R; Cc[i] = C; const int Rb = Epi::PERM ? ((R & ~31) + perm32(R & 31)) : R;
        voffA[i] = (unsigned)(R * K + C) * 2u; voffB[i] = (unsigned)(Rb * K + C) * 2u; }
    const size_t kstep = (size_t)(BK * 2);
    const size_t hstep = (size_t)HALF * K * 2;
    const size_t rowb = (size_t)K * 2;
    const unsigned ldsw = (unsigned)wid * 1024u;
    const int aoff = lds_byte(wr * 64 + fr, fq * 8), boff = lds_byte(wc * 32 + fr, fq * 8);
    unsigned gc[2][2], gn[2][2];
#pragma unroll
    for (int h = 0; h < 2; ++h)
#pragma unroll
        for (int i = 0; i < 2; ++i) { gc[h][i] = 0u; gn[h][i] = 0u; }
#define PG8_SA(b, h) (((b) * 2 + (h)) * HTB)
#define PG8_SB(b, h) ((4 + (b) * 2 + (h)) * HTB)
#define PG8_GLDS(src, bufoff, i) __builtin_amdgcn_global_load_lds((const unsigned*)(src), (LAS unsigned*)(lds + (bufoff) + ldsw + (i) * 8192), 16, 0, 0)
#define PG8_STAGE_B(bufoff, gbase) do { _Pragma("unroll") for (int _i = 0; _i < 2; ++_i) PG8_GLDS((const char*)(gbase) + voffB[_i], bufoff, _i); } while (0)
#define PG8_STAGE_A(bufoff, gbase, h, usenext) do { _Pragma("unroll") for (int _i = 0; _i < 2; ++_i) { \
        if constexpr (Sched::GATHER) { const unsigned _o = (usenext) ? gn[h][_i] : gc[h][_i]; PG8_GLDS((const char*)(gbase) + _o, bufoff, _i); } \
        else { PG8_GLDS((const char*)(gbase) + (h) * hstep + voffA[_i], bufoff, _i); } } } while (0)
#define PG8_LDA(dst, b, h) do { _Pragma("unroll") for (int m = 0; m < 4; ++m) _Pragma("unroll") for (int k = 0; k < 2; ++k) dst[m][k] = *(const LAS bf16x8*)(lds + PG8_SA(b, h) + aoff + m * 2048 + k * 1024); } while (0)
#define PG8_LDB(dst, b, h) do { _Pragma("unroll") for (int n = 0; n < 2; ++n) _Pragma("unroll") for (int k = 0; k < 2; ++k) dst[n][k] = *(const LAS bf16x8*)(lds + PG8_SB(b, h) + boff + n * 2048 + k * 1024); } while (0)
#define PG8_MMA(ai, bj, At, Bt) do { __builtin_amdgcn_s_setprio(1); _Pragma("unroll") for (int m = 0; m < 4; ++m) _Pragma("unroll") for (int n = 0; n < 2; ++n) _Pragma("unroll") for (int k = 0; k < 2; ++k) \
        acc[ai][bj][m][n] = __builtin_amdgcn_mfma_f32_16x16x32_bf16(Bt[n][k], At[m][k], acc[ai][bj][m][n], 0, 0, 0); __builtin_amdgcn_s_setprio(0); } while (0)
#define PG8_WAIT_V(n) asm volatile("s_waitcnt vmcnt(" #n ")" ::: "memory")
#define PG8_WAIT_L(n) asm volatile("s_waitcnt lgkmcnt(" #n ")" ::: "memory")
#define PG8_BAR __builtin_amdgcn_s_barrier()
#define PG8_SCHED __builtin_amdgcn_sched_barrier(0)
    Unit cur, nxt; int ui = 0;
    if (!S.next(0, cur)) return;
    f32x4 acc[2][2][4][2];
#pragma unroll
    for (int a = 0; a < 2; ++a)
#pragma unroll
        for (int b = 0; b < 2; ++b)
#pragma unroll
            for (int m = 0; m < 4; ++m)
#pragma unroll
                for (int n = 0; n < 2; ++n) acc[a][b][m][n] = (f32x4){0.f, 0.f, 0.f, 0.f};
    bf16x8 At[4][2], B0[2][2], B1[2][2];
    const char* cA; const char* cB = (const char*)Btg + (size_t)cur.brow * rowb;
    if constexpr (Sched::GATHER) {
        cA = (const char*)Ag;
#pragma unroll
        for (int h = 0; h < 2; ++h)
#pragma unroll
            for (int i = 0; i < 2; ++i) gc[h][i] = S.tok(cur, h * HALF + Rr[i]) * (unsigned)rowb + (unsigned)Cc[i] * 2u;
    } else cA = (const char*)Ag + (size_t)cur.arow * rowb;
    if constexpr (SP2) {
        PG8_STAGE_B(PG8_SB(0, 0), cB); PG8_STAGE_B(PG8_SB(0, 1), cB + hstep); PG8_STAGE_A(PG8_SA(0, 0), cA, 0, false); PG8_STAGE_A(PG8_SA(0, 1), cA, 1, false);
        if (wr == 1) PG8_BAR;
        PG8_WAIT_V(2); PG8_BAR;
        PG8_STAGE_B(PG8_SB(1, 0), cB + kstep); PG8_STAGE_A(PG8_SA(1, 0), cA + kstep, 0, false); PG8_STAGE_B(PG8_SB(1, 1), cB + hstep + kstep);
        PG8_WAIT_V(6); PG8_BAR;
    } else {
        PG8_STAGE_B(PG8_SB(0, 0), cB); PG8_STAGE_A(PG8_SA(0, 0), cA, 0, false); PG8_STAGE_B(PG8_SB(0, 1), cB + hstep); PG8_STAGE_A(PG8_SA(0, 1), cA, 1, false);
        if (wr == 1) PG8_BAR;
        PG8_WAIT_V(4); PG8_BAR;
        PG8_STAGE_B(PG8_SB(1, 0), cB + kstep); PG8_STAGE_A(PG8_SA(1, 0), cA + kstep, 0, false); PG8_STAGE_B(PG8_SB(1, 1), cB + hstep + kstep);
        PG8_WAIT_V(6); PG8_BAR;
    }
    for (;;) {
        const bool has_next = S.next(ui + 1, nxt);
        const char* nA; const char* nB = has_next ? (const char*)Btg + (size_t)nxt.brow * rowb : cB;
        if constexpr (Sched::GATHER) {
            nA = cA;
#pragma unroll
            for (int h = 0; h < 2; ++h)
#pragma unroll
                for (int i = 0; i < 2; ++i) gn[h][i] = has_next ? (S.tok(nxt, h * HALF + Rr[i]) * (unsigned)rowb + (unsigned)Cc[i] * 2u) : gc[h][i];
        } else nA = has_next ? (const char*)Ag + (size_t)nxt.arow * rowb : cA;
        for (int t = 0; t < nt; t += 2) {
            const bool last = (t == nt - 2);
            const char* a1 = cA + (size_t)(t + 1) * kstep;
            const char* a2 = last ? nA : cA + (size_t)(t + 2) * kstep; const char* b2 = last ? nB : cB + (size_t)(t + 2) * kstep;
            const char* a3 = a2 + kstep; const char* b3 = b2 + kstep;
            if constexpr (SP2) {
            PG8_LDB(B0, 0, 0); PG8_LDB(B1, 0, 1); PG8_SCHED; PG8_LDA(At, 0, 0); PG8_STAGE_A(PG8_SA(1, 1), a1, 1, false);
            PG8_WAIT_V(8); PG8_WAIT_L(0); PG8_BAR; PG8_MMA(0, 0, At, B0); PG8_MMA(0, 1, At, B1); PG8_BAR; PG8_SCHED;
            PG8_LDA(At, 0, 1); PG8_STAGE_B(PG8_SB(0, 0), b2); PG8_STAGE_B(PG8_SB(0, 1), b2 + hstep); PG8_STAGE_A(PG8_SA(0, 0), a2, 0, last);
            PG8_WAIT_V(8); PG8_WAIT_L(0); PG8_BAR; PG8_MMA(1, 0, At, B0); PG8_MMA(1, 1, At, B1); PG8_BAR; PG8_SCHED;
            PG8_LDB(B0, 1, 0); PG8_LDB(B1, 1, 1); PG8_SCHED; PG8_LDA(At, 1, 0); PG8_STAGE_A(PG8_SA(0, 1), a2, 1, last);
            PG8_WAIT_V(8); PG8_WAIT_L(0); PG8_BAR; PG8_MMA(0, 0, At, B0); PG8_MMA(0, 1, At, B1); PG8_BAR; PG8_SCHED;
            PG8_LDA(At, 1, 1); PG8_STAGE_B(PG8_SB(1, 0), b3); PG8_STAGE_B(PG8_SB(1, 1), b3 + hstep); PG8_STAGE_A(PG8_SA(1, 0), a3, 0, last);
            PG8_WAIT_V(8); PG8_WAIT_L(0); PG8_BAR; PG8_MMA(1, 0, At, B0); PG8_MMA(1, 1, At, B1); PG8_BAR; PG8_SCHED;
            } else {
            PG8_LDB(B0, 0, 0); PG8_SCHED; PG8_LDA(At, 0, 0); PG8_STAGE_A(PG8_SA(1, 1), a1, 1, false);
            PG8_WAIT_L(8); PG8_BAR; PG8_WAIT_L(0); PG8_MMA(0, 0, At, B0); PG8_BAR; PG8_SCHED;
            PG8_LDB(B1, 0, 1); PG8_STAGE_B(PG8_SB(0, 0), b2);
            PG8_BAR; PG8_WAIT_L(0); PG8_MMA(0, 1, At, B1); PG8_BAR;
            PG8_LDA(At, 0, 1); PG8_STAGE_A(PG8_SA(0, 0), a2, 0, last);
            PG8_BAR; PG8_WAIT_L(0); PG8_MMA(1, 0, At, B0); PG8_BAR; PG8_SCHED;
            PG8_STAGE_B(PG8_SB(0, 1), b2 + hstep);
            PG8_WAIT_V(6); PG8_BAR; PG8_MMA(1, 1, At, B1); PG8_BAR;
            PG8_LDB(B0, 1, 0); PG8_SCHED; PG8_LDA(At, 1, 0); PG8_STAGE_A(PG8_SA(0, 1), a2, 1, last);
            PG8_WAIT_L(8); PG8_BAR; PG8_WAIT_L(0); PG8_MMA(0, 0, At, B0); PG8_BAR; PG8_SCHED;
            PG8_LDB(B1, 1, 1); PG8_STAGE_B(PG8_SB(1, 0), b3);
            PG8_BAR; PG8_WAIT_L(0); PG8_MMA(0, 1, At, B1); PG8_BAR;
            PG8_LDA(At, 1, 1); PG8_STAGE_A(PG8_SA(1, 0), a3, 0, last);
            PG8_BAR; PG8_WAIT_L(0); PG8_MMA(1, 0, At, B0); PG8_BAR; PG8_SCHED;
            PG8_STAGE_B(PG8_SB(1, 1), b3 + hstep);
            PG8_WAIT_V(6); PG8_BAR; PG8_MMA(1, 1, At, B1); PG8_BAR;
            }
        }
        if (wr == 0) PG8_BAR;
        E(acc, cur, S, wr, wc, fr, fq);
        if (!has_next) break;
#pragma unroll
        for (int a = 0; a < 2; ++a)
#pragma unroll
            for (int b = 0; b < 2; ++b)
#pragma unroll
                for (int m = 0; m < 4; ++m)
#pragma unroll
                    for (int n = 0; n < 2; ++n) acc[a][b][m][n] = (f32x4){0.f, 0.f, 0.f, 0.f};
        cur = nxt; cA = nA; cB = nB; ++ui;
        if (wr == 1) PG8_BAR;
        if constexpr (Sched::GATHER) {
#pragma unroll
            for (int h = 0; h < 2; ++h)
#pragma unroll
                for (int i = 0; i < 2; ++i) gc[h][i] = gn[h][i];
        }
    }
    PG8_WAIT_V(0);
    PG8_BAR;
#undef PG8_SA
#undef PG8_SB
#undef PG8_GLDS
#undef PG8_STAGE_A
#undef PG8_STAGE_B
#undef PG8_LDA
#undef PG8_LDB
#undef PG8_MMA
#undef PG8_WAIT_V
#undef PG8_WAIT_L
#undef PG8_BAR
#undef PG8_SCHED
}


struct EpiZ {
    static constexpr bool PERM = true;
    static constexpr bool SP2 = ((PG8_SP2_MASK) >> 0) & 1;
    bf16_t* Z; const float* part; int npart;
    template <class S_> __device__ __forceinline__ void operator()(const f32x4 (&acc)[2][2][4][2], const Unit& u, const S_&, int wr, int wc, int fr, int fq) const {
        const int row0 = u.orow + wr * 64 + fr, col0 = u.ocol + wc * 32 + 8 * fq;
        float rs8[8];
#pragma unroll
        for (int r = 0; r < 8; ++r) { const int row = row0 + (r >> 2) * HALF + (r & 3) * 16;
            const f32x4* pp4 = (const f32x4*)(part + (size_t)row * NPART); const f32x4 p0 = pp4[0], p1 = pp4[1], p2 = pp4[2], p3 = pp4[3];
            const float ss = ((p0[0] + p0[1]) + (p0[2] + p0[3])) + ((p1[0] + p1[1]) + (p1[2] + p1[3])) + ((p2[0] + p2[1]) + (p2[2] + p2[3])) + ((p3[0] + p3[1]) + (p3[2] + p3[3]));
            rs8[r] = rsqrtf(ss * (1.0f / D) + 1e-6f); }
        if (u.ocol < 2 * CONVC) {
            const int ch0 = (u.ocol >> 8) * 128 + wc * 32 + 8 * fq;
#pragma unroll
            for (int ai = 0; ai < 2; ++ai)
#pragma unroll
                for (int m = 0; m < 4; ++m) {
                    const int row = row0 + ai * HALF + m * 16; const float rs = rs8[ai * 4 + m];
                    const f32x4 v0 = acc[ai][0][m][0] * rs, v1 = acc[ai][0][m][1] * rs, g0 = acc[ai][1][m][0] * rs, g1 = acc[ai][1][m][1] * rs;
                    float o[8];
#pragma unroll
                    for (int j = 0; j < 4; ++j) { o[j] = v0[j] * sigmoidf_(g0[j]); o[4 + j] = v1[j] * sigmoidf_(g1[j]); }
                    u32x4 w; w.x = cvt_pk_bf16(o[0], o[1]); w.y = cvt_pk_bf16(o[2], o[3]); w.z = cvt_pk_bf16(o[4], o[5]); w.w = cvt_pk_bf16(o[6], o[7]);
                    *(u32x4*)(Z + (size_t)row * ZC + ch0) = w; }
            return;
        }
#pragma unroll
        for (int ai = 0; ai < 2; ++ai)
#pragma unroll
            for (int m = 0; m < 4; ++m) {
                const int row = row0 + ai * HALF + m * 16; const float rs = rs8[ai * 4 + m];
                bf16_t* rowp = Z + (size_t)row * ZC + col0;
#pragma unroll
                for (int bj = 0; bj < 2; ++bj) { const f32x4 v0 = acc[ai][bj][m][0] * rs, v1 = acc[ai][bj][m][1] * rs;
                    u32x4 w; w.x = cvt_pk_bf16(v0[0], v0[1]); w.y = cvt_pk_bf16(v0[2], v0[3]); w.z = cvt_pk_bf16(v1[0], v1[1]); w.w = cvt_pk_bf16(v1[2], v1[3]);
                    *(u32x4*)(rowp + bj * HALF) = w; } }
    }
};
struct EpiRes {
    static constexpr bool PERM = true;
    static constexpr bool SP2 = ((PG8_SP2_MASK) >> 1) & 1;
    const float* hin32; const bf16_t* hin16; bf16_t* hb;
    template <class S_> __device__ __forceinline__ void operator()(const f32x4 (&acc)[2][2][4][2], const Unit& u, const S_&, int wr, int wc, int fr, int fq) const {
        const int row0 = u.orow + wr * 64 + fr, col0 = u.ocol + wc * 32 + 8 * fq;
        if (hin32) {
#pragma unroll
            for (int ai = 0; ai < 2; ++ai) {
                f32x4 r[4][2][2];
#pragma unroll
                for (int m = 0; m < 4; ++m)
#pragma unroll
                    for (int bj = 0; bj < 2; ++bj) { const size_t off = (size_t)(row0 + ai * HALF + m * 16) * D + col0 + bj * HALF; r[m][bj][0] = *(const f32x4*)(hin32 + off); r[m][bj][1] = *(const f32x4*)(hin32 + off + 4); }
#pragma unroll
                for (int m = 0; m < 4; ++m)
#pragma unroll
                    for (int bj = 0; bj < 2; ++bj) { const size_t off = (size_t)(row0 + ai * HALF + m * 16) * D + col0 + bj * HALF;
                        const f32x4 v0 = acc[ai][bj][m][0] + r[m][bj][0], v1 = acc[ai][bj][m][1] + r[m][bj][1];
                        u32x4 w; w.x = cvt_pk_bf16(v0[0], v0[1]); w.y = cvt_pk_bf16(v0[2], v0[3]); w.z = cvt_pk_bf16(v1[0], v1[1]); w.w = cvt_pk_bf16(v1[2], v1[3]);
                        *(u32x4*)(hb + off) = w; }
            }
        } else {
            u32x4 pw[2][4][2];
#pragma unroll
            for (int ai = 0; ai < 2; ++ai)
#pragma unroll
                for (int m = 0; m < 4; ++m)
#pragma unroll
                    for (int bj = 0; bj < 2; ++bj) pw[ai][m][bj] = *(const u32x4*)(hin16 + (size_t)(row0 + ai * HALF + m * 16) * D + col0 + bj * HALF);
#pragma unroll
            for (int ai = 0; ai < 2; ++ai)
#pragma unroll
                for (int m = 0; m < 4; ++m)
#pragma unroll
                    for (int bj = 0; bj < 2; ++bj) { const u32x4 p = pw[ai][m][bj];
                        const f32x4 r0 = (f32x4){__uint_as_float(p.x << 16), __uint_as_float(p.x & 0xffff0000u), __uint_as_float(p.y << 16), __uint_as_float(p.y & 0xffff0000u)};
                        const f32x4 r1 = (f32x4){__uint_as_float(p.z << 16), __uint_as_float(p.z & 0xffff0000u), __uint_as_float(p.w << 16), __uint_as_float(p.w & 0xffff0000u)};
                        const f32x4 v0 = acc[ai][bj][m][0] + r0, v1 = acc[ai][bj][m][1] + r1;
                        u32x4 w; w.x = cvt_pk_bf16(v0[0], v0[1]); w.y = cvt_pk_bf16(v0[2], v0[3]); w.z = cvt_pk_bf16(v1[0], v1[1]); w.w = cvt_pk_bf16(v1[2], v1[3]);
                        *(u32x4*)(hb + (size_t)(row0 + ai * HALF + m * 16) * D + col0 + bj * HALF) = w; }
        }
    }
};
struct EpiGU {
    static constexpr bool PERM = true;
    static constexpr bool SP2 = ((PG8_SP2_MASK) >> 2) & 1;
    bf16_t* hid; const float* rlist;
    template <class S_> __device__ __forceinline__ void operator()(const f32x4 (&acc)[2][2][4][2], const Unit& u, const S_& S, int wr, int wc, int fr, int fq) const {
        const int rl0 = wr * 64 + fr, col0 = (u.ocol >> 1) + wc * 32 + 8 * fq;
        float rs8[8];
#pragma unroll
        for (int r = 0; r < 8; ++r) rs8[r] = rlist[u.e * LCAP + u.mt * BM + rl0 + (r >> 2) * HALF + (r & 3) * 16];
#pragma unroll
        for (int ai = 0; ai < 2; ++ai)
#pragma unroll
            for (int m = 0; m < 4; ++m) {
                const int rl = rl0 + ai * HALF + m * 16;
                const float rs = rs8[ai * 4 + m];
                const f32x4 g0 = acc[ai][0][m][0] * rs, g1 = acc[ai][0][m][1] * rs, u0 = acc[ai][1][m][0] * rs, u1 = acc[ai][1][m][1] * rs;
                float o[8];
#pragma unroll
                for (int j = 0; j < 4; ++j) { o[j] = g0[j] * sigmoidf_(g0[j]) * u0[j]; o[4 + j] = g1[j] * sigmoidf_(g1[j]) * u1[j]; }
                u32x4 w; w.x = cvt_pk_bf16(o[0], o[1]); w.y = cvt_pk_bf16(o[2], o[3]); w.z = cvt_pk_bf16(o[4], o[5]); w.w = cvt_pk_bf16(o[6], o[7]);
                *(u32x4*)(hid + (size_t)(u.orow + rl) * FF + col0) = w; }
    }
};
struct EpiDown {
    static constexpr bool PERM = true;
    static constexpr bool SP2 = ((PG8_SP2_MASK) >> 3) & 1;
    bf16_t* ys; const float* glist; const int* cnt;
    template <class S_> __device__ __forceinline__ void operator()(const f32x4 (&acc)[2][2][4][2], const Unit& u, const S_&, int wr, int wc, int fr, int fq) const {
        const int rl0 = wr * 64 + fr, col0 = u.ocol + wc * 32 + 8 * fq; const int ce = cnt[u.e];
        float g8[8];
#pragma unroll
        for (int r = 0; r < 8; ++r) { const int pos = u.mt * BM + rl0 + (r >> 2) * HALF + (r & 3) * 16; g8[r] = glist[u.e * LCAP + pos]; if (pos >= ce) g8[r] = 0.f; }
#pragma unroll
        for (int ai = 0; ai < 2; ++ai)
#pragma unroll
            for (int m = 0; m < 4; ++m) {
                const int rl = rl0 + ai * HALF + m * 16;
                const float g = g8[ai * 4 + m];
                bf16_t* rowp = ys + (size_t)(u.orow + rl) * D + col0;
#pragma unroll
                for (int bj = 0; bj < 2; ++bj) { const f32x4 v0 = acc[ai][bj][m][0] * g, v1 = acc[ai][bj][m][1] * g;
                    u32x4 w; w.x = cvt_pk_bf16(v0[0], v0[1]); w.y = cvt_pk_bf16(v0[2], v0[3]); w.z = cvt_pk_bf16(v1[0], v1[1]); w.w = cvt_pk_bf16(v1[2], v1[3]);
                    *(u32x4*)(rowp + bj * HALF) = w; } }
    }
};
struct EpiPP {
    static constexpr bool PERM = true;
    static constexpr bool SP2 = ((PG8_SP2_MASK) >> 4) & 1;
    bf16_t* O;
    template <class S_> __device__ __forceinline__ void operator()(const f32x4 (&acc)[2][2][4][2], const Unit& u, const S_&, int wr, int wc, int fr, int fq) const {
        const int row0 = u.orow + wr * 64 + fr, col0 = u.ocol + wc * 32 + 8 * fq;
#pragma unroll
        for (int ai = 0; ai < 2; ++ai)
#pragma unroll
            for (int m = 0; m < 4; ++m) { bf16_t* rowp = O + (size_t)(row0 + ai * HALF + m * 16) * D + col0;
#pragma unroll
                for (int bj = 0; bj < 2; ++bj) { const f32x4 v0 = acc[ai][bj][m][0], v1 = acc[ai][bj][m][1];
                    u32x4 w; w.x = cvt_pk_bf16(v0[0], v0[1]); w.y = cvt_pk_bf16(v0[2], v0[3]); w.z = cvt_pk_bf16(v1[0], v1[1]); w.w = cvt_pk_bf16(v1[2], v1[3]);
                    *(u32x4*)(rowp + bj * HALF) = w; } }
    }
};
struct EpiPle {
    static constexpr bool PERM = true;
    static constexpr bool SP2 = ((PG8_SP2_MASK) >> 5) & 1;
    const bf16_t* hb; bf16_t* dst; const bf16_t* pp; const float* rsp; float* part;
    template <class S_> __device__ __forceinline__ void operator()(const f32x4 (&acc)[2][2][4][2], const Unit& u, const S_&, int wr, int wc, int fr, int fq) const {
        const int row0 = u.orow + wr * 64 + fr, col0 = u.ocol + wc * 32 + 8 * fq;
        float* pout = part + ((u.ocol >> 8) * 4 + wc);
        float rs8[8];
#pragma unroll
        for (int r = 0; r < 8; ++r) rs8[r] = rsp[row0 + (r >> 2) * HALF + (r & 3) * 16];
#pragma unroll
        for (int ai = 0; ai < 2; ++ai) {
            u32x4 hw[4][2], pw[4][2];
#pragma unroll
            for (int m = 0; m < 4; ++m)
#pragma unroll
                for (int bj = 0; bj < 2; ++bj) { const size_t off = (size_t)(row0 + ai * HALF + m * 16) * D + col0 + bj * HALF; hw[m][bj] = *(const u32x4*)(hb + off); pw[m][bj] = *(const u32x4*)(pp + off); }
#pragma unroll
            for (int m = 0; m < 4; ++m) {
                const int row = row0 + ai * HALF + m * 16; const float rs = rs8[ai * 4 + m]; float ss = 0.f;
#pragma unroll
                for (int bj = 0; bj < 2; ++bj) {
                    float hv[8], pv[8], o[8];
#pragma unroll
                    for (int j = 0; j < 4; ++j) { hv[2 * j] = __uint_as_float(hw[m][bj][j] << 16); hv[2 * j + 1] = __uint_as_float(hw[m][bj][j] & 0xffff0000u); pv[2 * j] = __uint_as_float(pw[m][bj][j] << 16); pv[2 * j + 1] = __uint_as_float(pw[m][bj][j] & 0xffff0000u); }
#pragma unroll
                    for (int j = 0; j < 4; ++j) { o[j] = hv[j] + sigmoidf_(acc[ai][bj][m][0][j] * rs) * pv[j]; o[4 + j] = hv[4 + j] + sigmoidf_(acc[ai][bj][m][1][j] * rs) * pv[4 + j]; }
                    u32x4 w; w.x = cvt_pk_bf16(o[0], o[1]); w.y = cvt_pk_bf16(o[2], o[3]); w.z = cvt_pk_bf16(o[4], o[5]); w.w = cvt_pk_bf16(o[6], o[7]);
#pragma unroll
                    for (int j = 0; j < 4; ++j) { const float a0 = __uint_as_float(w[j] << 16), a1 = __uint_as_float(w[j] & 0xffff0000u); ss += a0 * a0 + a1 * a1; }
                    *(u32x4*)(dst + (size_t)row * D + col0 + bj * HALF) = w; }
                ss += __shfl_xor(ss, 16); ss += __shfl_xor(ss, 32);
                if (fq == 0) pout[(size_t)row * NPART] = ss; }
        }
    }
};
}

struct Params {
    const float* in[35];
    float* out;
    unsigned char* ws;
    int ph_lo, ph_hi;
};
enum { I_X = 0, I_P, I_MIXN, I_WIN, I_CONVW, I_CONVB, I_CLNG, I_CLNB, I_MU, I_W0, I_W2, I_A0, I_A2, I_G2, I_KK, I_KA, I_RK, I_GNG, I_GNB, I_V0, I_V1, I_V2,
       I_WOUT, I_FFNN, I_RGW, I_RGB, I_REW, I_REB, I_EWG, I_EWU, I_EWD, I_PLEN, I_PLEG, I_PLEP, I_FINN };

typedef const Params __attribute__((address_space(4)))* KP;
struct Ctx {
    LAS unsigned char* lds;
    int tid, lane, wave, vcu, G, bid;
};

__device__ __forceinline__ Ctx fresh(const Ctx& C0) { Ctx C = C0; int t = threadIdx.x; asm volatile("" : "+v"(t)); C.tid = t; C.lane = t & 63; C.wave = __builtin_amdgcn_readfirstlane(t >> 6);
    int bx = blockIdx.x; asm volatile("" : "+s"(bx)); C.bid = bx; C.vcu = (C.G % 8 == 0) ? (bx % 8) * (C.G / 8) + bx / 8 : bx; return C; }

struct TrItem { const float* src; const float* gain; bf16_t* dst; int ldw, ldt, k0, n0, drow; };
__device__ __forceinline__ void tr_load(const TrItem& t, int lane, float (&v)[32]) {
    const float* src = t.src + (size_t)(t.k0 + (lane >> 5)) * t.ldw + t.n0 + (lane & 31);
#pragma unroll
    for (int i = 0; i < 32; ++i) v[i] = src[(size_t)(2 * i) * t.ldw];
}
__device__ __forceinline__ void tr_store(const TrItem& t, const float (&v)[32], LAS float* scr, int lane) {
    const int c = lane & 7;
    f32x4 g0 = (f32x4){1.f, 1.f, 1.f, 1.f}, g1 = g0;
    if (t.gain) { g0 = *(const f32x4*)(t.gain + t.k0 + 8 * c); g1 = *(const f32x4*)(t.gain + t.k0 + 8 * c + 4); }
#pragma unroll
    for (int i = 0; i < 32; ++i) scr[(2 * i + (lane >> 5)) * 33 + (lane & 31)] = v[i];
    asm volatile("s_waitcnt lgkmcnt(0)" ::: "memory");
#pragma unroll
    for (int j = 0; j < 4; ++j) { const int n = (lane >> 3) + 8 * j; const LAS float* s = scr + (8 * c) * 33 + n;
        u32x4 o; o.x = pk2(s[0 * 33] * g0[0], s[1 * 33] * g0[1]); o.y = pk2(s[2 * 33] * g0[2], s[3 * 33] * g0[3]); o.z = pk2(s[4 * 33] * g1[0], s[5 * 33] * g1[1]); o.w = pk2(s[6 * 33] * g1[2], s[7 * 33] * g1[3]);
        *(u32x4*)(t.dst + (size_t)(t.drow + n) * t.ldt + t.k0 + 8 * c) = o; }
    asm volatile("s_waitcnt lgkmcnt(0)" ::: "memory");
}

__device__ __forceinline__ void phase_prep(KP P, const Ctx& C0, unsigned char* wsb, const int part) {
    const Ctx C = fresh(C0);
    LAS float* scr = (LAS float*)(C.lds + C.wave * 16384);
    const int gw = C.vcu * 8 + C.wave, NGW = C.G * 8;
    const int lane = C.lane;
    constexpr int IT_IN = 16 * 85, IT_OUT = 16 * 32, IT_GU = 2 * NE * 16 * 16, IT_D = NE * 8 * 32, IT_PG = 16 * 32, IT_PP = 4 * 32;
    constexpr int IT_LAYER = IT_IN + IT_OUT + IT_GU + IT_D + IT_PG + IT_PP;
    if (part == 0) {
        auto decode = [&](int it) -> TrItem {
            TrItem t; t.gain = nullptr;
            const int l = it / IT_LAYER; int r = it % IT_LAYER;
            unsigned char* wl = wsb + WS_W + (size_t)l * W_LAYER;
            if (r < IT_IN) { const int kb = r / 85, nb = r % 85;
                t.src = P->in[I_WIN] + (size_t)l * D * IN_COLS; t.ldw = IN_COLS; t.k0 = kb * 64; t.n0 = nb * 32; t.gain = P->in[I_MIXN] + l * D; t.dst = (bf16_t*)(wl + WO_IN); t.ldt = D;
                t.drow = (t.n0 < 2 * CONVC) ? (((t.n0 & (CONVC - 1)) >> 7) * 256 + (t.n0 >= CONVC ? 128 : 0) + (t.n0 & 127)) : t.n0;
            } else if (r < IT_IN + IT_OUT) { r -= IT_IN; const int kb = r / 32, nb = r % 32;
                t.src = P->in[I_WOUT] + (size_t)l * D * D; t.ldw = D; t.k0 = kb * 64; t.n0 = nb * 32; t.dst = (bf16_t*)(wl + WO_OUT); t.ldt = D; t.drow = t.n0;
            } else if (r < IT_IN + IT_OUT + IT_GU) { r -= IT_IN + IT_OUT; const int half = r / (NE * 256), r2 = r % (NE * 256), e = r2 / 256, kb = (r2 % 256) / 16, nb = r2 % 16;
                t.src = (half ? P->in[I_EWU] : P->in[I_EWG]) + ((size_t)l * NE + e) * D * FF; t.ldw = FF; t.k0 = kb * 64; t.n0 = nb * 32; t.gain = P->in[I_FFNN] + l * D; t.dst = (bf16_t*)(wl + WO_GU); t.ldt = D;
                t.drow = e * 1024 + (t.n0 >> 7) * 256 + half * 128 + (t.n0 & 127);
            } else if (r < IT_IN + IT_OUT + IT_GU + IT_D) { r -= IT_IN + IT_OUT + IT_GU; const int e = r / 256, kb = (r % 256) / 32, nb = r % 32;
                t.src = P->in[I_EWD] + ((size_t)l * NE + e) * FF * D; t.ldw = D; t.k0 = kb * 64; t.n0 = nb * 32; t.dst = (bf16_t*)(wl + WO_D); t.ldt = FF; t.drow = e * 1024 + t.n0;
            } else if (r < IT_IN + IT_OUT + IT_GU + IT_D + IT_PG) { r -= IT_IN + IT_OUT + IT_GU + IT_D; const int kb = r / 32, nb = r % 32;
                t.src = P->in[I_PLEG] + (size_t)l * D * D; t.ldw = D; t.k0 = kb * 64; t.n0 = nb * 32; t.gain = P->in[I_PLEN] + l * D; t.dst = (bf16_t*)(wl + WO_PG); t.ldt = D; t.drow = t.n0;
            } else { r -= IT_IN + IT_OUT + IT_GU + IT_D + IT_PG; const int kb = r / 32, nb = r % 32;
                t.src = P->in[I_PLEP] + (size_t)l * PLE * D; t.ldw = D; t.k0 = kb * 64; t.n0 = nb * 32; t.dst = (bf16_t*)(wl + WO_PP); t.ldt = PLE; t.drow = t.n0; }
            return t; };
        unsigned* ctr = (unsigned*)(wsb + WS_CTL) + 2048;
        auto fetch8 = [&]() -> int { unsigned v = 0u; if (lane == 0) v = atomicAdd(ctr, 8u); return (int)__builtin_amdgcn_readfirstlane(v); };
        int cb = fetch8(), nb = fetch8(), off = 0;
        if (cb < DEPTH * IT_LAYER) {
            TrItem cur = decode(cb); float v[32]; tr_load(cur, lane, v);
            for (;;) {
                const int nx = (off + 1 < 8) ? cb + off + 1 : nb; const bool has = nx < DEPTH * IT_LAYER;
                TrItem nxt = cur; float vn[32];
                if (has) { nxt = decode(nx); tr_load(nxt, lane, vn); }
                tr_store(cur, v, scr, lane);
                if (!has) break;
                if (off + 1 < 8) ++off; else { cb = nb; off = 0; nb = fetch8(); }
                cur = nxt;
#pragma unroll
                for (int i = 0; i < 32; ++i) v[i] = vn[i];
            }
        }
    }
    if (part == 1) {
        const int gt = gw * 64 + lane, NGT = NGW * 64;
        bf16_t* w0 = (bf16_t*)(wsb + WS_W + WO_IN); bf16_t* w1 = (bf16_t*)(wsb + WS_W + W_LAYER + WO_IN);
        for (int i = gt; i < 96 * D / 8; i += NGT) *(u32x4*)(w0 + (size_t)IN_COLS * D + (size_t)i * 8) = (u32x4){0u, 0u, 0u, 0u};
        for (int i = gt; i < 32 * D / 8; i += NGT) *(u32x4*)(w1 + (size_t)(ZC_EB + 32) * D + (size_t)i * 8) = (u32x4){0u, 0u, 0u, 0u};
        const float* win1 = P->in[I_WIN] + (size_t)D * IN_COLS; const float* mu1 = P->in[I_MU] + RWKV_IN + 2 * RC; const float* v1 = P->in[I_V1]; const float* g1 = P->in[I_MIXN] + D;
        for (int k = gw; k < D; k += NGW) {
            const float* wr_ = win1 + (size_t)k * IN_COLS + ZC_V; float s = 0.f; const int j = lane & 31; const bool hi = lane >= 32;
            float s2 = 0.f, s3 = 0.f, s4 = 0.f;
#pragma unroll 8
            for (int c = 0; c < RC; c += 4) { const f32x4 m4 = *(const f32x4*)(mu1 + c), w4 = *(const f32x4*)(wr_ + c);
                s += w4[0] * (hi ? m4[0] : 1.0f - m4[0]) * v1[(c + 0) * LV + j]; s2 += w4[1] * (hi ? m4[1] : 1.0f - m4[1]) * v1[(c + 1) * LV + j];
                s3 += w4[2] * (hi ? m4[2] : 1.0f - m4[2]) * v1[(c + 2) * LV + j]; s4 += w4[3] * (hi ? m4[3] : 1.0f - m4[3]) * v1[(c + 3) * LV + j]; }
            s = (s + s2) + (s3 + s4);
            w1[(size_t)(ZC_EA + lane) * D + k] = (bf16_t)f2bf(s * g1[k]);
        }
        bf16_t* wrt = (bf16_t*)(wsb + WS_WR);
        for (int i = gt; i < DEPTH * 48 * D; i += NGT) { const int l = i / (48 * D), j = (i / D) % 48, k = i % D; float v = 0.f;
            if (j < NG) v = P->in[I_RGW][((size_t)l * D + k) * NG + j]; else if (j < NRT) { const int g = (j - NG) / EPG, e = (j - NG) % EPG; v = P->in[I_REW][(((size_t)l * NG + g) * D + k) * EPG + e]; }
            v *= P->in[I_FFNN][l * D + k];
            const unsigned hi = f2bf(v); const float lo = v - __uint_as_float(hi << 16);
            wrt[((size_t)(l * 2 + 0) * 48 + j) * D + k] = (bf16_t)hi; wrt[((size_t)(l * 2 + 1) * 48 + j) * D + k] = (bf16_t)f2bf(lo); }
        const f32x4* p4 = (const f32x4*)P->in[I_P]; u32x2* pb = (u32x2*)(wsb + WS_PB);
        static_assert(((size_t)DEPTH * M * PLE / 4) % (8 * 256 * 512) == 0, "p conversion tiling");
        for (size_t i = gt; i < (size_t)DEPTH * M * PLE / 4; i += (size_t)8 * NGT) { f32x4 v[8];
#pragma unroll
            for (int j = 0; j < 8; ++j) v[j] = p4[i + (size_t)j * NGT];
#pragma unroll
            for (int j = 0; j < 8; ++j) { u32x2 w; w.x = pk2(v[j][0], v[j][1]); w.y = pk2(v[j][2], v[j][3]); pb[i + (size_t)j * NGT] = w; } }
    }
    if (part == 2) {
        bf16_t* hb = (bf16_t*)(wsb + WS_HB); float* part = (float*)(wsb + WS_PART);
        for (int m0 = gw; m0 < M; m0 += 4 * NGW) {
            f32x4 xv[4][4];
#pragma unroll
            for (int q = 0; q < 4; ++q) { const f32x4* xr = (const f32x4*)(P->in[I_X] + (size_t)(m0 + q * NGW) * D) + lane;
#pragma unroll
                for (int j = 0; j < 4; ++j) xv[q][j] = xr[64 * j]; }
#pragma unroll
            for (int q = 0; q < 4; ++q) { const int m = m0 + q * NGW; u32x2* o = (u32x2*)(hb + (size_t)m * D) + lane; float sq = 0.f;
#pragma unroll
                for (int j = 0; j < 4; ++j) { const f32x4 v = xv[q][j]; sq += (v[0] * v[0] + v[1] * v[1]) + (v[2] * v[2] + v[3] * v[3]); u32x2 w; w.x = pk2(v[0], v[1]); w.y = pk2(v[2], v[3]); o[64 * j] = w; }
                sq = sum16(sq); sq += __shfl_xor(sq, 16); sq += __shfl_xor(sq, 32);
                if (lane < NPART) part[(size_t)m * NPART + lane] = lane == 0 ? sq : 0.f; }
        }
    }
}

__device__ __forceinline__ float xsum16(float x) { float a = x, b = x; asm volatile("s_nop 1\n\tv_permlane16_swap_b32 %0, %1" : "+v"(a), "+v"(b)); return a + b; }
__device__ __forceinline__ float xsum32(float x) { float a = x, b = x; asm volatile("s_nop 1\n\tv_permlane32_swap_b32 %0, %1" : "+v"(a), "+v"(b)); return a + b; }

constexpr int CH = 32;
constexpr int AB_K = 0, AB_W = 8192, AB_R = 16384, AB_A = 24576, AB_V = 32768, AB_Y = 40960, AB_G = 49152, AB_BON = 57344, AB_SET = 57472;
constexpr int XROW = 144;
constexpr int PS_X = 2 * AB_SET;
constexpr int XS_A = 0, XS_B = 4608, XS_K = 9216, XS_R = 13824, XS_V = 18432;
constexpr int PS_GAM = PS_X + 23040;
constexpr int PS_CON = PS_GAM + 256;
constexpr int PS_FLAG = PS_CON + 2688;
constexpr int PS_END = PS_FLAG + 64;
static_assert(PS_END <= LDS_BYTES - 64, "RWKV LDS map");
constexpr int LDS_SPIN_CAP = 1 << 20;
__device__ __forceinline__ void lds_wait_ge(LAS int* cnt, int target) {
    int sp = 0; while (__hip_atomic_load(cnt, __ATOMIC_RELAXED, __HIP_MEMORY_SCOPE_WORKGROUP) < target) { __builtin_amdgcn_s_sleep(1); if (++sp > LDS_SPIN_CAP) break; }
    __builtin_amdgcn_fence(__ATOMIC_ACQUIRE, "workgroup");
}
__device__ __forceinline__ void lds_signal(LAS int* cnt, int lane) {
    __builtin_amdgcn_fence(__ATOMIC_RELEASE, "workgroup"); asm volatile("s_waitcnt lgkmcnt(0)" ::: "memory");
    if (lane == 0) __hip_atomic_fetch_add(cnt, 1, __ATOMIC_RELAXED, __HIP_MEMORY_SCOPE_WORKGROUP);
}

#ifdef TIMING
#define TP_DECL() unsigned tacc[10] = {0u, 0u, 0u, 0u, 0u, 0u, 0u, 0u, 0u, 0u}; unsigned tlast = (unsigned)__builtin_amdgcn_s_memrealtime()
#define TP_ACC(i) do { const unsigned n_ = (unsigned)__builtin_amdgcn_s_memrealtime(); tacc[i] += n_ - tlast; tlast = n_; } while (0)
#define TP_OUT(i) do { ((unsigned*)(wsb + WS_CTL))[1024 + 40 + 2 * (i)] = 0u; ((unsigned*)(wsb + WS_CTL))[1024 + 41 + 2 * (i)] = tacc[i]; } while (0)
#else
#define TP_DECL() do {} while (0)
#define TP_ACC(i) do {} while (0)
#define TP_OUT(i) do {} while (0)
#endif
__device__ __forceinline__ void phase_mix(KP P, const Ctx& C0, unsigned char* wsb, int l, const int part) {
    const Ctx C = fresh(C0);
    const bf16_t* Z = (const bf16_t*)(wsb + WS_Z); bf16_t* Y = (bf16_t*)(wsb + WS_Y); bf16_t* VF = (bf16_t*)(wsb + WS_VF);
    const int tid = C.tid, lane = C.lane, wave = C.wave;
    if (part == 0) {
    {
        constexpr int CT = 32, UT = CT + 30;
        LAS bf16_t* ut = (LAS bf16_t*)C.lds;
        LAS float* co = (LAS float*)(C.lds + 65536);
        const int cp = tid & 255, th = tid >> 8;
        f32x2 cw[CONVW];
#pragma unroll
        for (int j = 0; j < CONVW; ++j) cw[j] = *(const f32x2*)(P->in[I_CONVW] + ((size_t)l * CONVW + j) * CONVC + 2 * cp);
        const f32x2 cb = *(const f32x2*)(P->in[I_CONVB] + l * CONVC + 2 * cp);
        const f32x4 lg0 = *(const f32x4*)(P->in[I_CLNG] + l * CONVC + lane * 8), lg1 = *(const f32x4*)(P->in[I_CLNG] + l * CONVC + lane * 8 + 4);
        const f32x4 lb0 = *(const f32x4*)(P->in[I_CLNB] + l * CONVC + lane * 8), lb1 = *(const f32x4*)(P->in[I_CLNB] + l * CONVC + lane * 8 + 4);
        u32x4 gv_[8], q_lc, q_lp; unsigned q_l2c, q_l2p, q_ea, q_eb;
        const int cgL = tid & 15, tokL = tid >> 4;
        const float* muL = P->in[I_MU] + (size_t)l * RWKV_IN + 3 * RC;
        const f32x4 ml0 = *(const f32x4*)(muL + cgL * 8), ml1 = *(const f32x4*)(muL + cgL * 8 + 4); const f32x2 ml2 = *(const f32x2*)(muL + 128 + cgL * 2);
        bf16_t* LR = (bf16_t*)(wsb + WS_LR);
#define CONV_LOAD(item_) do { const int b_ = (item_) >> 6, t0_ = ((item_) & 63) * CT; _Pragma("unroll") for (int i = 0; i < 8; ++i) { const int p = tid + 512 * i; const int row = p >> 6, g8 = p & 63; const int t = t0_ - 30 + row; \
            gv_[i] = (u32x4){0u, 0u, 0u, 0u}; if (p < UT * 64 && t >= 0) gv_[i] = *(const u32x4*)(Z + (size_t)(b_ * SEQ + t) * ZC + g8 * 8); } \
            { const int tq_ = t0_ + tokL; const bf16_t* rc_ = Z + (size_t)(b_ * SEQ + tq_) * ZC; const bf16_t* rp_ = rc_ - ZC; const bool hp_ = tq_ > 0; \
              q_lc = *(const u32x4*)(rc_ + ZC_WLO + cgL * 8); q_l2c = *(const unsigned*)(rc_ + ZC_WLO + 128 + cgL * 2); q_ea = *(const unsigned*)(rc_ + ZC_EA + cgL * 2); \
              q_lp = hp_ ? *(const u32x4*)(rp_ + ZC_WLO + cgL * 8) : (u32x4){0u, 0u, 0u, 0u}; q_l2p = hp_ ? *(const unsigned*)(rp_ + ZC_WLO + 128 + cgL * 2) : 0u; q_eb = hp_ ? *(const unsigned*)(rp_ + ZC_EB + cgL * 2) : 0u; } } while (0)
#ifndef MIXSKIP_CONV
        if (C.bid < M / CT) CONV_LOAD(C.bid);
        for (int item = C.bid; item < M / CT; item += C.G) {
#else
        for (int item = C.bid; item < 0; item += C.G) {
#endif
            const int b = item >> 6, t0 = (item & 63) * CT;
#pragma unroll
            for (int i = 0; i < 8; ++i) { const int p = tid + 512 * i; const int row = p >> 6, g8 = p & 63;
                if (p < UT * 64) *(LAS u32x4*)(ut + row * CONVC + g8 * 8) = gv_[i]; }
            {
#define LERP2(dst, wc_, wp_, m0, m1) do { const float c0_ = __uint_as_float((wc_) << 16), c1_ = __uint_as_float((wc_) & 0xffff0000u), p0_ = __uint_as_float((wp_) << 16), p1_ = __uint_as_float((wp_) & 0xffff0000u); \
                    (dst)[0] = c0_ + (p0_ - c0_) * (m0); (dst)[1] = c1_ + (p1_ - c1_) * (m1); } while (0)
                float zl[8], t2[2];
                LERP2(zl + 0, q_lc.x, q_lp.x, ml0[0], ml0[1]); LERP2(zl + 2, q_lc.y, q_lp.y, ml0[2], ml0[3]); LERP2(zl + 4, q_lc.z, q_lp.z, ml1[0], ml1[1]); LERP2(zl + 6, q_lc.w, q_lp.w, ml1[2], ml1[3]);
                const float am_ = (cgL < 4) ? 2.885390082f : -1.442695041f, as_ = (cgL < 4) ? -2.0f : 1.0f, ao_ = (cgL < 4) ? 1.0f : 0.0f; const bool aid_ = (cgL >= 4) && (cgL < 8);
#pragma unroll
                for (int j = 0; j < 8; ++j) { const float y_ = as_ * __builtin_amdgcn_rcpf(1.0f + __builtin_amdgcn_exp2f(zl[j] * am_)) + ao_; zl[j] = aid_ ? zl[j] : y_; }
                u32x4 pk; pk.x = pk2(zl[0], zl[1]); pk.y = pk2(zl[2], zl[3]); pk.z = pk2(zl[4], zl[5]); pk.w = pk2(zl[6], zl[7]);
                bf16_t* lrow = LR + (size_t)(b * SEQ + t0 + tokL) * LRC;
                *(u32x4*)(lrow + cgL * 8) = pk;
                LERP2(t2, q_l2c, q_l2p, ml2[0], ml2[1]);
                *(unsigned*)(lrow + 128 + cgL * 2) = pk2(sigmoidf_(t2[0]), sigmoidf_(t2[1]));
                *(unsigned*)(lrow + 160 + cgL * 2) = pk2(__uint_as_float(q_ea << 16) + __uint_as_float(q_eb << 16), __uint_as_float(q_ea & 0xffff0000u) + __uint_as_float(q_eb & 0xffff0000u));
#undef LERP2
            }
            __syncthreads();
            if (item + C.G < M / CT) CONV_LOAD(item + C.G);
#pragma unroll 1
            for (int blk = 0; blk < 2; ++blk) { const int tb = th * 16 + blk * 8;
                f32x2 u2[38];
#pragma unroll
                for (int i = 0; i < 38; ++i) { const unsigned w = *(const LAS unsigned*)(ut + (tb + i) * CONVC + 2 * cp); u2[i] = (f32x2){__uint_as_float(w << 16), __uint_as_float(w & 0xffff0000u)}; }
#pragma unroll
                for (int tt = 0; tt < 8; ++tt) { f32x2 a = cb;
#pragma unroll
                    for (int j = 0; j < CONVW; ++j) a += u2[tt + j] * cw[j];
                    *(LAS f32x2*)(co + (tb + tt) * CONVC + 2 * cp) = a; } }
            __syncthreads();
#pragma unroll 2
            for (int q = 0; q < CT / 8; ++q) { const int tt = wave * (CT / 8) + q;
                const f32x4 a0 = *(const LAS f32x4*)(co + tt * CONVC + lane * 8), a1 = *(const LAS f32x4*)(co + tt * CONVC + lane * 8 + 4);
                float s = (a0[0] + a0[1]) + (a0[2] + a0[3]) + (a1[0] + a1[1]) + (a1[2] + a1[3]);
                s = sum16(s); s += __shfl_xor(s, 16); s += __shfl_xor(s, 32);
                const float mean = s * (1.0f / CONVC);
                float d[8]; float q2 = 0.f;
#pragma unroll
                for (int j = 0; j < 4; ++j) { d[j] = a0[j] - mean; d[4 + j] = a1[j] - mean; }
#pragma unroll
                for (int j = 0; j < 8; ++j) q2 += d[j] * d[j];
                q2 = sum16(q2); q2 += __shfl_xor(q2, 16); q2 += __shfl_xor(q2, 32);
                const float rstd = rsqrtf(q2 * (1.0f / CONVC) + 1e-5f);
                float o[8];
#pragma unroll
                for (int j = 0; j < 4; ++j) { const float x0 = d[j] * rstd * lg0[j] + lb0[j], x1 = d[4 + j] * rstd * lg1[j] + lb1[j]; o[j] = x0 * sigmoidf_(x0); o[4 + j] = x1 * sigmoidf_(x1); }
                u32x4 w; w.x = pk2(o[0], o[1]); w.y = pk2(o[2], o[3]); w.z = pk2(o[4], o[5]); w.w = pk2(o[6], o[7]);
                *(u32x4*)(Y + (size_t)(b * SEQ + t0 + tt) * D + lane * 8) = w; }
            __syncthreads();
        }
    }
#undef CONV_LOAD
#ifdef TIMING
    if (C.bid == 0 && tid == 0 && l == 0) ((unsigned*)(wsb + WS_CTL))[1024 + 60] = (unsigned)__builtin_amdgcn_s_memrealtime();
#endif
    }
#ifdef TIMING
    if (part == 1 && C.bid == 0 && tid == 0 && l == 0) ((unsigned*)(wsb + WS_CTL))[1024 + 61] = (unsigned)__builtin_amdgcn_s_memrealtime();
#endif
    if (part == 1)
    {
        const int b = C.bid >> 3, h = C.bid & 7;
        LAS unsigned char* L = C.lds;
        LAS float* sCon = (LAS float*)(L + PS_CON); LAS int* flg = (LAS int*)(L + PS_FLAG);
        {
            const float* mu = P->in[I_MU] + (size_t)l * RWKV_IN;
            for (int i = tid; i < 672; i += 512) { float v;
                if (i < 192) v = mu[(i >> 6) * RC + h * HS + (i & 63)]; else if (i < 352) v = mu[3 * RC + i - 192];
                else { const int q = (i - 352) >> 6, c = h * HS + ((i - 352) & 63); const float* src = q == 0 ? P->in[I_KK] : q == 1 ? P->in[I_KA] : q == 2 ? P->in[I_RK] : q == 3 ? P->in[I_GNG] : P->in[I_GNB]; v = src[l * RC + c]; }
                sCon[i] = v; }
            if (tid < 16) flg[tid] = 0;
        }
        __syncthreads();
#define MIX_POST(cq_) do { LAS unsigned char* Sq_ = L + ((cq_) & 1) * AB_SET; _Pragma("unroll") for (int s_ = 0; s_ < 2; ++s_) { const int tk_ = tok0 + 16 * s_; const int t_ = (cq_) * CH + tk_; \
            const f32x4 y4 = *(const LAS f32x4*)((const LAS float*)(Sq_ + AB_Y) + tk_ * 64 + cgE * 4), v4 = *(const LAS f32x4*)((const LAS float*)(Sq_ + AB_V) + tk_ * 64 + cgE * 4), g4 = *(const LAS f32x4*)((const LAS float*)(Sq_ + AB_G) + tk_ * 64 + cgE * 4); \
            const float mean = sum16((y4[0] + y4[1]) + (y4[2] + y4[3])) * (1.0f / HS); const f32x4 d = y4 - mean; \
            const float var = sum16((d[0] * d[0] + d[1] * d[1]) + (d[2] * d[2] + d[3] * d[3])) * (1.0f / HS); \
            const float rstd = rsqrtf(var + 64e-5f); const float bon = ((const LAS float*)(Sq_ + AB_BON))[tk_]; float o[4]; \
            _Pragma("unroll") for (int j = 0; j < 4; ++j) o[j] = (d[j] * rstd * gngv[j] + gnbv[j] + bon * v4[j]) * g4[j]; \
            u32x2 w; w.x = pk2(o[0], o[1]); w.y = pk2(o[2], o[3]); *(u32x2*)(Y + (size_t)(b * SEQ + t_) * D + CONVC + hc) = w; } } while (0)
        if (wave < 4) {
            const int x = lane & 15, g = lane >> 4, ws = wave;
            const int tok0 = tid >> 4, cgE = tid & 15, hc = h * HS + cgE * 4;
            f32x4 mlt, mgt, mle, iac; u32x4 sel0, sel1;
#pragma unroll
            for (int r = 0; r < 4; ++r) { const int m = 4 * g + r; mlt[r] = (m < x) ? 1.f : 0.f; mgt[r] = (x < m) ? 1.f : 0.f; mle[r] = (m <= x) ? 1.f : 0.f; iac[r] = (m == x) ? 1.f : 0.f;
                const unsigned one = 0x3F80u << (16 * (x & 1)); const bool hit = (((x & 7) >> 1) == r);
                sel0[r] = (hit && g == (x >> 3)) ? one : 0u; sel1[r] = (hit && g == 2 + (x >> 3)) ? one : 0u; }
            const bf16x8 Sel0 = __builtin_bit_cast(bf16x8, sel0), Sel1 = __builtin_bit_cast(bf16x8, sel1);
            const f32x4 z4 = (f32x4){0.f, 0.f, 0.f, 0.f};
#define MF(a_, b_, c_) __builtin_amdgcn_mfma_f32_16x16x32_bf16(a_, b_, c_, 0, 0, 0)
#define CVP(a_) __builtin_bit_cast(bf16x8, (u32x4){cvtpk((a_)[0], (a_)[1]), cvtpk((a_)[2], (a_)[3]), 0u, 0u})
#define PK8(a_, b_) __builtin_bit_cast(bf16x8, (u32x4){cvtpk((a_)[0], (a_)[1]), cvtpk((a_)[2], (a_)[3]), cvtpk((b_)[0], (b_)[1]), cvtpk((b_)[2], (b_)[3])})
            f32x4 T[4];
#pragma unroll
            for (int i = 0; i < 4; ++i) T[i] = z4;
            u32x2 n_vf[2];
#define VF_LOAD(ch_) do { _Pragma("unroll") for (int s_ = 0; s_ < 2; ++s_) n_vf[s_] = (l > 0) ? *(const u32x2*)(VF + (size_t)(b * SEQ + (ch_) * CH + tok0 + 16 * s_) * RC + hc) : (u32x2){0u, 0u}; } while (0)
            VF_LOAD(0);
#ifdef TIMING
            if (C.bid == 0 && tid == 0 && l == 0) ((unsigned*)(wsb + WS_CTL))[1024 + 63] = (unsigned)__builtin_amdgcn_s_memrealtime();
#endif
            const f32x4 kkv = *(const LAS f32x4*)(sCon + 352 + cgE * 4), kav = *(const LAS f32x4*)(sCon + 416 + cgE * 4), rkv = *(const LAS f32x4*)(sCon + 480 + cgE * 4);
            TP_DECL();
#pragma unroll 1
            for (int ch = 0; ch < SEQ / CH; ++ch) {
                LAS unsigned char* Sa = L + (ch & 1) * AB_SET; LAS unsigned char* St = L + PS_X;
                u32x2 vfc[2];
#pragma unroll
                for (int s_ = 0; s_ < 2; ++s_) vfc[s_] = n_vf[s_];
                if (ch + 1 < SEQ / CH) VF_LOAD(ch + 1);
                TP_ACC(6);
                lds_wait_ge(flg + 0, ch + 1); lds_wait_ge(flg + 1, ch + 1); lds_wait_ge(flg + 2, ch + 1); lds_wait_ge(flg + 3, ch + 1);
                TP_ACC(0);
                {
                    LAS float* sR = (LAS float*)(Sa + AB_R); LAS float* sK = (LAS float*)(Sa + AB_K); LAS float* sW = (LAS float*)(Sa + AB_W); LAS float* sA = (LAS float*)(Sa + AB_A);
                    LAS float* sV = (LAS float*)(Sa + AB_V); LAS float* sY = (LAS float*)(Sa + AB_Y);
#pragma unroll
                    for (int s_ = 0; s_ < 2; ++s_) {
                        const int tok = tok0 + 16 * s_; const int t = ch * CH + tok;
                        const f32x4 r4 = *(const LAS f32x4*)(sR + tok * 64 + cgE * 4), k4 = *(const LAS f32x4*)(sK + tok * 64 + cgE * 4), cs = *(const LAS f32x4*)(sW + tok * 64 + cgE * 4), as4 = *(const LAS f32x4*)(sA + tok * 64 + cgE * 4);
                        f32x4 v4 = *(const LAS f32x4*)(sV + tok * 64 + cgE * 4);
                        f32x4 cp = (f32x4){1.f, 1.f, 1.f, 1.f}; if (tok > 0) cp = *(const LAS f32x4*)(sW + (tok - 1) * 64 + cgE * 4);
                        if (l == 0) { u32x2 w; w.x = cvtpk(v4[0], v4[1]); w.y = cvtpk(v4[2], v4[3]); *(u32x2*)(VF + (size_t)(b * SEQ + t) * RC + hc) = w; }
                        else { const f32x4 vg = *(const LAS f32x4*)(sY + tok * 64 + cgE * 4);
                            const float f0 = __uint_as_float(vfc[s_].x << 16), f1 = __uint_as_float(vfc[s_].x & 0xffff0000u), f2 = __uint_as_float(vfc[s_].y << 16), f3 = __uint_as_float(vfc[s_].y & 0xffff0000u);
                            v4[0] += (f0 - v4[0]) * vg[0]; v4[1] += (f1 - v4[1]) * vg[1]; v4[2] += (f2 - v4[2]) * vg[2]; v4[3] += (f3 - v4[3]) * vg[3]; }
                        f32x4 kk4, k2, bb, rt, gm4; float ssq = 0.f, rk = 0.f;
#pragma unroll
                        for (int j = 0; j < 4; ++j) { kk4[j] = k4[j] * kkv[j]; ssq += kk4[j] * kk4[j]; k2[j] = k4[j] * (1.0f + (as4[j] - 1.0f) * kav[j]); rk += r4[j] * k2[j] * rkv[j]; }
                        ssq = sum16(ssq);
                        const float inv = rsqrtf(fmaxf(ssq, 1e-24f));
                        rk = sum16(rk);
#pragma unroll
                        for (int j = 0; j < 4; ++j) { const float gm = cs[j], gi = __builtin_amdgcn_rcpf(gm), gp = cp[j]; gm4[j] = gm;
                            kk4[j] *= inv; bb[j] = kk4[j] * as4[j] * gi; kk4[j] = -kk4[j] * gp; k2[j] *= gi; rt[j] = r4[j] * gm; }
#define XST(off_, v_) *(LAS u32x2*)(St + (off_) + tok * XROW + cgE * 8) = (u32x2){cvtpk((v_)[0], (v_)[1]), cvtpk((v_)[2], (v_)[3])}
                        XST(XS_A, kk4); XST(XS_B, bb); XST(XS_K, k2); XST(XS_R, rt); XST(XS_V, v4);
#undef XST
                        *(LAS f32x4*)(sV + tok * 64 + cgE * 4) = v4;
                        if (cgE == 0) ((LAS float*)(Sa + AB_BON))[tok] = rk;
                        if (tok == CH - 1) *(LAS f32x4*)((LAS float*)(L + PS_GAM) + cgE * 4) = gm4;
                    }
                }
                TP_ACC(2);
                lds_signal(flg + 14, lane); lds_wait_ge(flg + 14, 4 * (ch + 1));
                TP_ACC(4);
#ifndef MIXSKIP_SCAN
#pragma unroll
                for (int sc = 0; sc < 2; ++sc) {
                    const LAS unsigned char* rowp = St + (16 * sc + x) * XROW + g * 16;
                    bf16x8 oA[2], oB[2], oK[2], oR[2];
#pragma unroll
                    for (int kp = 0; kp < 2; ++kp) { oA[kp] = *(const LAS bf16x8*)(rowp + XS_A + kp * 64); oB[kp] = *(const LAS bf16x8*)(rowp + XS_B + kp * 64);
                        oK[kp] = *(const LAS bf16x8*)(rowp + XS_K + kp * 64); oR[kp] = *(const LAS bf16x8*)(rowp + XS_R + kp * 64); }
                    const bf16x8 oV = *(const LAS bf16x8*)(St + XS_V + (16 * sc + x) * XROW + ((16 * ws + 8 * g) & 63) * 2);
                    const f32x4 aL = MF(oB[1], oA[1], MF(oB[0], oA[0], z4)) * mlt;
                    const f32x4 aLT = MF(oA[1], oB[1], MF(oA[0], oB[0], z4)) * mgt;
                    const f32x4 aKT = MF(oA[1], oK[1], MF(oA[0], oK[0], z4)) * mgt;
                    const f32x4 aMb = MF(oB[1], oR[1], MF(oB[0], oR[0], z4)) * mle;
                    const f32x4 aMk = MF(oK[1], oR[1], MF(oK[0], oR[0], z4)) * mle;
                    const bf16x8 pl = CVP(aL), plt = CVP(aLT);
                    const f32x4 l2 = MF(plt, pl, z4), l2t = MF(pl, plt, z4);
                    const bf16x8 pl2 = CVP(l2), pl2t = CVP(l2t);
                    const f32x4 l4 = MF(pl2t, pl2, z4), l4t = MF(pl2, pl2t, z4), l3t = MF(pl2, plt, z4);
                    const bf16x8 pl4 = CVP(l4), pl4t = CVP(l4t);
                    const f32x4 l8 = MF(pl4t, pl4, z4);
                    const f32x4 l12 = MF(pl4t, CVP(l8), z4);
                    const f32x4 q1t = iac + aLT + l2t + l3t, q2 = iac + l4 + l8 + l12;
                    const bf16x8 pq1t = CVP(q1t), pq2 = CVP(q2);
                    const f32x4 nn = MF(pq1t, pq2, z4), nnt = MF(pq2, pq1t, z4);
                    const bf16x8 pn = CVP(nn), pmb = CVP(aMb), pkt = CVP(aKT);
                    const f32x4 p2 = MF(CVP(nnt), pmb, z4);
                    const f32x4 p3 = MF(pkt, pn, z4), p3t = MF(pn, pkt, z4);
                    const f32x4 p4 = MF(CVP(p3t), pmb, aMk);
                    bf16x8 ARk[4], BKk[4];
#pragma unroll
                    for (int kt = 0; kt < 4; ++kt) { const bf16x8 se = (kt & 1) ? Sel1 : Sel0;
                        const f32x4 ta = MF(oA[kt >> 1], se, z4), tr = MF(oR[kt >> 1], se, z4), tb = MF(oB[kt >> 1], se, z4), tk = MF(oK[kt >> 1], se, z4);
                        ARk[kt] = PK8(ta, tr); BKk[kt] = PK8(tb, tk); }
                    const f32x4 trV = MF(oV, Sel0, z4);
                    const bf16x8 bN0 = PK8(nn, z4), bP2I = PK8(p2, iac);
                    f32x4 apT[4], rpT[4];
#pragma unroll
                    for (int kt = 0; kt < 4; ++kt) { apT[kt] = MF(ARk[kt], bN0, z4); rpT[kt] = MF(ARk[kt], bP2I, z4); }
                    const bf16x8 ApOp0 = PK8(apT[0], apT[1]), ApOp1 = PK8(apT[2], apT[3]), RpOp0 = PK8(rpT[0], rpT[1]), RpOp1 = PK8(rpT[2], rpT[3]);
                    const bf16x8 vOp = PK8(trV, z4);
                    f32x4 uT = MF(CVP(p3), vOp, z4), yT = MF(CVP(p4), vOp, z4);
                    const bf16x8 SOp0 = PK8(T[0], T[1]), SOp1 = PK8(T[2], T[3]);
                    uT = MF(ApOp0, SOp0, uT); uT = MF(ApOp1, SOp1, uT);
                    yT = MF(RpOp0, SOp0, yT); yT = MF(RpOp1, SOp1, yT);
                    const bf16x8 UV = PK8(uT, trV);
#pragma unroll
                    for (int kt = 0; kt < 4; ++kt) T[kt] = MF(BKk[kt], UV, T[kt]);
                    LAS float* yp = (LAS float*)(Sa + AB_Y) + (16 * sc + 4 * g) * 64 + 16 * ws + x;
#pragma unroll
                    for (int r = 0; r < 4; ++r) yp[r * 64] = yT[r];
                }
#endif
#pragma unroll
                for (int kt = 0; kt < 4; ++kt) T[kt] = T[kt] * *(const LAS f32x4*)((const LAS float*)(L + PS_GAM) + 16 * kt + 4 * g);
                TP_ACC(3);
                lds_signal(flg + 12, lane); lds_wait_ge(flg + 12, 4 * (ch + 1));
                TP_ACC(4);
            }
#undef MF
#undef CVP
#undef PK8
#undef VF_LOAD
#ifdef TIMING
            if (C.bid == 0 && tid == 0 && l == 0) ((unsigned*)(wsb + WS_CTL))[1024 + 62] = (unsigned)__builtin_amdgcn_s_memrealtime();
#endif
            if (C.bid == 0 && tid == 0 && l == 0) { TP_OUT(0); TP_OUT(2); TP_OUT(3); TP_OUT(4); TP_OUT(5); TP_OUT(6); }
        } else {
            const int ptid = tid - 256, pw = wave - 4, tok0 = ptid >> 4, cgE = ptid & 15, hc = h * HS + cgE * 4;
            __builtin_amdgcn_s_setprio(1);
            int pbar_epoch = 0;
#define PREP_BAR() do { ++pbar_epoch; lds_signal(flg + 8, lane); lds_wait_ge(flg + 8, 4 * pbar_epoch); } while (0)
            const int nt = pw, fr = lane & 15, fq = lane >> 4;
            bf16x8 Bw, Ba, Bv, Bg[3];
            {
                const int n = h * HS + nt * 16 + fr;
#pragma unroll
                for (int j = 0; j < 8; ++j) { const int k = 8 * fq + j;
                    Bw[j] = (short)f2bf(P->in[I_W2][((size_t)l * LW + k) * RC + n]); Ba[j] = (short)f2bf(P->in[I_A2][((size_t)l * LA + k) * RC + n]);
                    Bv[j] = (l > 0) ? (short)f2bf(P->in[I_V2][((size_t)(l - 1) * LV + k) * RC + n]) : (short)0;
#pragma unroll
                    for (int s3 = 0; s3 < 3; ++s3) Bg[s3][j] = (short)f2bf(P->in[I_G2][((size_t)l * LG + 32 * s3 + k) * RC + n]); }
            }
            const int ncol = h * HS + nt * 16 + fr;
            const float w0c = P->in[I_W0][l * RC + ncol], a0c = P->in[I_A0][l * RC + ncol], v0c = (l > 0) ? P->in[I_V0][(l - 1) * RC + ncol] : 0.f;
            const bf16_t* Zb = Z + (size_t)b * SEQ * ZC;
            u32x2 n_rc[2], n_rp[2], n_kc[2], n_kp[2], n_vc[2], n_vp[2]; bf16x8 n_Aw[2], n_Aa[2], n_Av[2], n_Ag[2][3];
            const unsigned vo_b = (unsigned)((tok0 * ZC + ZC_R + hc) * 2);
            const unsigned vo_a = (unsigned)((fr * LRC + fq * 8) * 2);
            const bf16_t* LRb = (const bf16_t*)(wsb + WS_LR) + (size_t)b * SEQ * LRC;
#define MIX_LOAD_Z(ch_, CHK_) do { _Pragma("unroll") for (int s_ = 0; s_ < 2; ++s_) { const char* bc_ = (const char*)(Zb + (size_t)((ch_) * CH + 16 * s_) * ZC); const char* bp_ = bc_ - ZC * 2; \
            const bool hp_ = !(CHK_) || ((ch_) * CH + 16 * s_ + tok0 > 0); const u32x2 z2_ = (u32x2){0u, 0u}; \
            n_rc[s_] = *(const u32x2*)(bc_ + (size_t)vo_b); n_kc[s_] = *(const u32x2*)(bc_ + (size_t)vo_b + 1024); n_vc[s_] = *(const u32x2*)(bc_ + (size_t)vo_b + 2048); \
            n_rp[s_] = hp_ ? *(const u32x2*)(bp_ + (size_t)vo_b) : z2_; n_kp[s_] = hp_ ? *(const u32x2*)(bp_ + (size_t)vo_b + 1024) : z2_; n_vp[s_] = hp_ ? *(const u32x2*)(bp_ + (size_t)vo_b + 2048) : z2_; } } while (0)
#define MIX_LOAD_A(ch_) do { _Pragma("unroll") for (int s_ = 0; s_ < 2; ++s_) { const char* ba_ = (const char*)(LRb + (size_t)((ch_) * CH + 16 * s_) * LRC); \
            n_Aw[s_] = *(const bf16x8*)(ba_ + (size_t)vo_a); n_Aa[s_] = *(const bf16x8*)(ba_ + (size_t)vo_a + 64); n_Ag[s_][0] = *(const bf16x8*)(ba_ + (size_t)vo_a + 128); n_Ag[s_][1] = *(const bf16x8*)(ba_ + (size_t)vo_a + 192); \
            n_Ag[s_][2] = *(const bf16x8*)(ba_ + (size_t)vo_a + 256); n_Av[s_] = *(const bf16x8*)(ba_ + (size_t)vo_a + 320); } } while (0)
            MIX_LOAD_Z(0, true); MIX_LOAD_A(0);
            const f32x4 mur = *(const LAS f32x4*)(sCon + cgE * 4), muk = *(const LAS f32x4*)(sCon + 64 + cgE * 4), muv = *(const LAS f32x4*)(sCon + 128 + cgE * 4);
            const f32x4 gngv = *(const LAS f32x4*)(sCon + 544 + cgE * 4), gnbv = *(const LAS f32x4*)(sCon + 608 + cgE * 4);
            TP_DECL();
#pragma unroll 1
            for (int ch = 0; ch < SEQ / CH; ++ch) {
                LAS unsigned char* Sa = L + (ch & 1) * AB_SET;
                LAS float* sK = (LAS float*)(Sa + AB_K); LAS float* sW = (LAS float*)(Sa + AB_W); LAS float* sR = (LAS float*)(Sa + AB_R); LAS float* sA = (LAS float*)(Sa + AB_A);
                LAS float* sV = (LAS float*)(Sa + AB_V); LAS float* sY = (LAS float*)(Sa + AB_Y); LAS float* sG = (LAS float*)(Sa + AB_G);
                TP_ACC(9);
                if (ch >= 2) { lds_wait_ge(flg + 12, 4 * (ch - 1)); TP_ACC(1); MIX_POST(ch - 2); }
                TP_ACC(5);
#pragma unroll
                for (int s_ = 0; s_ < 2; ++s_) {
                    const int tokE = tok0 + 16 * s_;
#define LERP2(dst, wc_, wp_, m0, m1) do { const float c0_ = __uint_as_float((wc_) << 16), c1_ = __uint_as_float((wc_) & 0xffff0000u), p0_ = __uint_as_float((wp_) << 16), p1_ = __uint_as_float((wp_) & 0xffff0000u); \
                        (dst)[0] = c0_ + (p0_ - c0_) * (m0); (dst)[1] = c1_ + (p1_ - c1_) * (m1); } while (0)
                    f32x4 r4, k4, v4; float t2[2];
                    LERP2(t2, n_rc[s_].x, n_rp[s_].x, mur[0], mur[1]); r4[0] = t2[0]; r4[1] = t2[1]; LERP2(t2, n_rc[s_].y, n_rp[s_].y, mur[2], mur[3]); r4[2] = t2[0]; r4[3] = t2[1];
                    LERP2(t2, n_kc[s_].x, n_kp[s_].x, muk[0], muk[1]); k4[0] = t2[0]; k4[1] = t2[1]; LERP2(t2, n_kc[s_].y, n_kp[s_].y, muk[2], muk[3]); k4[2] = t2[0]; k4[3] = t2[1];
                    LERP2(t2, n_vc[s_].x, n_vp[s_].x, muv[0], muv[1]); v4[0] = t2[0]; v4[1] = t2[1]; LERP2(t2, n_vc[s_].y, n_vp[s_].y, muv[2], muv[3]); v4[2] = t2[0]; v4[3] = t2[1];
                    *(LAS f32x4*)(sR + tokE * 64 + cgE * 4) = r4; *(LAS f32x4*)(sK + tokE * 64 + cgE * 4) = k4; *(LAS f32x4*)(sV + tokE * 64 + cgE * 4) = v4;
#undef LERP2
                }
                if (ch + 1 < SEQ / CH) MIX_LOAD_Z(ch + 1, false);
                TP_ACC(7);
                PREP_BAR();
                TP_ACC(6);
                {
                    f32x4 lw[2];
#pragma unroll
                    for (int mt = 0; mt < 2; ++mt) {
                        const f32x4 z4 = (f32x4){0.f, 0.f, 0.f, 0.f};
                        f32x4 cw4 = __builtin_amdgcn_mfma_f32_16x16x32_bf16(n_Aw[mt], Bw, z4, 0, 0, 0), ca4 = __builtin_amdgcn_mfma_f32_16x16x32_bf16(n_Aa[mt], Ba, z4, 0, 0, 0), cv4 = (l > 0) ? __builtin_amdgcn_mfma_f32_16x16x32_bf16(n_Av[mt], Bv, z4, 0, 0, 0) : z4, cg4 = z4;
#pragma unroll
                        for (int s3 = 0; s3 < 3; ++s3) cg4 = __builtin_amdgcn_mfma_f32_16x16x32_bf16(n_Ag[mt][s3], Bg[s3], cg4, 0, 0, 0);
#pragma unroll
                        for (int j = 0; j < 4; ++j) { const int o = (mt * 16 + fq * 4 + j) * 64 + nt * 16 + fr;
                            lw[mt][j] = -0.60653066f * sigmoidf_(cw4[j] + w0c); sA[o] = sigmoidf_(ca4[j] + a0c); sG[o] = cg4[j]; if (l > 0) sY[o] = sigmoidf_(cv4[j] + v0c); }
                    }
                    if (ch + 1 < SEQ / CH) MIX_LOAD_A(ch + 1);
                    float base = 0.f;
#pragma unroll
                    for (int mt = 0; mt < 2; ++mt) {
                        lw[mt][1] += lw[mt][0]; lw[mt][2] += lw[mt][1]; lw[mt][3] += lw[mt][2];
                        const float tg = lw[mt][3], s16 = xsum16(tg), s32 = xsum32(s16);
                        const float pg = (fq == 0) ? 0.f : (fq == 1) ? (s16 - tg) : (fq == 2) ? (s32 - s16) : (s32 - tg);
#pragma unroll
                        for (int j = 0; j < 4; ++j) sW[(mt * 16 + fq * 4 + j) * 64 + nt * 16 + fr] = __expf(base + pg + lw[mt][j]);
                        base += s32; }
                }
                TP_ACC(8);
                lds_signal(flg + pw, lane);
            }
            if (C.bid == 0 && tid == 256 && l == 0) { TP_OUT(1); TP_OUT(7); TP_OUT(8); TP_OUT(9); }
            lds_wait_ge(flg + 12, 4 * (SEQ / CH - 1)); MIX_POST(SEQ / CH - 2);
            lds_wait_ge(flg + 12, 4 * (SEQ / CH)); MIX_POST(SEQ / CH - 1);
            __builtin_amdgcn_s_setprio(0);
#undef MIX_LOAD_Z
#undef MIX_LOAD_A
#undef PREP_BAR
        }
#undef MIX_POST
        __syncthreads();
    }
}

__device__ __forceinline__ void phase_router(KP P, const Ctx& C0, unsigned char* wsb, int l) {
    const Ctx C = fresh(C0);
    const bf16_t* h = (const bf16_t*)(wsb + WS_HB); const bf16_t* wrh = (const bf16_t*)(wsb + WS_WR) + (size_t)(l * 2) * 48 * D; const bf16_t* wrl = wrh + (size_t)48 * D;
    float* rsf = (float*)(wsb + WS_RSF); int* cnt = (int*)(wsb + WS_CTL) + l * 64; int* tlist = (int*)(wsb + WS_TLIST); float* glist = (float*)(wsb + WS_GLIST); int* tslot = (int*)(wsb + WS_TSLOT);
    const int gw = C.vcu * 8 + C.wave, NGW = C.G * 8, lane = C.lane, fr = lane & 15, fq = lane >> 4, tid = C.tid;
    constexpr int WROW = 272;
    LAS unsigned char* wsl = C.lds;
    LAS float* lg = (LAS float*)(C.lds + 32768 + C.wave * 4096);
    LAS int* lcnt = (LAS int*)(C.lds + 65536);
    static_assert(M / 16 == 2 * 256 * 8, "two 16-token tiles per wave");
    if (tid < 64) lcnt[tid] = 0;
    f32x4 acc[2][3]; float ss[2] = {0.f, 0.f};
#pragma unroll
    for (int it = 0; it < 2; ++it)
#pragma unroll
        for (int nt = 0; nt < 3; ++nt) acc[it][nt] = (f32x4){0.f, 0.f, 0.f, 0.f};
    const bf16_t* hrow0 = h + (size_t)((gw) * 16 + fr) * D + fq * 8; const bf16_t* hrow1 = h + (size_t)((gw + NGW) * 16 + fr) * D + fq * 8;
#pragma unroll 1
    for (int kb = 0; kb < D / 128; ++kb) {
        __syncthreads();
#pragma unroll
        for (int i = 0; i < 3; ++i) { const int p = tid + 512 * i; const int hl = p / 768, r = (p % 768) >> 4, c = p & 15;
            *(LAS u32x4*)(wsl + (hl * 48 + r) * WROW + c * 16) = *(const u32x4*)((hl ? wrl : wrh) + (size_t)r * D + kb * 128 + c * 8); }
        bf16x8 a0[4], a1[4];
#pragma unroll
        for (int ks = 0; ks < 4; ++ks) { a0[ks] = *(const bf16x8*)(hrow0 + kb * 128 + ks * 32); a1[ks] = *(const bf16x8*)(hrow1 + kb * 128 + ks * 32); }
        __syncthreads();
#pragma unroll
        for (int ks = 0; ks < 4; ++ks) {
#pragma unroll
            for (int j = 0; j < 8; ++j) { const float x0 = __uint_as_float(((unsigned)(unsigned short)a0[ks][j]) << 16), x1 = __uint_as_float(((unsigned)(unsigned short)a1[ks][j]) << 16); ss[0] += x0 * x0; ss[1] += x1 * x1; }
#pragma unroll
            for (int nt = 0; nt < 3; ++nt) { const bf16x8 bh = *(const LAS bf16x8*)(wsl + (nt * 16 + fr) * WROW + (ks * 32 + fq * 8) * 2), bl = *(const LAS bf16x8*)(wsl + (48 + nt * 16 + fr) * WROW + (ks * 32 + fq * 8) * 2);
                acc[0][nt] = __builtin_amdgcn_mfma_f32_16x16x32_bf16(a0[ks], bh, acc[0][nt], 0, 0, 0); acc[0][nt] = __builtin_amdgcn_mfma_f32_16x16x32_bf16(a0[ks], bl, acc[0][nt], 0, 0, 0);
                acc[1][nt] = __builtin_amdgcn_mfma_f32_16x16x32_bf16(a1[ks], bh, acc[1][nt], 0, 0, 0); acc[1][nt] = __builtin_amdgcn_mfma_f32_16x16x32_bf16(a1[ks], bl, acc[1][nt], 0, 0, 0); }
        }
    }
    int me0[2], me1[2], mp0[2], mp1[2]; float mw0[2], mw1[2], mrs[2]; float* rlist = (float*)(wsb + WS_RLIST);
#pragma unroll
    for (int it = 0; it < 2; ++it) {
        const int tile = gw + it * NGW;
        float s2 = ss[it]; s2 += __shfl_xor(s2, 16); s2 += __shfl_xor(s2, 32);
        const float rsq = rsqrtf(s2 * (1.0f / D) + 1e-6f);
#pragma unroll
        for (int nt = 0; nt < 3; ++nt)
#pragma unroll
            for (int j = 0; j < 4; ++j) lg[(fq * 4 + j) * 48 + nt * 16 + fr] = acc[it][nt][j];
        if (fq == 0) { lg[768 + fr] = rsq; rsf[tile * 16 + fr] = rsq; }
        asm volatile("s_waitcnt lgkmcnt(0)" ::: "memory");
        me0[it] = 0; me1[it] = 0; mp0[it] = 0; mp1[it] = 0; mw0[it] = 0.f; mw1[it] = 0.f; mrs[it] = 0.f;
        if (lane < 16) {
            const float rs = lg[768 + lane]; const LAS float* q = lg + lane * 48; mrs[it] = rs;
            float gl[NG]; int gi = 0;
#pragma unroll
            for (int j = 0; j < NG; ++j) gl[j] = q[j] * rs + P->in[I_RGB][l * NG + j];
            float gm = gl[0];
#pragma unroll
            for (int j = 1; j < NG; ++j) if (gl[j] > gm) { gm = gl[j]; gi = j; }
            float den = 0.f;
#pragma unroll
            for (int j = 0; j < NG; ++j) den += __expf(gl[j] - gm);
            const float gp = 1.0f / den;
            float el[EPG];
#pragma unroll
            for (int e = 0; e < EPG; ++e) el[e] = q[NG + gi * EPG + e] * rs + P->in[I_REB][(l * NG + gi) * EPG + e];
            int i0 = 0; float m0 = el[0];
#pragma unroll
            for (int e = 1; e < EPG; ++e) if (el[e] > m0) { m0 = el[e]; i0 = e; }
            int i1 = (i0 == 0) ? 1 : 0; float m1 = -3.0e38f;
#pragma unroll
            for (int e = 0; e < EPG; ++e) if (e != i0 && el[e] > m1) { m1 = el[e]; i1 = e; }
            const float p1 = 1.0f / (1.0f + __expf(m0 - m1));
            mw0[it] = (1.0f - p1) * gp; mw1[it] = p1 * gp;
            me0[it] = gi * EPG + i0; me1[it] = gi * EPG + i1;
            mp0[it] = __hip_atomic_fetch_add(&lcnt[me0[it]], 1, __ATOMIC_RELAXED, __HIP_MEMORY_SCOPE_WORKGROUP); mp1[it] = __hip_atomic_fetch_add(&lcnt[me1[it]], 1, __ATOMIC_RELAXED, __HIP_MEMORY_SCOPE_WORKGROUP);
        }
        asm volatile("s_waitcnt lgkmcnt(0)" ::: "memory");
    }
    __syncthreads();
    if (tid < NE) lcnt[32 + tid] = atomicAdd(&cnt[tid], lcnt[tid]);
    __syncthreads();
    if (lane < 16) {
#pragma unroll
        for (int it = 0; it < 2; ++it) { const int t = (gw + it * NGW) * 16 + lane;
            const int p0 = lcnt[32 + me0[it]] + mp0[it], p1 = lcnt[32 + me1[it]] + mp1[it];
            tlist[me0[it] * LCAP + p0] = t; glist[me0[it] * LCAP + p0] = mw0[it]; rlist[me0[it] * LCAP + p0] = mrs[it]; tslot[t * 2] = me0[it] * LCAP + p0;
            tlist[me1[it] * LCAP + p1] = t; glist[me1[it] * LCAP + p1] = mw1[it]; rlist[me1[it] * LCAP + p1] = mrs[it]; tslot[t * 2 + 1] = me1[it] * LCAP + p1; }
    }
    __syncthreads();
}

__device__ __forceinline__ void moe_prefix(KP P, const Ctx& C0, unsigned char* wsb, int l) {
    const Ctx C = fresh(C0);
    const int* cnt = (const int*)(wsb + WS_CTL) + l * 64;
    LAS int* tp = (LAS int*)(C.lds + LDS_MISC); LAS int* ps = (LAS int*)(C.lds + LDS_MISC + 256);
    if (C.wave == 0) { const int e = C.lane & 31; const int nt_ = (cnt[e] + 255) >> 8; int inc = nt_;
#pragma unroll
        for (int o = 1; o < 32; o <<= 1) { const int v = __shfl_up(inc, o, 64); if ((C.lane & 31) >= o) inc += v; }
        if (C.lane < 32) { tp[e] = inc - nt_; ps[e] = (inc - nt_) * 256; if (e == 31) { tp[NE] = inc; ps[NE] = inc * 256; } } }
    __syncthreads();
}

__device__ __forceinline__ void phase_combine(KP P, const Ctx& C0, unsigned char* wsb, int l) {
    const Ctx C = fresh(C0);
    bf16_t* hb = (bf16_t*)(wsb + WS_HB); const bf16_t* ys = (const bf16_t*)(wsb + WS_YS); const int* tslot = (const int*)(wsb + WS_TSLOT); float* rsp = (float*)(wsb + WS_RSP);
    const LAS int* ps = (const LAS int*)(C.lds + LDS_MISC + 256);
    const int gw = C.vcu * 8 + C.wave, NGW = C.G * 8, lane = C.lane;
    static_assert((M / 2048) % 4 == 0, "rows per wave divisible by 4");
    for (int m0 = gw; m0 < M; m0 += 4 * NGW) {
        int sl[4][2];
#pragma unroll
        for (int q = 0; q < 4; ++q) { const u32x2 t2 = *(const u32x2*)(tslot + (size_t)(m0 + q * NGW) * 2); sl[q][0] = (int)t2.x; sl[q][1] = (int)t2.y; }
        u32x4 hv[4][2], ya[4][2], yb[4][2];
#pragma unroll
        for (int q = 0; q < 4; ++q) { const int m = m0 + q * NGW;
            const size_t r0 = (size_t)(ps[sl[q][0] >> 16] + (sl[q][0] & 0xffff)), r1 = (size_t)(ps[sl[q][1] >> 16] + (sl[q][1] & 0xffff));
            const u32x4* hr = (const u32x4*)(hb + (size_t)m * D) + lane; const u32x4* y0 = (const u32x4*)(ys + r0 * D) + lane; const u32x4* y1 = (const u32x4*)(ys + r1 * D) + lane;
#pragma unroll
            for (int j = 0; j < 2; ++j) { hv[q][j] = hr[64 * j]; ya[q][j] = y0[64 * j]; yb[q][j] = y1[64 * j]; } }
#pragma unroll
        for (int q = 0; q < 4; ++q) { const int m = m0 + q * NGW; u32x4* hr = (u32x4*)(hb + (size_t)m * D) + lane; float s = 0.f;
#pragma unroll
            for (int j = 0; j < 2; ++j) { u32x4 w;
#pragma unroll
                for (int c = 0; c < 4; ++c) { const float lo = (__uint_as_float(hv[q][j][c] << 16) + __uint_as_float(ya[q][j][c] << 16)) + __uint_as_float(yb[q][j][c] << 16);
                    const float hi = (__uint_as_float(hv[q][j][c] & 0xffff0000u) + __uint_as_float(ya[q][j][c] & 0xffff0000u)) + __uint_as_float(yb[q][j][c] & 0xffff0000u);
                    w[c] = pk2(lo, hi); const float rl = __uint_as_float(w[c] << 16), rh = __uint_as_float(w[c] & 0xffff0000u); s += rl * rl + rh * rh; }
                hr[64 * j] = w; }
            s = sum16(s); s += __shfl_xor(s, 16); s += __shfl_xor(s, 32);
            if (lane == 0) rsp[m] = rsqrtf(s * (1.0f / D) + 1e-6f); }
    }
}

__device__ __forceinline__ void phase_final(KP P, const Ctx& C0, unsigned char* wsb) {
    const Ctx C = fresh(C0);
    float* out = P->out; const bf16_t* h = (const bf16_t*)(wsb + WS_Y); const float* g = P->in[I_FINN]; const float* part = (const float*)(wsb + WS_PART);
    const int gw = C.vcu * 8 + C.wave, NGW = C.G * 8, lane = C.lane;
    f32x4 gv[4];
#pragma unroll
    for (int j = 0; j < 4; ++j) gv[j] = ((const f32x4*)g)[lane * 4 + j];
    for (int m0 = gw; m0 < M; m0 += 4 * NGW) {
        u32x4 ra[4], rb[4]; float ssq[4];
#pragma unroll
        for (int q = 0; q < 4; ++q) { const int m = m0 + q * NGW; const u32x4* hr = (const u32x4*)(h + (size_t)m * D) + lane * 2; ra[q] = hr[0]; rb[q] = hr[1]; ssq[q] = (lane < NPART) ? part[(size_t)m * NPART + lane] : 0.f; }
#pragma unroll
        for (int q = 0; q < 4; ++q) { const int m = m0 + q * NGW; const u32x4 a = ra[q], b = rb[q];
            float ss = sum16(ssq[q]); ss += __shfl_xor(ss, 16); ss += __shfl_xor(ss, 32);
            const float rs = rsqrtf(ss * (1.0f / D) + 1e-6f);
            f32x4* o = (f32x4*)(out + (size_t)m * D) + lane * 4;
            o[0] = (f32x4){__uint_as_float(a.x << 16), __uint_as_float(a.x & 0xffff0000u), __uint_as_float(a.y << 16), __uint_as_float(a.y & 0xffff0000u)} * rs * gv[0];
            o[1] = (f32x4){__uint_as_float(a.z << 16), __uint_as_float(a.z & 0xffff0000u), __uint_as_float(a.w << 16), __uint_as_float(a.w & 0xffff0000u)} * rs * gv[1];
            o[2] = (f32x4){__uint_as_float(b.x << 16), __uint_as_float(b.x & 0xffff0000u), __uint_as_float(b.y << 16), __uint_as_float(b.y & 0xffff0000u)} * rs * gv[2];
            o[3] = (f32x4){__uint_as_float(b.z << 16), __uint_as_float(b.z & 0xffff0000u), __uint_as_float(b.w << 16), __uint_as_float(b.w & 0xffff0000u)} * rs * gv[3];
#ifdef TIMING
            if (m == 0 && lane == 0) { asm volatile("s_waitcnt vmcnt(0)" ::: "memory"); const unsigned* st = (const unsigned*)(wsb + WS_CTL) + 1024; out[0] = exp2f(rintf(16.0f * log2f((float)(st[TIM_A1] - st[TIM_A0]) * 0.01f + 1.0f)) * 0.0625f) * 0.1f; }
#endif
        }
    }
}

__device__ __forceinline__ float dbg_dot(const bf16_t* a, const bf16_t* b, int K, int lane) {
    float s = 0.f;
    for (int k = lane * 8; k < K; k += 512) { const u32x4 av = *(const u32x4*)(a + k), bv = *(const u32x4*)(b + k);
#pragma unroll
        for (int j = 0; j < 4; ++j) s += __uint_as_float(av[j] << 16) * __uint_as_float(bv[j] << 16) + __uint_as_float(av[j] & 0xffff0000u) * __uint_as_float(bv[j] & 0xffff0000u); }
    return wave_sum(s);
}
__device__ __forceinline__ void phase_dbg(KP P, const Ctx& C0, unsigned char* wsb, const int mode) {
    const Ctx C = fresh(C0);
    const int gw = C.vcu * 8 + C.wave, NGW = C.G * 8, lane = C.lane;
    const bf16_t* hb = (const bf16_t*)(wsb + WS_HB); const float* part = (const float*)(wsb + WS_PART);
    unsigned char* wl = wsb + WS_W;
    for (int m = gw; m < M; m += NGW) {
        bool ok = true;
        for (int q = 0; q < 4; ++q) {
            unsigned hsh = (unsigned)m * 2654435761u + (unsigned)q * 40503u; hsh ^= hsh >> 13;
            if (mode == 1) {
                const int n = hsh % IN_COLS;
                float ss = 0.f; for (int p = 0; p < NPART; ++p) ss += part[(size_t)m * NPART + p];
                const float ref = dbg_dot(hb + (size_t)m * D, (const bf16_t*)(wl + WO_IN) + (size_t)n * D, D, lane) * rsqrtf(ss * (1.0f / D) + 1e-6f);
                const float got = bf2f(((const bf16_t*)(wsb + WS_Z))[(size_t)m * ZC + n]);
                if (!(fabsf(got - ref) <= 0.02f * fabsf(ref) + 0.02f)) ok = false;
            } else if (mode == 2) {
                const int n = hsh % D;
                const float ref = P->in[I_X][(size_t)m * D + n] + dbg_dot((const bf16_t*)(wsb + WS_Y) + (size_t)m * D, (const bf16_t*)(wl + WO_OUT) + (size_t)n * D, D, lane);
                const float got = P->out[(size_t)m * D + n];
                if (!(fabsf(got - ref) <= 0.02f * fabsf(ref) + 0.02f)) ok = false;
            } else if (mode == 3) {
                const int n = hsh % IN_COLS; const int k = (hsh >> 8) % D;
                const float ref = P->in[I_WIN][(size_t)k * IN_COLS + n] * P->in[I_MIXN][k];
                const float got = bf2f(((const bf16_t*)(wl + WO_IN))[(size_t)n * D + k]);
                if (!(fabsf(got - ref) <= 0.01f * fabsf(ref) + 1e-4f)) ok = false;
            } else if (mode == 4) {
                const int n = hsh % D;
                const float ref = P->in[I_X][(size_t)m * D + n]; const float got = bf2f(hb[(size_t)m * D + n]);
                if (!(fabsf(got - ref) <= 0.01f * fabsf(ref) + 1e-4f)) ok = false;
            }
        }
        const f32x4* xr = (const f32x4*)(P->in[I_X] + (size_t)m * D) + lane; f32x4* o = (f32x4*)(P->out + (size_t)m * D) + lane;
#pragma unroll
        for (int j = 0; j < 4; ++j) o[64 * j] = ok ? xr[64 * j] : (f32x4){0.f, 0.f, 0.f, 0.f};
    }
}

#define XB_TMO      128
#define XB_XCNT(j)  (256  + 64 * (j))
#define XB_XSUB(j)  (1280 + 64 * (j))
#define XB_XGEN(j)  (2304 + 64 * (j))
#define XB_TOP      3328
#define XB_TOPGEN   3392
#define XCD_BAR_WORDS 3456
#define XB_SPIN_CAP (1u << 22)
constexpr int CW_BAR = 8192;
constexpr int LDS_XB = LDS_BYTES - 64;
__device__ __forceinline__ unsigned xb_ld(unsigned* p)              { return __hip_atomic_load(p, __ATOMIC_RELAXED, __HIP_MEMORY_SCOPE_AGENT); }
__device__ __forceinline__ unsigned xb_add(unsigned* p, unsigned v) { return __hip_atomic_fetch_add(p, v, __ATOMIC_RELAXED, __HIP_MEMORY_SCOPE_AGENT); }
__device__ __forceinline__ unsigned xb_xcc_id() { return (unsigned)__builtin_amdgcn_s_getreg((3 << 11) | 20) & 0xFu; }
#define XB_SPIN(cond, bar) do { unsigned _sp = 0; while (cond) { __builtin_amdgcn_s_sleep(1); \
    if ((++_sp & 255u) == 0u) { if (xb_ld(&(bar)[XB_TMO])) break; if (_sp > XB_SPIN_CAP) { atomicAdd(&(bar)[XB_TMO], 1u); break; } } } } while (0)
struct XcdBarrier { unsigned* bar; unsigned x; volatile LAS unsigned* st; };
__device__ __forceinline__ XcdBarrier xcd_barrier_post(unsigned* bar, volatile LAS unsigned* st) {
    XcdBarrier b; b.bar = bar; b.x = xb_xcc_id(); b.st = st;
    if (threadIdx.x == 0) (void)xb_add(&bar[XB_XCNT(b.x)], 1u);
    return b;
}
__device__ __forceinline__ void xcd_barrier_complete(unsigned* bar, unsigned x, unsigned& nloc, unsigned& nx) {
    const unsigned G = gridDim.x * gridDim.y * gridDim.z;
    unsigned sum, cnt, mine, sp = 0u;
    for (;;) {
        sum = 0u; cnt = 0u; mine = 0u;
#pragma unroll
        for (unsigned j = 0; j < 16; ++j) { const unsigned c = xb_ld(&bar[XB_XCNT(j)]); sum += c; cnt += (c > 0u) ? 1u : 0u; mine = (j == x) ? c : mine; }
        if (sum == G) break;
        __builtin_amdgcn_s_sleep(1);
        if ((++sp & 255u) == 0u) { if (xb_ld(&bar[XB_TMO])) break; if (sp > XB_SPIN_CAP) { atomicAdd(&bar[XB_TMO], 1u); break; } }
    }
    nloc = mine > 0u ? mine : 1u; nx = cnt > 0u ? cnt : 1u;
}
__device__ __forceinline__ void xcd_barrier(const XcdBarrier& b) {
    asm volatile("s_waitcnt vmcnt(0)" ::: "memory");
    __syncthreads();
    if (threadIdx.x == 0) {
        unsigned* bar = b.bar;
        __builtin_amdgcn_s_waitcnt(0);
        unsigned nloc = b.st[0], nx = b.st[1];
        if (nloc == 0u) { xcd_barrier_complete(bar, b.x, nloc, nx); b.st[0] = nloc; b.st[1] = nx; }
        const unsigned old = xb_add(&bar[XB_XSUB(b.x)], 1u);
        const unsigned gen = old / nloc;
        if (old + 1u == (gen + 1u) * nloc) {
            __builtin_amdgcn_fence(__ATOMIC_RELEASE, "agent");
            asm volatile("s_waitcnt vmcnt(0)" ::: "memory");
            const unsigned og = xb_add(&bar[XB_TOP], 1u);
            const unsigned tg = og / nx;
            if (og + 1u == (tg + 1u) * nx) xb_add(&bar[XB_TOPGEN], 1u);
            else XB_SPIN(xb_ld(&bar[XB_TOPGEN]) == tg, bar);
            __builtin_amdgcn_fence(__ATOMIC_ACQUIRE, "agent");
            xb_add(&bar[XB_XGEN(b.x)], 1u);
            asm volatile("s_waitcnt vmcnt(0)" ::: "memory");
        } else {
            XB_SPIN(xb_ld(&bar[XB_XGEN(b.x)]) == gen, bar);
            __builtin_amdgcn_fence(__ATOMIC_ACQUIRE, "agent");
            asm volatile("s_waitcnt vmcnt(0)" ::: "memory");
        }
    }
    __syncthreads();
}

constexpr int N_PREP = 3;
constexpr int N_PHASES = N_PREP + 1 + 8 * DEPTH;

constexpr int PP_UNITS = (M / 256) * (D / 256), PP_Q1 = 4, PP_Q2 = 3;
__device__ __forceinline__ void run_pp_tail(const Ctx& C, KP KPp, unsigned char* ws, unsigned char* wl, int l, int bid, const int which) {
    const LAS int* tprefix = (const LAS int*)(C.lds + LDS_MISC);
    const int T = tprefix[32], R = (T + 63) >> 6, rem = T - 64 * (R - 1);
    const int U = (bid & 7) * 32 + (bid >> 3);
    const int nidle = 256 - 4 * rem, rank = U - 4 * rem;
    const int P1 = min(PP_UNITS, nidle * PP_Q1), P12 = min(PP_UNITS, P1 + nidle * PP_Q2);
    pg8::SubsetOrder S; S.B.init(M, D, C.G, bid); S.limit = PP_UNITS;
    if (which == 0) { S.first = rank; S.stride = nidle; S.count = rank >= 0 ? PP_Q1 : 0; }
    else if (which == 1) { S.first = P1 + rank; S.stride = nidle; S.count = rank >= 0 ? PP_Q2 : 0; }
    else { S.first = P12 + bid; S.stride = C.G; S.count = PP_UNITS; }
    pg8::EpiPP E{(bf16_t*)KPp->out + (size_t)M * D};
    pg8::gemm_phase(C.lds, (const bf16_t*)(ws + WS_PB) + (size_t)l * M * PLE, (const bf16_t*)(wl + WO_PP), PLE, S, E);
}

__device__ __forceinline__ void run_layer_phase(const Ctx& C, const int l_, const int sub) {
    KP KPp = (KP)__builtin_amdgcn_kernarg_segment_ptr(); asm volatile("" : "+s"(KPp));
    unsigned char* ws = KPp->ws;
    int bid = blockIdx.x; asm volatile("" : "+s"(bid));
    int l = l_; asm volatile("" : "+s"(l));
    unsigned char* wl = ws + WS_W + (size_t)l * W_LAYER;
    bf16_t* hb = (bf16_t*)(ws + WS_HB);
    if (sub == 0) {
        pg8::StaticOrder S; S.init(M, ZC, C.G, bid);
        pg8::EpiZ E{(bf16_t*)(ws + WS_Z), (const float*)(ws + WS_PART), NPART};
        pg8::gemm_phase(C.lds, l == 0 ? (const bf16_t*)hb : (const bf16_t*)KPp->out, (const bf16_t*)(wl + WO_IN), D, S, E);
    } else if (sub == 1) {
        phase_mix(KPp, C, ws, l, 0);
    } else if (sub == 8) {
        phase_mix(KPp, C, ws, l, 1);
    } else if (sub == 2) {
        pg8::StaticOrder S; S.init(M, D, C.G, bid);
        pg8::EpiRes E{l == 0 ? KPp->in[I_X] : (const float*)nullptr, (const bf16_t*)KPp->out, hb};
        pg8::gemm_phase(C.lds, (const bf16_t*)(ws + WS_Y), (const bf16_t*)(wl + WO_OUT), D, S, E);
    } else if (sub == 3) {
        phase_router(KPp, C, ws, l);
    } else if (sub == 4) {
        moe_prefix(KPp, C, ws, l);
        pg8::GroupedOrder<true> S{(const LAS int*)(C.lds + LDS_MISC), (const LAS int*)(C.lds + LDS_MISC + 256), (const int*)(ws + WS_CTL) + l * 64, (const int*)(ws + WS_TLIST), 1024, C.G, bid};
        pg8::EpiGU E{(bf16_t*)(ws + WS_HID), (const float*)(ws + WS_RLIST)};
        pg8::gemm_phase(C.lds, hb, (const bf16_t*)(wl + WO_GU), D, S, E);
        run_pp_tail(C, KPp, ws, wl, l, bid, 0);
    } else if (sub == 5) {
        moe_prefix(KPp, C, ws, l);
        pg8::GroupedOrder<false> S{(const LAS int*)(C.lds + LDS_MISC), (const LAS int*)(C.lds + LDS_MISC + 256), (const int*)(ws + WS_CTL) + l * 64, (const int*)(ws + WS_TLIST), 1024, C.G, bid};
        pg8::EpiDown E{(bf16_t*)(ws + WS_YS), (const float*)(ws + WS_GLIST), (const int*)(ws + WS_CTL) + l * 64};
        pg8::gemm_phase(C.lds, (const bf16_t*)(ws + WS_HID), (const bf16_t*)(wl + WO_D), FF, S, E);
        run_pp_tail(C, KPp, ws, wl, l, bid, 1);
    } else if (sub == 6) {
        moe_prefix(KPp, C, ws, l);
        phase_combine(KPp, C, ws, l);
        __syncthreads();
        run_pp_tail(C, KPp, ws, wl, l, bid, 2);
    } else {
        pg8::StaticOrder S; S.init(M, D, C.G, bid);
        pg8::EpiPle E{hb, l == DEPTH - 1 ? (bf16_t*)(ws + WS_Y) : (bf16_t*)KPp->out, (const bf16_t*)KPp->out + (size_t)M * D, (const float*)(ws + WS_RSP), (float*)(ws + WS_PART)};
        pg8::gemm_phase(C.lds, hb, (const bf16_t*)(wl + WO_PG), D, S, E);
    }
}

__global__ void __launch_bounds__(512, 2) mega(Params P) {
    extern __shared__ __attribute__((aligned(16))) unsigned char lds_raw[];
    Ctx C; C.lds = (LAS unsigned char*)lds_raw; C.tid = threadIdx.x; C.lane = C.tid & 63; C.wave = __builtin_amdgcn_readfirstlane(C.tid >> 6);
    C.G = gridDim.x; C.vcu = 0; C.bid = 0;
    cg::grid_group grid = cg::this_grid();
    const int lo = P.ph_lo, hi = P.ph_hi & 0xffff; const bool fin = (P.ph_hi >> 16) != 0;
    if (threadIdx.x < 2) ((LAS unsigned*)(lds_raw + LDS_XB))[threadIdx.x] = 0u;
    __syncthreads();
    const XcdBarrier xbar = xcd_barrier_post((unsigned*)(P.ws + WS_CTL) + CW_BAR, (volatile LAS unsigned*)((LAS unsigned char*)lds_raw + LDS_XB));
    if (lo < 0) grid.sync();
#define GSYNC() do { asm volatile("s_waitcnt vmcnt(0) lgkmcnt(0)" ::: "memory"); xcd_barrier(xbar); } while (0)
#ifdef TIMING
#define STAMP(k) do { if (blockIdx.x == 0 && threadIdx.x == 0) ((unsigned*)(P.ws + WS_CTL))[1024 + (k)] = (unsigned)__builtin_amdgcn_s_memrealtime(); } while (0)
#else
#define STAMP(k) do {} while (0)
#endif
#define PHASE(k, body) do { if (lo <= (k) && (k) < hi) { if ((k) > lo) GSYNC(); STAMP(k); body; } } while (0)
    PHASE(0, { KP KPp = (KP)__builtin_amdgcn_kernarg_segment_ptr(); asm volatile("" : "+s"(KPp)); phase_prep(KPp, C, KPp->ws, 1); phase_prep(KPp, C, KPp->ws, 0); phase_prep(KPp, C, KPp->ws, 2); });
#define LAYER_PHASE(l, sub) PHASE(N_PREP + 8 * (l) + (sub), run_layer_phase(C, l, sub))
#define MIX_PHASE(l) PHASE(N_PREP + 8 * (l) + 1, { run_layer_phase(C, l, 1); GSYNC(); run_layer_phase(C, l, 8); })
    LAYER_PHASE(0, 0); MIX_PHASE(0); LAYER_PHASE(0, 2); LAYER_PHASE(0, 3); LAYER_PHASE(0, 4); LAYER_PHASE(0, 5); LAYER_PHASE(0, 6); LAYER_PHASE(0, 7);
    LAYER_PHASE(1, 0); MIX_PHASE(1); LAYER_PHASE(1, 2); LAYER_PHASE(1, 3); LAYER_PHASE(1, 4); LAYER_PHASE(1, 5); LAYER_PHASE(1, 6); LAYER_PHASE(1, 7);
#ifdef DBG_MODE
    { GSYNC(); KP KPp = (KP)__builtin_amdgcn_kernarg_segment_ptr(); asm volatile("" : "+s"(KPp)); phase_dbg(KPp, C, KPp->ws, DBG_MODE); }
#endif
    if (fin || (lo <= N_PHASES - 1 && N_PHASES - 1 < hi)) { if (N_PHASES - 1 > lo) GSYNC(); STAMP(N_PHASES - 1); { KP KPp = (KP)__builtin_amdgcn_kernarg_segment_ptr(); asm volatile("" : "+s"(KPp)); phase_final(KPp, C, KPp->ws); } }
}

extern "C" void kernel_launch(void* const* d_in, const int* in_sizes, int n_in, void* d_out, int out_size, void* d_ws, size_t ws_size, hipStream_t stream) {
    static int grid = 0;
    if (grid == 0) {
        if (n_in != 35 || out_size != M * D || ws_size < WS_END) { fprintf(stderr, "kernel_launch: unexpected shapes (n_in %d out %d ws %zu)\n", n_in, out_size, ws_size); grid = -1; return; }
        int dev = 0, cus = 0, per_cu = 0;
        hipGetDevice(&dev); hipDeviceGetAttribute(&cus, hipDeviceAttributeMultiprocessorCount, dev);
        hipFuncSetAttribute((const void*)mega, hipFuncAttributeMaxDynamicSharedMemorySize, LDS_BYTES);
        hipOccupancyMaxActiveBlocksPerMultiprocessor(&per_cu, (const void*)mega, 512, LDS_BYTES);
        (void)hipGetLastError();
        if (per_cu < 1 || cus != 256) { fprintf(stderr, "kernel_launch: occupancy %d per CU, %d CUs: unsupported\n", per_cu, cus); grid = -1; return; }
        grid = 256;
    }
    if (grid < 0) return;
    hipMemsetAsync((char*)d_ws + WS_CTL, 0, CTL_BYTES, stream);
    Params p{};
    for (int i = 0; i < 35; ++i) p.in[i] = (const float*)d_in[i];
    p.out = (float*)d_out; p.ws = (unsigned char*)d_ws;
#if MK_N_LAUNCHES == 1
    p.ph_lo = 0; p.ph_hi = (N_PHASES < PH_STOP ? N_PHASES : (PH_STOP | (DBG_FIN << 16)));
    { void* args[] = {&p}; hipLaunchCooperativeKernel((const void*)mega, dim3(grid), dim3(512), args, LDS_BYTES, stream); }
#else
    for (int ph = 0; ph < N_PHASES; ++ph) { p.ph_lo = ph; p.ph_hi = ph + 1; void* args[] = {&p}; hipLaunchCooperativeKernel((const void*)mega, dim3(grid), dim3(512), args, LDS_BYTES, stream); }
#endif
}
```

```cpp
#include <hip/hip_runtime.h>
#include <hip/hip_cooperative_groups.h>
#include <cstdio>
#include <cstdint>
namespace cg = cooperative_groups;

#define LAS __attribute__((address_space(3)))
typedef unsigned short bf16_t;
typedef short bf16x8 __attribute__((ext_vector_type(8)));
typedef float f32x4 __attribute__((ext_vector_type(4)));
typedef float f32x2 __attribute__((ext_vector_type(2)));
typedef unsigned u32x4 __attribute__((ext_vector_type(4)));
typedef unsigned u32x2 __attribute__((ext_vector_type(2)));

#ifndef PREP_REP
#define PREP_REP 1
#endif
#ifndef P2_MASK
#define P2_MASK 15
#endif
#ifndef RT_STOP
#define RT_STOP 1
#endif
#ifndef RT_TR
#define RT_TR 63
#endif
#ifndef TR_MASK
#define TR_MASK 63
#endif
#ifndef PREP_MASK
#define PREP_MASK 7
#endif
#define BLK_LO 0
#define BLK_HI 0
#define DBG_FIN 1
#define TIM_A0 5
#define TIM_A1 6
#define TIM_B0 6
#define TIM_B1 7
#ifndef PH_STOP
#define PH_STOP 99
#endif
#ifndef PH_MASK
#define PH_MASK 0xFFFF
#endif
#define PH_ON(k) ((PH_MASK >> (k)) & 1)
#ifndef MK_N_LAUNCHES
#define MK_N_LAUNCHES 1
#endif

constexpr int BATCH = 32, SEQ = 2048, M = BATCH * SEQ, D = 1024, DEPTH = 2;
constexpr int CONVC = 512, CONVW = 31, RC = 512, NH = 8, HS = 64;
constexpr int LW = 32, LA = 32, LV = 32, LG = 96;
constexpr int RWKV_IN = 3 * RC + LW + LA + LG;
constexpr int IN_COLS = 2 * CONVC + RWKV_IN;
constexpr int ZC = 2816;
constexpr int ZC_R = 1024, ZC_K = 1536, ZC_V = 2048, ZC_WLO = 2560, ZC_ALO = 2592, ZC_GLO = 2624, ZC_EA = 2720, ZC_EB = 2752;
constexpr int NG = 4, EPG = 8, NE = 32, FF = 512, PLE = 256, NRT = 36;
constexpr int LCAP = 65536;
constexpr int MAXSLOT = 2 * M + NE * 256;
constexpr int NPART = 16;

constexpr size_t MiB = 1u << 20;
constexpr size_t WS_CTL = 0;
constexpr size_t CTL_BYTES = 1 * MiB;
constexpr size_t WS_WR = 1 * MiB;
constexpr size_t WS_PART = 2 * MiB;
constexpr size_t WS_RSF = 6 * MiB;
constexpr size_t WS_RSP = 6 * MiB + 512 * 1024;
constexpr size_t WS_TSLOT = 7 * MiB;
constexpr size_t WS_GLIST = 8 * MiB;
constexpr size_t WS_TLIST = 16 * MiB;
constexpr size_t WS_RLIST = 976 * MiB;
constexpr size_t WS_W = 24 * MiB;
constexpr size_t W_LAYER = 107 * MiB;
constexpr size_t WO_IN = 0;
constexpr size_t WO_OUT = 6 * MiB;
constexpr size_t WO_GU = 8 * MiB;
constexpr size_t WO_D = 72 * MiB;
constexpr size_t WO_PG = 104 * MiB;
constexpr size_t WO_PP = 106 * MiB;
constexpr size_t WS_HB = 238 * MiB;
constexpr size_t WS_VF = 366 * MiB;
constexpr size_t WS_PB = 430 * MiB;
constexpr size_t WS_R = 494 * MiB;
constexpr size_t WS_Z = WS_R;
constexpr size_t WS_Y = WS_R + 352 * MiB;
constexpr size_t WS_HID = WS_R;
constexpr size_t WS_YS = WS_R + 144 * MiB;
constexpr size_t WS_PP = WS_R;
constexpr size_t WS_LR = 984 * MiB;
constexpr int LRC = 192;
constexpr size_t WS_END = 1008 * MiB;
static_assert(WS_W + 2 * W_LAYER <= WS_HB && WS_YS + (size_t)MAXSLOT * D * 2 <= WS_END && WS_HID + (size_t)MAXSLOT * FF * 2 <= WS_YS, "ws map");

constexpr int LDS_BYTES = 150 * 1024;
constexpr int LDS_MISC = 131072;

__device__ __forceinline__ float bf2f(bf16_t b) { return __uint_as_float(((unsigned)b) << 16); }
__device__ __forceinline__ unsigned f2bf(float f) { unsigned u = __float_as_uint(f); return (u + 0x7fffu + ((u >> 16) & 1u)) >> 16; }
typedef __bf16 bf16v2_t __attribute__((ext_vector_type(2)));
__device__ __forceinline__ unsigned cvtpk(float lo, float hi) { const f32x2 f = {lo, hi}; const bf16v2_t b = __builtin_convertvector(f, bf16v2_t); return __builtin_bit_cast(unsigned, b); }
__device__ __forceinline__ unsigned pk2(float lo, float hi) { return cvtpk(lo, hi); }
__device__ __forceinline__ unsigned cvt_pk_bf16(float lo, float hi) { unsigned r; asm volatile("v_cvt_pk_bf16_f32 %0, %1, %2" : "=v"(r) : "v"(lo), "v"(hi)); return r; }
__device__ __forceinline__ f32x4 unpk4(u32x2 w) { return (f32x4){__uint_as_float(w.x << 16), __uint_as_float(w.x & 0xffff0000u), __uint_as_float(w.y << 16), __uint_as_float(w.y & 0xffff0000u)}; }
__device__ __forceinline__ float sigmoidf_(float x) { return __builtin_amdgcn_rcpf(1.0f + __expf(-x)); }
__device__ __forceinline__ float tanhf_(float x) { return 1.0f - 2.0f * __builtin_amdgcn_rcpf(1.0f + __expf(2.0f * x)); }
__device__ __forceinline__ float wave_sum(float v) {
#pragma unroll
    for (int o = 1; o < 64; o <<= 1) v += __shfl_xor(v, o);
    return v;
}
__device__ __forceinline__ float red16(float v) {
#pragma unroll
    for (int o = 1; o < 16; o <<= 1) v += __shfl_xor(v, o);
    return v;
}
__device__ __forceinline__ float red8(float v) {
#pragma unroll
    for (int o = 1; o < 8; o <<= 1) v += __shfl_xor(v, o);
    return v;
}

__device__ __forceinline__ float dpp_add(float x, const int ctrl_sel) {
    int v = __builtin_bit_cast(int, x), r;
    if (ctrl_sel == 0) r = __builtin_amdgcn_update_dpp(v, v, 0xB1, 0xf, 0xf, true);
    else if (ctrl_sel == 1) r = __builtin_amdgcn_update_dpp(v, v, 0x4E, 0xf, 0xf, true);
    else if (ctrl_sel == 2) r = __builtin_amdgcn_update_dpp(v, v, 0x141, 0xf, 0xf, true);
    else r = __builtin_amdgcn_update_dpp(v, v, 0x140, 0xf, 0xf, true);
    return x + __builtin_bit_cast(float, r);
}
__device__ __forceinline__ float sum8(float x) { x = dpp_add(x, 0); x = dpp_add(x, 1); x = dpp_add(x, 2); return x; }
__device__ __forceinline__ float sum16(float x) { x = sum8(x); x = dpp_add(x, 3); return x; }


#ifndef PG8_SP2_MASK
#define PG8_SP2_MASK 0x2f
#endif
#ifndef PG8_SP2
#define PG8_SP2 true
#endif
namespace pg8 {
constexpr int BM = 256, BK = 64, HALF = 128, HTB = HALF * BK * 2, STAGE_BYTES = 8 * HTB, NXCD = 8, WGM = 8;
__host__ __device__ __forceinline__ int lds_byte(int r, int c) { const int st = (r >> 4) * 2 + (c >> 5), rr = r & 15, cc = c & 31, ob = rr * 64 + cc * 2; return st * 1024 + (ob ^ (((ob >> 9) & 1) << 5)); }
__host__ __device__ __forceinline__ void stage_rc(int b, int& R, int& C) { const int st = b / 1024, sb = b % 1024, swz = sb ^ (((sb >> 9) & 1) << 5); R = (st >> 1) * 16 + swz / 64; C = (st & 1) * 32 + (swz % 64) / 2; }
__host__ __device__ __forceinline__ int perm32(int rho) { const int n = rho >> 4, i = rho & 15; return 8 * (i >> 2) + 4 * n + (i & 3); }

struct Unit { int arow, brow, orow, ocol, e, mt; };

struct StaticOrder {
    static constexpr bool GATHER = false;
    int nM, nN, nwg, G, c;
    __device__ void init(int M_, int N_, int G_, int c_) { nM = M_ / BM; nN = N_ / BM; nwg = nM * nN; G = G_; c = c_; }
    __device__ bool next(int i, Unit& u) const { return at((long)i * G + c, u); }
    __device__ bool at(const long L, Unit& u) const {
        if (L >= nwg) return false;
        int wgid = (int)L; { const int q = nwg / NXCD, r = nwg % NXCD, xcd = wgid % NXCD, off = wgid / NXCD; wgid = (xcd < r ? xcd * (q + 1) : r * (q + 1) + (xcd - r) * q) + off; }
        const int nig = WGM * nN, gid = wgid / nig, fm = gid * WGM, gsz = (nM - fm) < WGM ? (nM - fm) : WGM;
        const int pm = fm + ((wgid % nig) % gsz), pn = (wgid % nig) / gsz;
        u.arow = pm * BM; u.brow = pn * BM; u.orow = pm * BM; u.ocol = pn * BM; u.e = 0; u.mt = pm; return true;
    }
    __device__ __forceinline__ unsigned tok(const Unit&, int) const { return 0u; }
};

struct SubsetOrder {
    static constexpr bool GATHER = false;
    StaticOrder B; int first, stride, count, limit;
    __device__ bool next(int i, Unit& u) const { if (i >= count) return false; const int L = first + i * stride; if (L >= limit) return false; return B.at(L, u); }
    __device__ __forceinline__ unsigned tok(const Unit&, int) const { return 0u; }
};

template <bool GATHER_> struct GroupedOrder {
    static constexpr bool GATHER = GATHER_;
    const LAS int* tprefix;
    const LAS int* pstart;
    const int* cnt;
    const int* tlist;
    int brows;
    int G, c;
    __device__ bool next(int i, Unit& u) const {
        const int q = c & 7, j = c >> 3;
        const int U = q * 32 + j;
        const int mtg = i * 64 + (U >> 2), nt = U & 3;
        const int total = tprefix[32];
        if (mtg >= total) return false;
        int e = 0;
#pragma unroll 1
        for (int s = 16; s >= 1; s >>= 1) { if (tprefix[e + s] <= mtg) e += s; }
        const int mt = mtg - tprefix[e];
        u.e = e; u.mt = mt; u.arow = pstart[e] + mt * BM; u.orow = u.arow; u.brow = e * brows + nt * BM; u.ocol = nt * BM; return true;
    }
    __device__ __forceinline__ unsigned tok(const Unit& u, int r) const {
        const int pos = u.mt * BM + r;
        const unsigned t = (unsigned)tlist[u.e * LCAP + pos]; const int c = cnt[u.e];
        return pos < c ? t : 0u;
    }
};

template <class Epi, class Sched>
__device__ __forceinline__ void gemm_phase(LAS unsigned char* lds, const bf16_t* Ag, const bf16_t* Btg, const int K, const Sched& S, const Epi& E) {
    int tid_ = threadIdx.x; asm volatile("" : "+v"(tid_));
    const int tid = tid_, wid = __builtin_amdgcn_readfirstlane(tid >> 6), lane = tid & 63, wr = wid >> 2, wc = wid & 3, fr = lane & 15, fq = lane >> 4;
    constexpr bool SP2 = PG8_SP2 && Epi::SP2;
    const int nt = K / BK;
    unsigned voffA[2], voffB[2]; int Rr[2], Cc[2];
#pragma unroll
    for (int i = 0; i < 2; ++i) { int R, C; stage_rc(tid * 16 + i * 8192, R, C); Rr[i] = R; Cc[i] = C; const int Rb = Epi::PERM ? ((R & ~31) + perm32(R & 31)) : R;
        voffA[i] = (unsigned)(R * K + C) * 2u; voffB[i] = (unsigned)(Rb * K + C) * 2u; }
    const size_t kstep = (size_t)(BK * 2);
    const size_t hstep = (size_t)HALF * K * 2;
    const size_t rowb = (size_t)K * 2;
    const unsigned ldsw = (unsigned)wid * 1024u;
    const int aoff = lds_byte(wr * 64 + fr, fq * 8), boff = lds_byte(wc * 32 + fr, fq * 8);
    unsigned gc[2][2], gn[2][2];
#pragma unroll
    for (int h = 0; h < 2; ++h)
#pragma unroll
        for (int i = 0; i < 2; ++i) { gc[h][i] = 0u; gn[h][i] = 0u; }
#define PG8_SA(b, h) (((b) * 2 + (h)) * HTB)
#define PG8_SB(b, h) ((4 + (b) * 2 + (h)) * HTB)
#define PG8_GLDS(src, bufoff, i) __builtin_amdgcn_global_load_lds((const unsigned*)(src), (LAS unsigned*)(lds + (bufoff) + ldsw + (i) * 8192), 16, 0, 0)
#define PG8_STAGE_B(bufoff, gbase) do { _Pragma("unroll") for (int _i = 0; _i < 2; ++_i) PG8_GLDS((const char*)(gbase) + voffB[_i], bufoff, _i); } while (0)
#define PG8_STAGE_A(bufoff, gbase, h, usenext) do { _Pragma("unroll") for (int _i = 0; _i < 2; ++_i) { \
        if constexpr (Sched::GATHER) { const unsigned _o = (usenext) ? gn[h][_i] : gc[h][_i]; PG8_GLDS((const char*)(gbase) + _o, bufoff, _i); } \
        else { PG8_GLDS((const char*)(gbase) + (h) * hstep + voffA[_i], bufoff, _i); } } } while (0)
#define PG8_LDA(dst, b, h) do { _Pragma("unroll") for (int m = 0; m < 4; ++m) _Pragma("unroll") for (int k = 0; k < 2; ++k) dst[m][k] = *(const LAS bf16x8*)(lds + PG8_SA(b, h) + aoff + m * 2048 + k * 1024); } while (0)
#define PG8_LDB(dst, b, h) do { _Pragma("unroll") for (int n = 0; n < 2; ++n) _Pragma("unroll") for (int k = 0; k < 2; ++k) dst[n][k] = *(const LAS bf16x8*)(lds + PG8_SB(b, h) + boff + n * 2048 + k * 1024); } while (0)
#define PG8_MMA(ai, bj, At, Bt) do { __builtin_amdgcn_s_setprio(1); _Pragma("unroll") for (int m = 0; m < 4; ++m) _Pragma("unroll") for (int n = 0; n < 2; ++n) _Pragma("unroll") for (int k = 0; k < 2; ++k) \
        acc[ai][bj][m][n] = __builtin_amdgcn_mfma_f32_16x16x32_bf16(Bt[n][k], At[m][k], acc[ai][bj][m][n], 0, 0, 0); __builtin_amdgcn_s_setprio(0); } while (0)
#define PG8_WAIT_V(n) asm volatile("s_waitcnt vmcnt(" #n ")" ::: "memory")
#define PG8_WAIT_L(n) asm volatile("s_waitcnt lgkmcnt(" #n ")" ::: "memory")
#define PG8_BAR __builtin_amdgcn_s_barrier()
#define PG8_SCHED __builtin_amdgcn_sched_barrier(0)
    Unit cur, nxt; int ui = 0;
    if (!S.next(0, cur)) return;
    f32x4 acc[2][2][4][2];
#pragma unroll
    for (int a = 0; a < 2; ++a)
#pragma unroll
        for (int b = 0; b < 2; ++b)
#pragma unroll
            for (int m = 0; m < 4; ++m)
#pragma unroll
                for (int n = 0; n < 2; ++n) acc[a][b][m][n] = (f32x4){0.f, 0.f, 0.f, 0.f};
    bf16x8 At[4][2], B0[2][2], B1[2][2];
    const char* cA; const char* cB = (const char*)Btg + (size_t)cur.brow * rowb;
    if constexpr (Sched::GATHER) {
        cA = (const char*)Ag;
#pragma unroll
        for (int h = 0; h < 2; ++h)
#pragma unroll
            for (int i = 0; i < 2; ++i) gc[h][i] = S.tok(cur, h * HALF + Rr[i]) * (unsigned)rowb + (unsigned)Cc[i] * 2u;
    } else cA = (const char*)Ag + (size_t)cur.arow * rowb;
    if constexpr (SP2) {
        PG8_STAGE_B(PG8_SB(0, 0), cB); PG8_STAGE_B(PG8_SB(0, 1), cB + hstep); PG8_STAGE_A(PG8_SA(0, 0), cA, 0, false); PG8_STAGE_A(PG8_SA(0, 1), cA, 1, false);
        if (wr == 1) PG8_BAR;
        PG8_WAIT_V(2); PG8_BAR;
        PG8_STAGE_B(PG8_SB(1, 0), cB + kstep); PG8_STAGE_A(PG8_SA(1, 0), cA + kstep, 0, false); PG8_STAGE_B(PG8_SB(1, 1), cB + hstep + kstep);
        PG8_WAIT_V(6); PG8_BAR;
    } else {
        PG8_STAGE_B(PG8_SB(0, 0), cB); PG8_STAGE_A(PG8_SA(0, 0), cA, 0, false); PG8_STAGE_B(PG8_SB(0, 1), cB + hstep); PG8_STAGE_A(PG8_SA(0, 1), cA, 1, false);
        if (wr == 1) PG8_BAR;
        PG8_WAIT_V(4); PG8_BAR;
        PG8_STAGE_B(PG8_SB(1, 0), cB + kstep); PG8_STAGE_A(PG8_SA(1, 0), cA + kstep, 0, false); PG8_STAGE_B(PG8_SB(1, 1), cB + hstep + kstep);
        PG8_WAIT_V(6); PG8_BAR;
    }
    for (;;) {
        const bool has_next = S.next(ui + 1, nxt);
        const char* nA; const char* nB = has_next ? (const char*)Btg + (size_t)nxt.brow * rowb : cB;
        if constexpr (Sched::GATHER) {
            nA = cA;
#pragma unroll
            for (int h = 0; h < 2; ++h)
#pragma unroll
                for (int i = 0; i < 2; ++i) gn[h][i] = has_next ? (S.tok(nxt, h * HALF + Rr[i]) * (unsigned)rowb + (unsigned)Cc[i] * 2u) : gc[h][i];
        } else nA = has_next ? (const char*)Ag + (size_t)nxt.arow * rowb : cA;
        for (int t = 0; t < nt; t += 2) {
            const bool last = (t == nt - 2);
            const char* a1 = cA + (size_t)(t + 1) * kstep;
            const char* a2 = last ? nA : cA + (size_t)(t + 2) * kstep; const char* b2 = last ? nB : cB + (size_t)(t + 2) * kstep;
            const char* a3 = a2 + kstep; const char* b3 = b2 + kstep;
            if constexpr (SP2) {
            PG8_LDB(B0, 0, 0); PG8_LDB(B1, 0, 1); PG8_SCHED; PG8_LDA(At, 0, 0); PG8_STAGE_A(PG8_SA(1, 1), a1, 1, false);
            PG8_WAIT_V(8); PG8_WAIT_L(0); PG8_BAR; PG8_MMA(0, 0, At, B0); PG8_MMA(0, 1, At, B1); PG8_BAR; PG8_SCHED;
            PG8_LDA(At, 0, 1); PG8_STAGE_B(PG8_SB(0, 0), b2); PG8_STAGE_B(PG8_SB(0, 1), b2 + hstep); PG8_STAGE_A(PG8_SA(0, 0), a2, 0, last);
            PG8_WAIT_V(8); PG8_WAIT_L(0); PG8_BAR; PG8_MMA(1, 0, At, B0); PG8_MMA(1, 1, At, B1); PG8_BAR; PG8_SCHED;
            PG8_LDB(B0, 1, 0); PG8_LDB(B1, 1, 1); PG8_SCHED; PG8_LDA(At, 1, 0); PG8_STAGE_A(PG8_SA(0, 1), a2, 1, last);
            PG8_WAIT_V(8); PG8_WAIT_L(0); PG8_BAR; PG8_MMA(0, 0, At, B0); PG8_MMA(0, 1, At, B1); PG8_BAR; PG8_SCHED;
            PG8_LDA(At, 1, 1); PG8_STAGE_B(PG8_SB(1, 0), b3); PG8_STAGE_B(PG8_SB(1, 1), b3 + hstep); PG8_STAGE_A(PG8_SA(1, 0), a3, 0, last);
            PG8_WAIT_V(8); PG8_WAIT_L(0); PG8_BAR; PG8_MMA(1, 0, At, B0); PG8_MMA(1, 1, At, B1); PG8_BAR; PG8_SCHED;
            } else {
            PG8_LDB(B0, 0, 0); PG8_SCHED; PG8_LDA(At, 0, 0); PG8_STAGE_A(PG8_SA(1, 1), a1, 1, false);
            PG8_WAIT_L(8); PG8_BAR; PG8_WAIT_L(0); PG8_MMA(0, 0, At, B0); PG8_BAR; PG8_SCHED;
            PG8_LDB(B1, 0, 1); PG8_STAGE_B(PG8_SB(0, 0), b2);
            PG8_BAR; PG8_WAIT_L(0); PG8_MMA(0, 1, At, B1); PG8_BAR;
            PG8_LDA(At, 0, 1); PG8_STAGE_A(PG8_SA(0, 0), a2, 0, last);
            PG8_BAR; PG8_WAIT_L(0); PG8_MMA(1, 0, At, B0); PG8_BAR; PG8_SCHED;
            PG8_STAGE_B(PG8_SB(0, 1), b2 + hstep);
            PG8_WAIT_V(6); PG8_BAR; PG8_MMA(1, 1, At, B1); PG8_BAR;
            PG8_LDB(B0, 1, 0); PG8_SCHED; PG8_LDA(At, 1, 0); PG8_STAGE_A(PG8_SA(0, 1), a2, 1, last);
            PG8_WAIT_L(8); PG8_BAR; PG8_WAIT_L(0); PG8_MMA(0, 0, At, B0); PG8_BAR; PG8_SCHED;
            PG8_LDB(B1, 1, 1); PG8_STAGE_B(PG8_SB(1, 0), b3);
            PG8_BAR; PG8_WAIT_L(0); PG8_MMA(0, 1, At, B1); PG8_BAR;
            PG8_LDA(At, 1, 1); PG8_STAGE_A(PG8_SA(1, 0), a3, 0, last);
            PG8_BAR; PG8_WAIT_L(0); PG8_MMA(1, 0, At, B0); PG8_BAR; PG8_SCHED;
            PG8_STAGE_B(PG8_SB(1, 1), b3 + hstep);
            PG8_WAIT_V(6); PG8_BAR; PG8_MMA(1, 1, At, B1); PG8_BAR;
            }
        }
        if (wr == 0) PG8_BAR;
        E(acc, cur, S, wr, wc, fr, fq);
        if (!has_next) break;
#pragma unroll
        for (int a = 0; a < 2; ++a)
#pragma unroll
            for (int b = 0; b < 2; ++b)
#pragma unroll
                for (int m = 0; m < 4; ++m)
#pragma unroll
                    for (int n = 0; n < 2; ++n) acc[a][b][m][n] = (f32x4){0.f, 0.f, 0.f, 0.f};
        cur = nxt; cA = nA; cB = nB; ++ui;
        if (wr == 1) PG8_BAR;
        if constexpr (Sched::GATHER) {
#pragma unroll
            for (int h = 0; h < 2; ++h)
#pragma unroll
                for (int i = 0; i < 2; ++i) gc[h][i] = gn[h][i];
        }
    }
    PG8_WAIT_V(0);
    PG8_BAR;
#undef PG8_SA
#undef PG8_SB
#undef PG8_GLDS
#undef PG8_STAGE_A
#undef PG8_STAGE_B
#undef PG8_LDA
#undef PG8_LDB
#undef PG8_MMA
#undef PG8_WAIT_V
#undef PG8_WAIT_L
#undef PG8_BAR
#undef PG8_SCHED
}


struct EpiZ {
    static constexpr bool PERM = true;
    static constexpr bool SP2 = ((PG8_SP2_MASK) >> 0) & 1;
    bf16_t* Z; const float* part; int npart;
    template <class S_> __device__ __forceinline__ void operator()(const f32x4 (&acc)[2][2][4][2], const Unit& u, const S_&, int wr, int wc, int fr, int fq) const {
        const int row0 = u.orow + wr * 64 + fr, col0 = u.ocol + wc * 32 + 8 * fq;
        float rs8[8];
#pragma unroll
        for (int r = 0; r < 8; ++r) { const int row = row0 + (r >> 2) * HALF + (r & 3) * 16;
            const f32x4* pp4 = (const f32x4*)(part + (size_t)row * NPART); const f32x4 p0 = pp4[0], p1 = pp4[1], p2 = pp4[2], p3 = pp4[3];
            const float ss = ((p0[0] + p0[1]) + (p0[2] + p0[3])) + ((p1[0] + p1[1]) + (p1[2] + p1[3])) + ((p2[0] + p2[1]) + (p2[2] + p2[3])) + ((p3[0] + p3[1]) + (p3[2] + p3[3]));
            rs8[r] = rsqrtf(ss * (1.0f / D) + 1e-6f); }
        if (u.ocol < 2 * CONVC) {
            const int ch0 = (u.ocol >> 8) * 128 + wc * 32 + 8 * fq;
#pragma unroll
            for (int ai = 0; ai < 2; ++ai)
#pragma unroll
                for (int m = 0; m < 4; ++m) {
                    const int row = row0 + ai * HALF + m * 16; const float rs = rs8[ai * 4 + m];
                    const f32x4 v0 = acc[ai][0][m][0] * rs, v1 = acc[ai][0][m][1] * rs, g0 = acc[ai][1][m][0] * rs, g1 = acc[ai][1][m][1] * rs;
                    float o[8];
#pragma unroll
                    for (int j = 0; j < 4; ++j) { o[j] = v0[j] * sigmoidf_(g0[j]); o[4 + j] = v1[j] * sigmoidf_(g1[j]); }
                    u32x4 w; w.x = cvt_pk_bf16(o[0], o[1]); w.y = cvt_pk_bf16(o[2], o[3]); w.z = cvt_pk_bf16(o[4], o[5]); w.w = cvt_pk_bf16(o[6], o[7]);
                    *(u32x4*)(Z + (size_t)row * ZC + ch0) = w; }
            return;
        }
#pragma unroll
        for (int ai = 0; ai < 2; ++ai)
#pragma unroll
            for (int m = 0; m < 4; ++m) {
                const int row = row0 + ai * HALF + m * 16; const float rs = rs8[ai * 4 + m];
                bf16_t* rowp = Z + (size_t)row * ZC + col0;
#pragma unroll
                for (int bj = 0; bj < 2; ++bj) { const f32x4 v0 = acc[ai][bj][m][0] * rs, v1 = acc[ai][bj][m][1] * rs;
                    u32x4 w; w.x = cvt_pk_bf16(v0[0], v0[1]); w.y = cvt_pk_bf16(v0[2], v0[3]); w.z = cvt_pk_bf16(v1[0], v1[1]); w.w = cvt_pk_bf16(v1[2], v1[3]);
                    *(u32x4*)(rowp + bj * HALF) = w; } }
    }
};
struct EpiRes {
    static constexpr bool PERM = true;
    static constexpr bool SP2 = ((PG8_SP2_MASK) >> 1) & 1;
    const float* hin32; const bf16_t* hin16; bf16_t* hb;
    template <class S_> __device__ __forceinline__ void operator()(const f32x4 (&acc)[2][2][4][2], const Unit& u, const S_&, int wr, int wc, int fr, int fq) const {
        const int row0 = u.orow + wr * 64 + fr, col0 = u.ocol + wc * 32 + 8 * fq;
        if (hin32) {
#pragma unroll
            for (int ai = 0; ai < 2; ++ai) {
                f32x4 r[4][2][2];
#pragma unroll
                for (int m = 0; m < 4; ++m)
#pragma unroll
                    for (int bj = 0; bj < 2; ++bj) { const size_t off = (size_t)(row0 + ai * HALF + m * 16) * D + col0 + bj * HALF; r[m][bj][0] = *(const f32x4*)(hin32 + off); r[m][bj][1] = *(const f32x4*)(hin32 + off + 4); }
#pragma unroll
                for (int m = 0; m < 4; ++m)
#pragma unroll
                    for (int bj = 0; bj < 2; ++bj) { const size_t off = (size_t)(row0 + ai * HALF + m * 16) * D + col0 + bj * HALF;
                        const f32x4 v0 = acc[ai][bj][m][0] + r[m][bj][0], v1 = acc[ai][bj][m][1] + r[m][bj][1];
                        u32x4 w; w.x = cvt_pk_bf16(v0[0], v0[1]); w.y = cvt_pk_bf16(v0[2], v0[3]); w.z = cvt_pk_bf16(v1[0], v1[1]); w.w = cvt_pk_bf16(v1[2], v1[3]);
                        *(u32x4*)(hb + off) = w; }
            }
        } else {
            u32x4 pw[2][4][2];
#pragma unroll
            for (int ai = 0; ai < 2; ++ai)
#pragma unroll
                for (int m = 0; m < 4; ++m)
#pragma unroll
                    for (int bj = 0; bj < 2; ++bj) pw[ai][m][bj] = *(const u32x4*)(hin16 + (size_t)(row0 + ai * HALF + m * 16) * D + col0 + bj * HALF);
#pragma unroll
            for (int ai = 0; ai < 2; ++ai)
#pragma unroll
                for (int m = 0; m < 4; ++m)
#pragma unroll
                    for (int bj = 0; bj < 2; ++bj) { const u32x4 p = pw[ai][m][bj];
                        const f32x4 r0 = (f32x4){__uint_as_float(p.x << 16), __uint_as_float(p.x & 0xffff0000u), __uint_as_float(p.y << 16), __uint_as_float(p.y & 0xffff0000u)};
                        const f32x4 r1 = (f32x4){__uint_as_float(p.z << 16), __uint_as_float(p.z & 0xffff0000u), __uint_as_float(p.w << 16), __uint_as_float(p.w & 0xffff0000u)};
                        const f32x4 v0 = acc[ai][bj][m][0] + r0, v1 = acc[ai][bj][m][1] + r1;
                        u32x4 w; w.x = cvt_pk_bf16(v0[0], v0[1]); w.y = cvt_pk_bf16(v0[2], v0[3]); w.z = cvt_pk_bf16(v1[0], v1[1]); w.w = cvt_pk_bf16(v1[2], v1[3]);
                        *(u32x4*)(hb + (size_t)(row0 + ai * HALF + m * 16) * D + col0 + bj * HALF) = w; }
        }
    }
};
struct EpiGU {
    static constexpr bool PERM = true;
    static constexpr bool SP2 = ((PG8_SP2_MASK) >> 2) & 1;
    bf16_t* hid; const float* rlist;
    template <class S_> __device__ __forceinline__ void operator()(const f32x4 (&acc)[2][2][4][2], const Unit& u, const S_& S, int wr, int wc, int fr, int fq) const {
        const int rl0 = wr * 64 + fr, col0 = (u.ocol >> 1) + wc * 32 + 8 * fq;
        float rs8[8];
#pragma unroll
        for (int r = 0; r < 8; ++r) rs8[r] = rlist[u.e * LCAP + u.mt * BM + rl0 + (r >> 2) * HALF + (r & 3) * 16];
#pragma unroll
        for (int ai = 0; ai < 2; ++ai)
#pragma unroll
            for (int m = 0; m < 4; ++m) {
                const int rl = rl0 + ai * HALF + m * 16;
                const float rs = rs8[ai * 4 + m];
                const f32x4 g0 = acc[ai][0][m][0] * rs, g1 = acc[ai][0][m][1] * rs, u0 = acc[ai][1][m][0] * rs, u1 = acc[ai][1][m][1] * rs;
                float o[8];
#pragma unroll
                for (int j = 0; j < 4; ++j) { o[j] = g0[j] * sigmoidf_(g0[j]) * u0[j]; o[4 + j] = g1[j] * sigmoidf_(g1[j]) * u1[j]; }
                u32x4 w; w.x = cvt_pk_bf16(o[0], o[1]); w.y = cvt_pk_bf16(o[2], o[3]); w.z = cvt_pk_bf16(o[4], o[5]); w.w = cvt_pk_bf16(o[6], o[7]);
                *(u32x4*)(hid + (size_t)(u.orow + rl) * FF + col0) = w; }
    }
};
struct EpiDown {
    static constexpr bool PERM = true;
    static constexpr bool SP2 = ((PG8_SP2_MASK) >> 3) & 1;
    bf16_t* ys; const float* glist; const int* cnt;
    template <class S_> __device__ __forceinline__ void operator()(const f32x4 (&acc)[2][2][4][2], const Unit& u, const S_&, int wr, int wc, int fr, int fq) const {
        const int rl0 = wr * 64 + fr, col0 = u.ocol + wc * 32 + 8 * fq; const int ce = cnt[u.e];
        float g8[8];
#pragma unroll
        for (int r = 0; r < 8; ++r) { const int pos = u.mt * BM + rl0 + (r >> 2) * HALF + (r & 3) * 16; g8[r] = glist[u.e * LCAP + pos]; if (pos >= ce) g8[r] = 0.f; }
#pragma unroll
        for (int ai = 0; ai < 2; ++ai)
#pragma unroll
            for (int m = 0; m < 4; ++m) {
                const int rl = rl0 + ai * HALF + m * 16;
                const float g = g8[ai * 4 + m];
                bf16_t* rowp = ys + (size_t)(u.orow + rl) * D + col0;
#pragma unroll
                for (int bj = 0; bj < 2; ++bj) { const f32x4 v0 = acc[ai][bj][m][0] * g, v1 = acc[ai][bj][m][1] * g;
                    u32x4 w; w.x = cvt_pk_bf16(v0[0], v0[1]); w.y = cvt_pk_bf16(v0[2], v0[3]); w.z = cvt_pk_bf16(v1[0], v1[1]); w.w = cvt_pk_bf16(v1[2], v1[3]);
                    *(u32x4*)(rowp + bj * HALF) = w; } }
    }
};
struct EpiPP {
    static constexpr bool PERM = true;
    static constexpr bool SP2 = ((PG8_SP2_MASK) >> 4) & 1;
    bf16_t* O;
    template <class S_> __device__ __forceinline__ void operator()(const f32x4 (&acc)[2][2][4][2], const Unit& u, const S_&, int wr, int wc, int fr, int fq) const {
        const int row0 = u.orow + wr * 64 + fr, col0 = u.ocol + wc * 32 + 8 * fq;
#pragma unroll
        for (int ai = 0; ai < 2; ++ai)
#pragma unroll
            for (int m = 0; m < 4; ++m) { bf16_t* rowp = O + (size_t)(row0 + ai * HALF + m * 16) * D + col0;
#pragma unroll
                for (int bj = 0; bj < 2; ++bj) { const f32x4 v0 = acc[ai][bj][m][0], v1 = acc[ai][bj][m][1];
                    u32x4 w; w.x = cvt_pk_bf16(v0[0], v0[1]); w.y = cvt_pk_bf16(v0[2], v0[3]); w.z = cvt_pk_bf16(v1[0], v1[1]); w.w = cvt_pk_bf16(v1[2], v1[3]);
                    *(u32x4*)(rowp + bj * HALF) = w; } }
    }
};
struct EpiPle {
    static constexpr bool PERM = true;
    static constexpr bool SP2 = ((PG8_SP2_MASK) >> 5) & 1;
    const bf16_t* hb; bf16_t* dst; const bf16_t* pp; const float* rsp; float* part;
    template <class S_> __device__ __forceinline__ void operator()(const f32x4 (&acc)[2][2][4][2], const Unit& u, const S_&, int wr, int wc, int fr, int fq) const {
        const int row0 = u.orow + wr * 64 + fr, col0 = u.ocol + wc * 32 + 8 * fq;
        float* pout = part + ((u.ocol >> 8) * 4 + wc);
        float rs8[8];
#pragma unroll
        for (int r = 0; r < 8; ++r) rs8[r] = rsp[row0 + (r >> 2) * HALF + (r & 3) * 16];
#pragma unroll
        for (int ai = 0; ai < 2; ++ai) {
            u32x4 hw[4][2], pw[4][2];
#pragma unroll
            for (int m = 0; m < 4; ++m)
#pragma unroll
                for (int bj = 0; bj < 2; ++bj) { const size_t off = (size_t)(row0 + ai * HALF + m * 16) * D + col0 + bj * HALF; hw[m][bj] = *(const u32x4*)(hb + off); pw[m][bj] = *(const u32x4*)(pp + off); }
#pragma unroll
            for (int m = 0; m < 4; ++m) {
                const int row = row0 + ai * HALF + m * 16; const float rs = rs8[ai * 4 + m]; float ss = 0.f;
#pragma unroll
                for (int bj = 0; bj < 2; ++bj) {
                    float hv[8], pv[8], o[8];
#pragma unroll
                    for (int j = 0; j < 4; ++j) { hv[2 * j] = __uint_as_float(hw[m][bj][j] << 16); hv[2 * j + 1] = __uint_as_float(hw[m][bj][j] & 0xffff0000u); pv[2 * j] = __uint_as_float(pw[m][bj][j] << 16); pv[2 * j + 1] = __uint_as_float(pw[m][bj][j] & 0xffff0000u); }
#pragma unroll
                    for (int j = 0; j < 4; ++j) { o[j] = hv[j] + sigmoidf_(acc[ai][bj][m][0][j] * rs) * pv[j]; o[4 + j] = hv[4 + j] + sigmoidf_(acc[ai][bj][m][1][j] * rs) * pv[4 + j]; }
                    u32x4 w; w.x = cvt_pk_bf16(o[0], o[1]); w.y = cvt_pk_bf16(o[2], o[3]); w.z = cvt_pk_bf16(o[4], o[5]); w.w = cvt_pk_bf16(o[6], o[7]);
#pragma unroll
                    for (int j = 0; j < 4; ++j) { const float a0 = __uint_as_float(w[j] << 16), a1 = __uint_as_float(w[j] & 0xffff0000u); ss += a0 * a0 + a1 * a1; }
                    *(u32x4*)(dst + (size_t)row * D + col0 + bj * HALF) = w; }
                ss += __shfl_xor(ss, 16); ss += __shfl_xor(ss, 32);
                if (fq == 0) pout[(size_t)row * NPART] = ss; }
        }
    }
};
}

struct Params {
    const float* in[35];
    float* out;
    unsigned char* ws;
    int ph_lo, ph_hi;
};
enum { I_X = 0, I_P, I_MIXN, I_WIN, I_CONVW, I_CONVB, I_CLNG, I_CLNB, I_MU, I_W0, I_W2, I_A0, I_A2, I_G2, I_KK, I_KA, I_RK, I_GNG, I_GNB, I_V0, I_V1, I_V2,
       I_WOUT, I_FFNN, I_RGW, I_RGB, I_REW, I_REB, I_EWG, I_EWU, I_EWD, I_PLEN, I_PLEG, I_PLEP, I_FINN };

typedef const Params __attribute__((address_space(4)))* KP;
struct Ctx {
    LAS unsigned char* lds;
    int tid, lane, wave, vcu, G, bid;
};

__device__ __forceinline__ Ctx fresh(const Ctx& C0) { Ctx C = C0; int t = threadIdx.x; asm volatile("" : "+v"(t)); C.tid = t; C.lane = t & 63; C.wave = __builtin_amdgcn_readfirstlane(t >> 6);
    int bx = blockIdx.x; asm volatile("" : "+s"(bx)); C.bid = bx; C.vcu = (C.G % 8 == 0) ? (bx % 8) * (C.G / 8) + bx / 8 : bx; return C; }

struct TrItem { const float* src; const float* gain; bf16_t* dst; int ldw, ldt, k0, n0, drow; };
__device__ __forceinline__ void tr_load(const TrItem& t, int lane, float (&v)[32]) {
    const float* src = t.src + (size_t)(t.k0 + (lane >> 5)) * t.ldw + t.n0 + (lane & 31);
#pragma unroll
    for (int i = 0; i < 32; ++i) v[i] = src[(size_t)(2 * i) * t.ldw];
}
__device__ __forceinline__ void tr_store(const TrItem& t, const float (&v)[32], LAS float* scr, int lane) {
    const int c = lane & 7;
    f32x4 g0 = (f32x4){1.f, 1.f, 1.f, 1.f}, g1 = g0;
    if (t.gain) { g0 = *(const f32x4*)(t.gain + t.k0 + 8 * c); g1 = *(const f32x4*)(t.gain + t.k0 + 8 * c + 4); }
#pragma unroll
    for (int i = 0; i < 32; ++i) scr[(2 * i + (lane >> 5)) * 33 + (lane & 31)] = v[i];
    asm volatile("s_waitcnt lgkmcnt(0)" ::: "memory");
#pragma unroll
    for (int j = 0; j < 4; ++j) { const int n = (lane >> 3) + 8 * j; const LAS float* s = scr + (8 * c) * 33 + n;
        u32x4 o; o.x = pk2(s[0 * 33] * g0[0], s[1 * 33] * g0[1]); o.y = pk2(s[2 * 33] * g0[2], s[3 * 33] * g0[3]); o.z = pk2(s[4 * 33] * g1[0], s[5 * 33] * g1[1]); o.w = pk2(s[6 * 33] * g1[2], s[7 * 33] * g1[3]);
        *(u32x4*)(t.dst + (size_t)(t.drow + n) * t.ldt + t.k0 + 8 * c) = o; }
    asm volatile("s_waitcnt lgkmcnt(0)" ::: "memory");
}

__device__ __forceinline__ void phase_prep(KP P, const Ctx& C0, unsigned char* wsb, const int part) {
    const Ctx C = fresh(C0);
    LAS float* scr = (LAS float*)(C.lds + C.wave * 16384);
    const int gw = C.vcu * 8 + C.wave, NGW = C.G * 8;
    const int lane = C.lane;
    constexpr int IT_IN = 16 * 85, IT_OUT = 16 * 32, IT_GU = 2 * NE * 16 * 16, IT_D = NE * 8 * 32, IT_PG = 16 * 32, IT_PP = 4 * 32;
    constexpr int IT_LAYER = IT_IN + IT_OUT + IT_GU + IT_D + IT_PG + IT_PP;
    if (part == 0) {
        auto decode = [&](int it) -> TrItem {
            TrItem t; t.gain = nullptr;
            const int l = it / IT_LAYER; int r = it % IT_LAYER;
            unsigned char* wl = wsb + WS_W + (size_t)l * W_LAYER;
            if (r < IT_IN) { const int kb = r / 85, nb = r % 85;
                t.src = P->in[I_WIN] + (size_t)l * D * IN_COLS; t.ldw = IN_COLS; t.k0 = kb * 64; t.n0 = nb * 32; t.gain = P->in[I_MIXN] + l * D; t.dst = (bf16_t*)(wl + WO_IN); t.ldt = D;
                t.drow = (t.n0 < 2 * CONVC) ? (((t.n0 & (CONVC - 1)) >> 7) * 256 + (t.n0 >= CONVC ? 128 : 0) + (t.n0 & 127)) : t.n0;
            } else if (r < IT_IN + IT_OUT) { r -= IT_IN; const int kb = r / 32, nb = r % 32;
                t.src = P->in[I_WOUT] + (size_t)l * D * D; t.ldw = D; t.k0 = kb * 64; t.n0 = nb * 32; t.dst = (bf16_t*)(wl + WO_OUT); t.ldt = D; t.drow = t.n0;
            } else if (r < IT_IN + IT_OUT + IT_GU) { r -= IT_IN + IT_OUT; const int half = r / (NE * 256), r2 = r % (NE * 256), e = r2 / 256, kb = (r2 % 256) / 16, nb = r2 % 16;
                t.src = (half ? P->in[I_EWU] : P->in[I_EWG]) + ((size_t)l * NE + e) * D * FF; t.ldw = FF; t.k0 = kb * 64; t.n0 = nb * 32; t.gain = P->in[I_FFNN] + l * D; t.dst = (bf16_t*)(wl + WO_GU); t.ldt = D;
                t.drow = e * 1024 + (t.n0 >> 7) * 256 + half * 128 + (t.n0 & 127);
            } else if (r < IT_IN + IT_OUT + IT_GU + IT_D) { r -= IT_IN + IT_OUT + IT_GU; const int e = r / 256, kb = (r % 256) / 32, nb = r % 32;
                t.src = P->in[I_EWD] + ((size_t)l * NE + e) * FF * D; t.ldw = D; t.k0 = kb * 64; t.n0 = nb * 32; t.dst = (bf16_t*)(wl + WO_D); t.ldt = FF; t.drow = e * 1024 + t.n0;
            } else if (r < IT_IN + IT_OUT + IT_GU + IT_D + IT_PG) { r -= IT_IN + IT_OUT + IT_GU + IT_D; const int kb = r / 32, nb = r % 32;
                t.src = P->in[I_PLEG] + (size_t)l * D * D; t.ldw = D; t.k0 = kb * 64; t.n0 = nb * 32; t.gain = P->in[I_PLEN] + l * D; t.dst = (bf16_t*)(wl + WO_PG); t.ldt = D; t.drow = t.n0;
            } else { r -= IT_IN + IT_OUT + IT_GU + IT_D + IT_PG; const int kb = r / 32, nb = r % 32;
                t.src = P->in[I_PLEP] + (size_t)l * PLE * D; t.ldw = D; t.k0 = kb * 64; t.n0 = nb * 32; t.dst = (bf16_t*)(wl + WO_PP); t.ldt = PLE; t.drow = t.n0; }
            return t; };
        int it = gw;
        if (it < DEPTH * IT_LAYER) {
            TrItem cur = decode(it); float v[32]; tr_load(cur, lane, v);
            for (;;) {
                const int nx = it + NGW; const bool has = nx < DEPTH * IT_LAYER;
                TrItem nxt = cur; float vn[32];
                if (has) { nxt = decode(nx); tr_load(nxt, lane, vn); }
                tr_store(cur, v, scr, lane);
                if (!has) break;
                cur = nxt; it = nx;
#pragma unroll
                for (int i = 0; i < 32; ++i) v[i] = vn[i];
            }
        }
    }
    if (part == 1) {
        const int gt = gw * 64 + lane, NGT = NGW * 64;
        bf16_t* w0 = (bf16_t*)(wsb + WS_W + WO_IN); bf16_t* w1 = (bf16_t*)(wsb + WS_W + W_LAYER + WO_IN);
        for (int i = gt; i < 96 * D / 8; i += NGT) *(u32x4*)(w0 + (size_t)IN_COLS * D + (size_t)i * 8) = (u32x4){0u, 0u, 0u, 0u};
        for (int i = gt; i < 32 * D / 8; i += NGT) *(u32x4*)(w1 + (size_t)(ZC_EB + 32) * D + (size_t)i * 8) = (u32x4){0u, 0u, 0u, 0u};
        const float* win1 = P->in[I_WIN] + (size_t)D * IN_COLS; const float* mu1 = P->in[I_MU] + RWKV_IN + 2 * RC; const float* v1 = P->in[I_V1]; const float* g1 = P->in[I_MIXN] + D;
        for (int k = gw; k < D; k += NGW) {
            const float* wr_ = win1 + (size_t)k * IN_COLS + ZC_V; float s = 0.f; const int j = lane & 31; const bool hi = lane >= 32;
            float s2 = 0.f, s3 = 0.f, s4 = 0.f;
#pragma unroll 8
            for (int c = 0; c < RC; c += 4) { const f32x4 m4 = *(const f32x4*)(mu1 + c), w4 = *(const f32x4*)(wr_ + c);
                s += w4[0] * (hi ? m4[0] : 1.0f - m4[0]) * v1[(c + 0) * LV + j]; s2 += w4[1] * (hi ? m4[1] : 1.0f - m4[1]) * v1[(c + 1) * LV + j];
                s3 += w4[2] * (hi ? m4[2] : 1.0f - m4[2]) * v1[(c + 2) * LV + j]; s4 += w4[3] * (hi ? m4[3] : 1.0f - m4[3]) * v1[(c + 3) * LV + j]; }
            s = (s + s2) + (s3 + s4);
            w1[(size_t)(ZC_EA + lane) * D + k] = (bf16_t)f2bf(s * g1[k]);
        }
        bf16_t* wrt = (bf16_t*)(wsb + WS_WR);
        for (int i = gt; i < DEPTH * 48 * D; i += NGT) { const int l = i / (48 * D), j = (i / D) % 48, k = i % D; float v = 0.f;
            if (j < NG) v = P->in[I_RGW][((size_t)l * D + k) * NG + j]; else if (j < NRT) { const int g = (j - NG) / EPG, e = (j - NG) % EPG; v = P->in[I_REW][(((size_t)l * NG + g) * D + k) * EPG + e]; }
            v *= P->in[I_FFNN][l * D + k];
            const unsigned hi = f2bf(v); const float lo = v - __uint_as_float(hi << 16);
            wrt[((size_t)(l * 2 + 0) * 48 + j) * D + k] = (bf16_t)hi; wrt[((size_t)(l * 2 + 1) * 48 + j) * D + k] = (bf16_t)f2bf(lo); }
        const f32x4* p4 = (const f32x4*)P->in[I_P]; u32x2* pb = (u32x2*)(wsb + WS_PB);
        static_assert(((size_t)DEPTH * M * PLE / 4) % (8 * 256 * 512) == 0, "p conversion tiling");
        for (size_t i = gt; i < (size_t)DEPTH * M * PLE / 4; i += (size_t)8 * NGT) { f32x4 v[8];
#pragma unroll
            for (int j = 0; j < 8; ++j) v[j] = p4[i + (size_t)j * NGT];
#pragma unroll
            for (int j = 0; j < 8; ++j) { u32x2 w; w.x = pk2(v[j][0], v[j][1]); w.y = pk2(v[j][2], v[j][3]); pb[i + (size_t)j * NGT] = w; } }
    }
    if (part == 2) {
        bf16_t* hb = (bf16_t*)(wsb + WS_HB); float* part = (float*)(wsb + WS_PART);
        for (int m0 = gw; m0 < M; m0 += 4 * NGW) {
            f32x4 xv[4][4];
#pragma unroll
            for (int q = 0; q < 4; ++q) { const f32x4* xr = (const f32x4*)(P->in[I_X] + (size_t)(m0 + q * NGW) * D) + lane;
#pragma unroll
                for (int j = 0; j < 4; ++j) xv[q][j] = xr[64 * j]; }
#pragma unroll
            for (int q = 0; q < 4; ++q) { const int m = m0 + q * NGW; u32x2* o = (u32x2*)(hb + (size_t)m * D) + lane; float sq = 0.f;
#pragma unroll
                for (int j = 0; j < 4; ++j) { const f32x4 v = xv[q][j]; sq += (v[0] * v[0] + v[1] * v[1]) + (v[2] * v[2] + v[3] * v[3]); u32x2 w; w.x = pk2(v[0], v[1]); w.y = pk2(v[2], v[3]); o[64 * j] = w; }
                sq = sum16(sq); sq += __shfl_xor(sq, 16); sq += __shfl_xor(sq, 32);
                if (lane < NPART) part[(size_t)m * NPART + lane] = lane == 0 ? sq : 0.f; }
        }
    }
}

__device__ __forceinline__ float xsum16(float x) { float a = x, b = x; asm volatile("s_nop 1\n\tv_permlane16_swap_b32 %0, %1" : "+v"(a), "+v"(b)); return a + b; }
__device__ __forceinline__ float xsum32(float x) { float a = x, b = x; asm volatile("s_nop 1\n\tv_permlane32_swap_b32 %0, %1" : "+v"(a), "+v"(b)); return a + b; }

constexpr int CH = 32;
constexpr int AB_K = 0, AB_W = 8192, AB_R = 16384, AB_V = 24576, AB_Y = 32768, AB_A = 40960, AB_G = 45056, AB_BON = 49152, AB_SET = 49280;
constexpr int XROW = 144;
constexpr int PS_X = 2 * AB_SET, XS_SET = 23040;
constexpr int XS_A = 0, XS_B = 4608, XS_K = 9216, XS_R = 13824, XS_V = 18432;
constexpr int PS_GAM = PS_X + 2 * XS_SET;
constexpr int PS_CON = PS_GAM + 512;
constexpr int PS_FLAG = PS_CON + 2688;
constexpr int PS_END = PS_FLAG + 64;
static_assert(PS_END <= LDS_BYTES - 64, "RWKV LDS map");
constexpr int LDS_SPIN_CAP = 1 << 20;
__device__ __forceinline__ void lds_wait_ge(LAS int* cnt, int target) {
    int sp = 0; while (__hip_atomic_load(cnt, __ATOMIC_RELAXED, __HIP_MEMORY_SCOPE_WORKGROUP) < target) { __builtin_amdgcn_s_sleep(1); if (++sp > LDS_SPIN_CAP) break; }
    __builtin_amdgcn_fence(__ATOMIC_ACQUIRE, "workgroup");
}
__device__ __forceinline__ void lds_signal(LAS int* cnt, int lane) {
    __builtin_amdgcn_fence(__ATOMIC_RELEASE, "workgroup"); asm volatile("s_waitcnt lgkmcnt(0)" ::: "memory");
    if (lane == 0) __hip_atomic_fetch_add(cnt, 1, __ATOMIC_RELAXED, __HIP_MEMORY_SCOPE_WORKGROUP);
}

#ifdef TIMING
#define TP_DECL() unsigned tacc[10] = {0u, 0u, 0u, 0u, 0u, 0u, 0u, 0u, 0u, 0u}; unsigned tlast = (unsigned)__builtin_amdgcn_s_memrealtime()
#define TP_ACC(i) do { const unsigned n_ = (unsigned)__builtin_amdgcn_s_memrealtime(); tacc[i] += n_ - tlast; tlast = n_; } while (0)
#define TP_OUT(i) do { ((unsigned*)(wsb + WS_CTL))[1024 + 40 + 2 * (i)] = 0u; ((unsigned*)(wsb + WS_CTL))[1024 + 41 + 2 * (i)] = tacc[i]; } while (0)
#else
#define TP_DECL() do {} while (0)
#define TP_ACC(i) do {} while (0)
#define TP_OUT(i) do {} while (0)
#endif
__device__ __forceinline__ void phase_mix(KP P, const Ctx& C0, unsigned char* wsb, int l, const int part) {
    const Ctx C = fresh(C0);
    const bf16_t* Z = (const bf16_t*)(wsb + WS_Z); bf16_t* Y = (bf16_t*)(wsb + WS_Y); bf16_t* VF = (bf16_t*)(wsb + WS_VF);
    const int tid = C.tid, lane = C.lane, wave = C.wave;
    if (part == 0) {
    {
        constexpr int CT = 32, UT = CT + 30;
        LAS bf16_t* ut = (LAS bf16_t*)C.lds;
        LAS float* co = (LAS float*)(C.lds + 65536);
        const int cp = tid & 255, th = tid >> 8;
        f32x2 cw[CONVW];
#pragma unroll
        for (int j = 0; j < CONVW; ++j) cw[j] = *(const f32x2*)(P->in[I_CONVW] + ((size_t)l * CONVW + j) * CONVC + 2 * cp);
        const f32x2 cb = *(const f32x2*)(P->in[I_CONVB] + l * CONVC + 2 * cp);
        const f32x4 lg0 = *(const f32x4*)(P->in[I_CLNG] + l * CONVC + lane * 8), lg1 = *(const f32x4*)(P->in[I_CLNG] + l * CONVC + lane * 8 + 4);
        const f32x4 lb0 = *(const f32x4*)(P->in[I_CLNB] + l * CONVC + lane * 8), lb1 = *(const f32x4*)(P->in[I_CLNB] + l * CONVC + lane * 8 + 4);
        u32x4 gv_[8], q_lc, q_lp; unsigned q_l2c, q_l2p, q_ea, q_eb;
        const int cgL = tid & 15, tokL = tid >> 4;
        const float* muL = P->in[I_MU] + (size_t)l * RWKV_IN + 3 * RC;
        const f32x4 ml0 = *(const f32x4*)(muL + cgL * 8), ml1 = *(const f32x4*)(muL + cgL * 8 + 4); const f32x2 ml2 = *(const f32x2*)(muL + 128 + cgL * 2);
        bf16_t* LR = (bf16_t*)(wsb + WS_LR);
#define CONV_LOAD(item_) do { const int b_ = (item_) >> 6, t0_ = ((item_) & 63) * CT; _Pragma("unroll") for (int i = 0; i < 8; ++i) { const int p = tid + 512 * i; const int row = p >> 6, g8 = p & 63; const int t = t0_ - 30 + row; \
            gv_[i] = (u32x4){0u, 0u, 0u, 0u}; if (p < UT * 64 && t >= 0) gv_[i] = *(const u32x4*)(Z + (size_t)(b_ * SEQ + t) * ZC + g8 * 8); } \
            { const int tq_ = t0_ + tokL; const bf16_t* rc_ = Z + (size_t)(b_ * SEQ + tq_) * ZC; const bf16_t* rp_ = rc_ - ZC; const bool hp_ = tq_ > 0; \
              q_lc = *(const u32x4*)(rc_ + ZC_WLO + cgL * 8); q_l2c = *(const unsigned*)(rc_ + ZC_WLO + 128 + cgL * 2); q_ea = *(const unsigned*)(rc_ + ZC_EA + cgL * 2); \
              q_lp = hp_ ? *(const u32x4*)(rp_ + ZC_WLO + cgL * 8) : (u32x4){0u, 0u, 0u, 0u}; q_l2p = hp_ ? *(const unsigned*)(rp_ + ZC_WLO + 128 + cgL * 2) : 0u; q_eb = hp_ ? *(const unsigned*)(rp_ + ZC_EB + cgL * 2) : 0u; } } while (0)
#ifndef MIXSKIP_CONV
        if (C.bid < M / CT) CONV_LOAD(C.bid);
        for (int item = C.bid; item < M / CT; item += C.G) {
#else
        for (int item = C.bid; item < 0; item += C.G) {
#endif
            const int b = item >> 6, t0 = (item & 63) * CT;
#pragma unroll
            for (int i = 0; i < 8; ++i) { const int p = tid + 512 * i; const int row = p >> 6, g8 = p & 63;
                if (p < UT * 64) *(LAS u32x4*)(ut + row * CONVC + g8 * 8) = gv_[i]; }
            {
#define LERP2(dst, wc_, wp_, m0, m1) do { const float c0_ = __uint_as_float((wc_) << 16), c1_ = __uint_as_float((wc_) & 0xffff0000u), p0_ = __uint_as_float((wp_) << 16), p1_ = __uint_as_float((wp_) & 0xffff0000u); \
                    (dst)[0] = c0_ + (p0_ - c0_) * (m0); (dst)[1] = c1_ + (p1_ - c1_) * (m1); } while (0)
                float zl[8], t2[2];
                LERP2(zl + 0, q_lc.x, q_lp.x, ml0[0], ml0[1]); LERP2(zl + 2, q_lc.y, q_lp.y, ml0[2], ml0[3]); LERP2(zl + 4, q_lc.z, q_lp.z, ml1[0], ml1[1]); LERP2(zl + 6, q_lc.w, q_lp.w, ml1[2], ml1[3]);
                const float am_ = (cgL < 4) ? 2.885390082f : -1.442695041f, as_ = (cgL < 4) ? -2.0f : 1.0f, ao_ = (cgL < 4) ? 1.0f : 0.0f; const bool aid_ = (cgL >= 4) && (cgL < 8);
#pragma unroll
                for (int j = 0; j < 8; ++j) { const float y_ = as_ * __builtin_amdgcn_rcpf(1.0f + __builtin_amdgcn_exp2f(zl[j] * am_)) + ao_; zl[j] = aid_ ? zl[j] : y_; }
                u32x4 pk; pk.x = pk2(zl[0], zl[1]); pk.y = pk2(zl[2], zl[3]); pk.z = pk2(zl[4], zl[5]); pk.w = pk2(zl[6], zl[7]);
                bf16_t* lrow = LR + (size_t)(b * SEQ + t0 + tokL) * LRC;
                *(u32x4*)(lrow + cgL * 8) = pk;
                LERP2(t2, q_l2c, q_l2p, ml2[0], ml2[1]);
                *(unsigned*)(lrow + 128 + cgL * 2) = pk2(sigmoidf_(t2[0]), sigmoidf_(t2[1]));
                *(unsigned*)(lrow + 160 + cgL * 2) = pk2(__uint_as_float(q_ea << 16) + __uint_as_float(q_eb << 16), __uint_as_float(q_ea & 0xffff0000u) + __uint_as_float(q_eb & 0xffff0000u));
#undef LERP2
            }
            __syncthreads();
            if (item + C.G < M / CT) CONV_LOAD(item + C.G);
#pragma unroll 1
            for (int blk = 0; blk < 2; ++blk) { const int tb = th * 16 + blk * 8;
                f32x2 u2[38];
#pragma unroll
                for (int i = 0; i < 38; ++i) { const unsigned w = *(const LAS unsigned*)(ut + (tb + i) * CONVC + 2 * cp); u2[i] = (f32x2){__uint_as_float(w << 16), __uint_as_float(w & 0xffff0000u)}; }
#pragma unroll
                for (int tt = 0; tt < 8; ++tt) { f32x2 a = cb;
#pragma unroll
                    for (int j = 0; j < CONVW; ++j) a += u2[tt + j] * cw[j];
                    *(LAS f32x2*)(co + (tb + tt) * CONVC + 2 * cp) = a; } }
            __syncthreads();
#pragma unroll 2
            for (int q = 0; q < CT / 8; ++q) { const int tt = wave * (CT / 8) + q;
                const f32x4 a0 = *(const LAS f32x4*)(co + tt * CONVC + lane * 8), a1 = *(const LAS f32x4*)(co + tt * CONVC + lane * 8 + 4);
                float s = (a0[0] + a0[1]) + (a0[2] + a0[3]) + (a1[0] + a1[1]) + (a1[2] + a1[3]);
                s = sum16(s); s += __shfl_xor(s, 16); s += __shfl_xor(s, 32);
                const float mean = s * (1.0f / CONVC);
                float d[8]; float q2 = 0.f;
#pragma unroll
                for (int j = 0; j < 4; ++j) { d[j] = a0[j] - mean; d[4 + j] = a1[j] - mean; }
#pragma unroll
                for (int j = 0; j < 8; ++j) q2 += d[j] * d[j];
                q2 = sum16(q2); q2 += __shfl_xor(q2, 16); q2 += __shfl_xor(q2, 32);
                const float rstd = rsqrtf(q2 * (1.0f / CONVC) + 1e-5f);
                float o[8];
#pragma unroll
                for (int j = 0; j < 4; ++j) { const float x0 = d[j] * rstd * lg0[j] + lb0[j], x1 = d[4 + j] * rstd * lg1[j] + lb1[j]; o[j] = x0 * sigmoidf_(x0); o[4 + j] = x1 * sigmoidf_(x1); }
                u32x4 w; w.x = pk2(o[0], o[1]); w.y = pk2(o[2], o[3]); w.z = pk2(o[4], o[5]); w.w = pk2(o[6], o[7]);
                *(u32x4*)(Y + (size_t)(b * SEQ + t0 + tt) * D + lane * 8) = w; }
            __syncthreads();
        }
    }
#undef CONV_LOAD
#ifdef TIMING
    if (C.bid == 0 && tid == 0 && l == 0) ((unsigned*)(wsb + WS_CTL))[1024 + 60] = (unsigned)__builtin_amdgcn_s_memrealtime();
#endif
    }
#ifdef TIMING
    if (part == 1 && C.bid == 0 && tid == 0 && l == 0) ((unsigned*)(wsb + WS_CTL))[1024 + 61] = (unsigned)__builtin_amdgcn_s_memrealtime();
#endif
    if (part == 1)
    {
        const int b = C.bid >> 3, h = C.bid & 7;
        LAS unsigned char* L = C.lds;
        LAS float* sCon = (LAS float*)(L + PS_CON); LAS int* flg = (LAS int*)(L + PS_FLAG);
        {
            const float* mu = P->in[I_MU] + (size_t)l * RWKV_IN;
            for (int i = tid; i < 672; i += 512) { float v;
                if (i < 192) v = mu[(i >> 6) * RC + h * HS + (i & 63)]; else if (i < 352) v = mu[3 * RC + i - 192];
                else { const int q = (i - 352) >> 6, c = h * HS + ((i - 352) & 63); const float* src = q == 0 ? P->in[I_KK] : q == 1 ? P->in[I_KA] : q == 2 ? P->in[I_RK] : q == 3 ? P->in[I_GNG] : P->in[I_GNB]; v = src[l * RC + c]; }
                sCon[i] = v; }
            if (tid < 16) flg[tid] = 0;
        }
        __syncthreads();
#define MIX_POST(cq_) do { LAS unsigned char* Sq_ = L + ((cq_) & 1) * AB_SET; _Pragma("unroll") for (int s_ = 0; s_ < 2; ++s_) { const int tk_ = tok0 + 16 * s_; const int t_ = (cq_) * CH + tk_; \
            const f32x4 y4 = *(const LAS f32x4*)((const LAS float*)(Sq_ + AB_Y) + tk_ * 64 + cgE * 4), v4 = *(const LAS f32x4*)((const LAS float*)(Sq_ + AB_V) + tk_ * 64 + cgE * 4), g4 = unpk4(*(const LAS u32x2*)((const LAS bf16_t*)(Sq_ + AB_G) + tk_ * 64 + cgE * 4)); \
            const float mean = sum16((y4[0] + y4[1]) + (y4[2] + y4[3])) * (1.0f / HS); const f32x4 d = y4 - mean; \
            const float var = sum16((d[0] * d[0] + d[1] * d[1]) + (d[2] * d[2] + d[3] * d[3])) * (1.0f / HS); \
            const float rstd = rsqrtf(var + 64e-5f); const float bon = ((const LAS float*)(Sq_ + AB_BON))[tk_]; float o[4]; \
            _Pragma("unroll") for (int j = 0; j < 4; ++j) o[j] = (d[j] * rstd * gngv[j] + gnbv[j] + bon * v4[j]) * g4[j]; \
            u32x2 w; w.x = pk2(o[0], o[1]); w.y = pk2(o[2], o[3]); *(u32x2*)(Y + (size_t)(b * SEQ + t_) * D + CONVC + hc) = w; } } while (0)
        if (wave < 2) {
            const int x = lane & 15, g = lane >> 4, sw = wave;
            f32x4 mlt, mgt, mle, iac; u32x4 sel0, sel1;
#pragma unroll
            for (int r = 0; r < 4; ++r) { const int m = 4 * g + r; mlt[r] = (m < x) ? 1.f : 0.f; mgt[r] = (x < m) ? 1.f : 0.f; mle[r] = (m <= x) ? 1.f : 0.f; iac[r] = (m == x) ? 1.f : 0.f;
                const unsigned one = 0x3F80u << (16 * (x & 1)); const bool hit = (((x & 7) >> 1) == r);
                sel0[r] = (hit && g == (x >> 3)) ? one : 0u; sel1[r] = (hit && g == 2 + (x >> 3)) ? one : 0u; }
            const bf16x8 Sel0 = __builtin_bit_cast(bf16x8, sel0), Sel1 = __builtin_bit_cast(bf16x8, sel1);
            const f32x4 z4 = (f32x4){0.f, 0.f, 0.f, 0.f};
#define MF(a_, b_, c_) __builtin_amdgcn_mfma_f32_16x16x32_bf16(a_, b_, c_, 0, 0, 0)
#define CVP(a_) __builtin_bit_cast(bf16x8, (u32x4){cvtpk((a_)[0], (a_)[1]), cvtpk((a_)[2], (a_)[3]), 0u, 0u})
#define PK8(a_, b_) __builtin_bit_cast(bf16x8, (u32x4){cvtpk((a_)[0], (a_)[1]), cvtpk((a_)[2], (a_)[3]), cvtpk((b_)[0], (b_)[1]), cvtpk((b_)[2], (b_)[3])})
            f32x4 T[2][4];
#pragma unroll
            for (int c2 = 0; c2 < 2; ++c2)
#pragma unroll
                for (int i = 0; i < 4; ++i) T[c2][i] = z4;
#ifdef TIMING
            if (C.bid == 0 && tid == 0 && l == 0) ((unsigned*)(wsb + WS_CTL))[1024 + 63] = (unsigned)__builtin_amdgcn_s_memrealtime();
#endif
#pragma unroll 1
            for (int ch = 0; ch < SEQ / CH; ++ch) {
                LAS unsigned char* Sa = L + (ch & 1) * AB_SET; LAS unsigned char* St = L + PS_X + (ch & 1) * XS_SET; LAS float* gam = (LAS float*)(L + PS_GAM) + (ch & 1) * 64;
                lds_wait_ge(flg + 14, 2 * (ch + 1));
#pragma unroll
                for (int sc = 0; sc < 2; ++sc) {
                    const LAS unsigned char* rowp = St + (16 * sc + x) * XROW + g * 16;
                    bf16x8 oA[2], oB[2], oK[2], oR[2], oV[2];
#pragma unroll
                    for (int kp = 0; kp < 2; ++kp) { oA[kp] = *(const LAS bf16x8*)(rowp + XS_A + kp * 64); oB[kp] = *(const LAS bf16x8*)(rowp + XS_B + kp * 64);
                        oK[kp] = *(const LAS bf16x8*)(rowp + XS_K + kp * 64); oR[kp] = *(const LAS bf16x8*)(rowp + XS_R + kp * 64); }
#pragma unroll
                    for (int c2 = 0; c2 < 2; ++c2) oV[c2] = *(const LAS bf16x8*)(St + XS_V + (16 * sc + x) * XROW + ((32 * sw + 16 * c2 + 8 * g) & 63) * 2);
                    const f32x4 aL = MF(oB[1], oA[1], MF(oB[0], oA[0], z4)) * mlt;
                    const f32x4 aLT = MF(oA[1], oB[1], MF(oA[0], oB[0], z4)) * mgt;
                    const f32x4 aKT = MF(oA[1], oK[1], MF(oA[0], oK[0], z4)) * mgt;
                    const f32x4 aMb = MF(oB[1], oR[1], MF(oB[0], oR[0], z4)) * mle;
                    const f32x4 aMk = MF(oK[1], oR[1], MF(oK[0], oR[0], z4)) * mle;
                    const bf16x8 pl = CVP(aL), plt = CVP(aLT);
                    const f32x4 l2 = MF(plt, pl, z4), l2t = MF(pl, plt, z4);
                    const bf16x8 pl2 = CVP(l2), pl2t = CVP(l2t);
                    const f32x4 l4 = MF(pl2t, pl2, z4), l4t = MF(pl2, pl2t, z4), l3t = MF(pl2, plt, z4);
                    const bf16x8 pl4 = CVP(l4), pl4t = CVP(l4t);
                    const f32x4 l8 = MF(pl4t, pl4, z4);
                    const f32x4 l12 = MF(pl4t, CVP(l8), z4);
                    const f32x4 q1t = iac + aLT + l2t + l3t, q2 = iac + l4 + l8 + l12;
                    const bf16x8 pq1t = CVP(q1t), pq2 = CVP(q2);
                    const f32x4 nn = MF(pq1t, pq2, z4), nnt = MF(pq2, pq1t, z4);
                    const bf16x8 pn = CVP(nn), pmb = CVP(aMb), pkt = CVP(aKT);
                    const f32x4 p2 = MF(CVP(nnt), pmb, z4);
                    const f32x4 p3 = MF(pkt, pn, z4), p3t = MF(pn, pkt, z4);
                    const f32x4 p4 = MF(CVP(p3t), pmb, aMk);
                    bf16x8 ARk[4], BKk[4];
#pragma unroll
                    for (int kt = 0; kt < 4; ++kt) { const bf16x8 se = (kt & 1) ? Sel1 : Sel0;
                        const f32x4 ta = MF(oA[kt >> 1], se, z4), tr = MF(oR[kt >> 1], se, z4), tb = MF(oB[kt >> 1], se, z4), tk = MF(oK[kt >> 1], se, z4);
                        ARk[kt] = PK8(ta, tr); BKk[kt] = PK8(tb, tk); }
                    const bf16x8 bN0 = PK8(nn, z4), bP2I = PK8(p2, iac);
                    f32x4 apT[4], rpT[4];
#pragma unroll
                    for (int kt = 0; kt < 4; ++kt) { apT[kt] = MF(ARk[kt], bN0, z4); rpT[kt] = MF(ARk[kt], bP2I, z4); }
                    const bf16x8 ApOp0 = PK8(apT[0], apT[1]), ApOp1 = PK8(apT[2], apT[3]), RpOp0 = PK8(rpT[0], rpT[1]), RpOp1 = PK8(rpT[2], rpT[3]);
                    const bf16x8 p3o = CVP(p3), p4o = CVP(p4);
#pragma unroll
                    for (int c2 = 0; c2 < 2; ++c2) {
                        const f32x4 trV = MF(oV[c2], Sel0, z4);
                        const bf16x8 vOp = PK8(trV, z4);
                        f32x4 uT = MF(p3o, vOp, z4), yT = MF(p4o, vOp, z4);
                        const bf16x8 SOp0 = PK8(T[c2][0], T[c2][1]), SOp1 = PK8(T[c2][2], T[c2][3]);
                        uT = MF(ApOp0, SOp0, uT); uT = MF(ApOp1, SOp1, uT);
                        yT = MF(RpOp0, SOp0, yT); yT = MF(RpOp1, SOp1, yT);
                        const bf16x8 UV = PK8(uT, trV);
#pragma unroll
                        for (int kt = 0; kt < 4; ++kt) T[c2][kt] = MF(BKk[kt], UV, T[c2][kt]);
                        LAS float* yp = (LAS float*)(Sa + AB_Y) + (16 * sc + 4 * g) * 64 + 32 * sw + 16 * c2 + x;
#pragma unroll
                        for (int r = 0; r < 4; ++r) yp[r * 64] = yT[r];
                    }
                }
#pragma unroll
                for (int kt = 0; kt < 4; ++kt) { const f32x4 gq = *(const LAS f32x4*)(gam + 16 * kt + 4 * g); T[0][kt] = T[0][kt] * gq; T[1][kt] = T[1][kt] * gq; }
                lds_signal(flg + 12, lane);
            }
#undef MF
#undef CVP
#undef PK8
#ifdef TIMING
            if (C.bid == 0 && tid == 0 && l == 0) ((unsigned*)(wsb + WS_CTL))[1024 + 62] = (unsigned)__builtin_amdgcn_s_memrealtime();
#endif
        } else if (wave < 4) {
            const int ctid = tid - 128, tok0 = ctid >> 4, cgE = ctid & 15, hc = h * HS + cgE * 4;
            u32x2 n_vf[4];
#define VF_LOAD(ch_) do { _Pragma("unroll") for (int s_ = 0; s_ < 4; ++s_) n_vf[s_] = (l > 0) ? *(const u32x2*)(VF + (size_t)(b * SEQ + (ch_) * CH + tok0 + 8 * s_) * RC + hc) : (u32x2){0u, 0u}; } while (0)
            VF_LOAD(0);
            const f32x4 kkv = *(const LAS f32x4*)(sCon + 352 + cgE * 4), kav = *(const LAS f32x4*)(sCon + 416 + cgE * 4), rkv = *(const LAS f32x4*)(sCon + 480 + cgE * 4);
#pragma unroll 1
            for (int ch = 0; ch < SEQ / CH; ++ch) {
                LAS unsigned char* Sa = L + (ch & 1) * AB_SET; LAS unsigned char* St = L + PS_X + (ch & 1) * XS_SET; LAS float* gam = (LAS float*)(L + PS_GAM) + (ch & 1) * 64;
                u32x2 vfc[4];
#pragma unroll
                for (int s_ = 0; s_ < 4; ++s_) vfc[s_] = n_vf[s_];
                if (ch + 1 < SEQ / CH) VF_LOAD(ch + 1);
                lds_wait_ge(flg + 0, ch + 1); lds_wait_ge(flg + 1, ch + 1); lds_wait_ge(flg + 2, ch + 1); lds_wait_ge(flg + 3, ch + 1);
                if (ch >= 2) lds_wait_ge(flg + 12, 2 * (ch - 1));
                LAS float* sR = (LAS float*)(Sa + AB_R); LAS float* sK = (LAS float*)(Sa + AB_K); LAS float* sW = (LAS float*)(Sa + AB_W);
                LAS float* sV = (LAS float*)(Sa + AB_V); LAS float* sY = (LAS float*)(Sa + AB_Y);
#pragma unroll
                for (int s_ = 0; s_ < 4; ++s_) {
                    const int tok = tok0 + 8 * s_; const int t = ch * CH + tok;
                    const f32x4 r4 = *(const LAS f32x4*)(sR + tok * 64 + cgE * 4), k4 = *(const LAS f32x4*)(sK + tok * 64 + cgE * 4), cs = *(const LAS f32x4*)(sW + tok * 64 + cgE * 4), as4 = unpk4(*(const LAS u32x2*)((const LAS bf16_t*)(Sa + AB_A) + tok * 64 + cgE * 4));
                    f32x4 v4 = *(const LAS f32x4*)(sV + tok * 64 + cgE * 4);
                    f32x4 cp = (f32x4){1.f, 1.f, 1.f, 1.f}; if (tok > 0) cp = *(const LAS f32x4*)(sW + (tok - 1) * 64 + cgE * 4);
                    if (l == 0) { u32x2 w; w.x = cvtpk(v4[0], v4[1]); w.y = cvtpk(v4[2], v4[3]); *(u32x2*)(VF + (size_t)(b * SEQ + t) * RC + hc) = w; }
                    else { const f32x4 vg = *(const LAS f32x4*)(sY + tok * 64 + cgE * 4);
                        const float f0 = __uint_as_float(vfc[s_].x << 16), f1 = __uint_as_float(vfc[s_].x & 0xffff0000u), f2 = __uint_as_float(vfc[s_].y << 16), f3 = __uint_as_float(vfc[s_].y & 0xffff0000u);
                        v4[0] += (f0 - v4[0]) * vg[0]; v4[1] += (f1 - v4[1]) * vg[1]; v4[2] += (f2 - v4[2]) * vg[2]; v4[3] += (f3 - v4[3]) * vg[3]; }
                    f32x4 kk4, k2, bb, rt, gm4; float ssq = 0.f, rk = 0.f;
#pragma unroll
                    for (int j = 0; j < 4; ++j) { kk4[j] = k4[j] * kkv[j]; ssq += kk4[j] * kk4[j]; k2[j] = k4[j] * (1.0f + (as4[j] - 1.0f) * kav[j]); rk += r4[j] * k2[j] * rkv[j]; }
                    ssq = sum16(ssq);
                    const float inv = rsqrtf(fmaxf(ssq, 1e-24f));
                    rk = sum16(rk);
#pragma unroll
                    for (int j = 0; j < 4; ++j) { const float gm = cs[j], gi = __builtin_amdgcn_rcpf(gm), gp = cp[j]; gm4[j] = gm;
                        kk4[j] *= inv; bb[j] = kk4[j] * as4[j] * gi; kk4[j] = -kk4[j] * gp; k2[j] *= gi; rt[j] = r4[j] * gm; }
#define XST(off_, v_) *(LAS u32x2*)(St + (off_) + tok * XROW + cgE * 8) = (u32x2){cvtpk((v_)[0], (v_)[1]), cvtpk((v_)[2], (v_)[3])}
                    XST(XS_A, kk4); XST(XS_B, bb); XST(XS_K, k2); XST(XS_R, rt); XST(XS_V, v4);
#undef XST
                    *(LAS f32x4*)(sV + tok * 64 + cgE * 4) = v4;
                    if (cgE == 0) ((LAS float*)(Sa + AB_BON))[tok] = rk;
                    if (tok == CH - 1) *(LAS f32x4*)(gam + cgE * 4) = gm4;
                }
                lds_signal(flg + 14, lane);
            }
#undef VF_LOAD
        } else {
            const int ptid = tid - 256, pw = wave - 4, tok0 = ptid >> 4, cgE = ptid & 15, hc = h * HS + cgE * 4;
            __builtin_amdgcn_s_setprio(1);
            int pbar_epoch = 0;
#define PREP_BAR() do { ++pbar_epoch; lds_signal(flg + 8, lane); lds_wait_ge(flg + 8, 4 * pbar_epoch); } while (0)
            const int nt = pw, fr = lane & 15, fq = lane >> 4;
            bf16x8 Bw, Ba, Bv, Bg[3];
            {
                const int n = h * HS + nt * 16 + fr;
#pragma unroll
                for (int j = 0; j < 8; ++j) { const int k = 8 * fq + j;
                    Bw[j] = (short)f2bf(P->in[I_W2][((size_t)l * LW + k) * RC + n]); Ba[j] = (short)f2bf(P->in[I_A2][((size_t)l * LA + k) * RC + n]);
                    Bv[j] = (l > 0) ? (short)f2bf(P->in[I_V2][((size_t)(l - 1) * LV + k) * RC + n]) : (short)0;
#pragma unroll
                    for (int s3 = 0; s3 < 3; ++s3) Bg[s3][j] = (short)f2bf(P->in[I_G2][((size_t)l * LG + 32 * s3 + k) * RC + n]); }
            }
            const int ncol = h * HS + nt * 16 + fr;
            const float w0c = P->in[I_W0][l * RC + ncol], a0c = P->in[I_A0][l * RC + ncol], v0c = (l > 0) ? P->in[I_V0][(l - 1) * RC + ncol] : 0.f;
            const bf16_t* Zb = Z + (size_t)b * SEQ * ZC;
            u32x2 n_rc[2], n_rp[2], n_kc[2], n_kp[2], n_vc[2], n_vp[2]; bf16x8 n_Aw[2], n_Aa[2], n_Av[2], n_Ag[2][3];
            const unsigned vo_b = (unsigned)((tok0 * ZC + ZC_R + hc) * 2);
            const unsigned vo_a = (unsigned)((fr * LRC + fq * 8) * 2);
            const bf16_t* LRb = (const bf16_t*)(wsb + WS_LR) + (size_t)b * SEQ * LRC;
#define MIX_LOAD_Z(ch_, CHK_) do { _Pragma("unroll") for (int s_ = 0; s_ < 2; ++s_) { const char* bc_ = (const char*)(Zb + (size_t)((ch_) * CH + 16 * s_) * ZC); const char* bp_ = bc_ - ZC * 2; \
            const bool hp_ = !(CHK_) || ((ch_) * CH + 16 * s_ + tok0 > 0); const u32x2 z2_ = (u32x2){0u, 0u}; \
            n_rc[s_] = *(const u32x2*)(bc_ + (size_t)vo_b); n_kc[s_] = *(const u32x2*)(bc_ + (size_t)vo_b + 1024); n_vc[s_] = *(const u32x2*)(bc_ + (size_t)vo_b + 2048); \
            n_rp[s_] = hp_ ? *(const u32x2*)(bp_ + (size_t)vo_b) : z2_; n_kp[s_] = hp_ ? *(const u32x2*)(bp_ + (size_t)vo_b + 1024) : z2_; n_vp[s_] = hp_ ? *(const u32x2*)(bp_ + (size_t)vo_b + 2048) : z2_; } } while (0)
#define MIX_LOAD_A(ch_) do { _Pragma("unroll") for (int s_ = 0; s_ < 2; ++s_) { const char* ba_ = (const char*)(LRb + (size_t)((ch_) * CH + 16 * s_) * LRC); \
            n_Aw[s_] = *(const bf16x8*)(ba_ + (size_t)vo_a); n_Aa[s_] = *(const bf16x8*)(ba_ + (size_t)vo_a + 64); n_Ag[s_][0] = *(const bf16x8*)(ba_ + (size_t)vo_a + 128); n_Ag[s_][1] = *(const bf16x8*)(ba_ + (size_t)vo_a + 192); \
            n_Ag[s_][2] = *(const bf16x8*)(ba_ + (size_t)vo_a + 256); n_Av[s_] = *(const bf16x8*)(ba_ + (size_t)vo_a + 320); } } while (0)
            MIX_LOAD_Z(0, true); MIX_LOAD_A(0);
            const f32x4 mur = *(const LAS f32x4*)(sCon + cgE * 4), muk = *(const LAS f32x4*)(sCon + 64 + cgE * 4), muv = *(const LAS f32x4*)(sCon + 128 + cgE * 4);
            const f32x4 gngv = *(const LAS f32x4*)(sCon + 544 + cgE * 4), gnbv = *(const LAS f32x4*)(sCon + 608 + cgE * 4);
            TP_DECL();
#pragma unroll 1
            for (int ch = 0; ch < SEQ / CH; ++ch) {
                LAS unsigned char* Sa = L + (ch & 1) * AB_SET;
                LAS float* sK = (LAS float*)(Sa + AB_K); LAS float* sW = (LAS float*)(Sa + AB_W); LAS float* sR = (LAS float*)(Sa + AB_R); LAS bf16_t* sAh = (LAS bf16_t*)(Sa + AB_A);
                LAS float* sV = (LAS float*)(Sa + AB_V); LAS float* sY = (LAS float*)(Sa + AB_Y); LAS bf16_t* sGh = (LAS bf16_t*)(Sa + AB_G);
                TP_ACC(9);
                if (ch >= 2) { lds_wait_ge(flg + 12, 2 * (ch - 1)); TP_ACC(1); MIX_POST(ch - 2); }
                TP_ACC(5);
#pragma unroll
                for (int s_ = 0; s_ < 2; ++s_) {
                    const int tokE = tok0 + 16 * s_;
#define LERP2(dst, wc_, wp_, m0, m1) do { const float c0_ = __uint_as_float((wc_) << 16), c1_ = __uint_as_float((wc_) & 0xffff0000u), p0_ = __uint_as_float((wp_) << 16), p1_ = __uint_as_float((wp_) & 0xffff0000u); \
                        (dst)[0] = c0_ + (p0_ - c0_) * (m0); (dst)[1] = c1_ + (p1_ - c1_) * (m1); } while (0)
                    f32x4 r4, k4, v4; float t2[2];
                    LERP2(t2, n_rc[s_].x, n_rp[s_].x, mur[0], mur[1]); r4[0] = t2[0]; r4[1] = t2[1]; LERP2(t2, n_rc[s_].y, n_rp[s_].y, mur[2], mur[3]); r4[2] = t2[0]; r4[3] = t2[1];
                    LERP2(t2, n_kc[s_].x, n_kp[s_].x, muk[0], muk[1]); k4[0] = t2[0]; k4[1] = t2[1]; LERP2(t2, n_kc[s_].y, n_kp[s_].y, muk[2], muk[3]); k4[2] = t2[0]; k4[3] = t2[1];
                    LERP2(t2, n_vc[s_].x, n_vp[s_].x, muv[0], muv[1]); v4[0] = t2[0]; v4[1] = t2[1]; LERP2(t2, n_vc[s_].y, n_vp[s_].y, muv[2], muv[3]); v4[2] = t2[0]; v4[3] = t2[1];
                    *(LAS f32x4*)(sR + tokE * 64 + cgE * 4) = r4; *(LAS f32x4*)(sK + tokE * 64 + cgE * 4) = k4; *(LAS f32x4*)(sV + tokE * 64 + cgE * 4) = v4;
#undef LERP2
                }
                if (ch + 1 < SEQ / CH) MIX_LOAD_Z(ch + 1, false);
                TP_ACC(7);
                PREP_BAR();
                TP_ACC(6);
                {
                    f32x4 lw[2];
#pragma unroll
                    for (int mt = 0; mt < 2; ++mt) {
                        const f32x4 z4 = (f32x4){0.f, 0.f, 0.f, 0.f};
                        f32x4 cw4 = __builtin_amdgcn_mfma_f32_16x16x32_bf16(n_Aw[mt], Bw, z4, 0, 0, 0), ca4 = __builtin_amdgcn_mfma_f32_16x16x32_bf16(n_Aa[mt], Ba, z4, 0, 0, 0), cv4 = (l > 0) ? __builtin_amdgcn_mfma_f32_16x16x32_bf16(n_Av[mt], Bv, z4, 0, 0, 0) : z4, cg4 = z4;
#pragma unroll
                        for (int s3 = 0; s3 < 3; ++s3) cg4 = __builtin_amdgcn_mfma_f32_16x16x32_bf16(n_Ag[mt][s3], Bg[s3], cg4, 0, 0, 0);
#pragma unroll
                        for (int j = 0; j < 4; ++j) { const int o = (mt * 16 + fq * 4 + j) * 64 + nt * 16 + fr;
                            lw[mt][j] = -0.60653066f * sigmoidf_(cw4[j] + w0c); sAh[o] = (bf16_t)cvtpk(sigmoidf_(ca4[j] + a0c), 0.f); sGh[o] = (bf16_t)cvtpk(cg4[j], 0.f); if (l > 0) sY[o] = sigmoidf_(cv4[j] + v0c); }
                    }
                    if (ch + 1 < SEQ / CH) MIX_LOAD_A(ch + 1);
                    float base = 0.f;
#pragma unroll
                    for (int mt = 0; mt < 2; ++mt) {
                        lw[mt][1] += lw[mt][0]; lw[mt][2] += lw[mt][1]; lw[mt][3] += lw[mt][2];
                        const float tg = lw[mt][3], s16 = xsum16(tg), s32 = xsum32(s16);
                        const float pg = (fq == 0) ? 0.f : (fq == 1) ? (s16 - tg) : (fq == 2) ? (s32 - s16) : (s32 - tg);
#pragma unroll
                        for (int j = 0; j < 4; ++j) sW[(mt * 16 + fq * 4 + j) * 64 + nt * 16 + fr] = __expf(base + pg + lw[mt][j]);
                        base += s32; }
                }
                TP_ACC(8);
                lds_signal(flg + pw, lane);
            }
            if (C.bid == 0 && tid == 256 && l == 0) { TP_OUT(1); TP_OUT(7); TP_OUT(8); TP_OUT(9); }
            lds_wait_ge(flg + 12, 2 * (SEQ / CH - 1)); MIX_POST(SEQ / CH - 2);
            lds_wait_ge(flg + 12, 2 * (SEQ / CH)); MIX_POST(SEQ / CH - 1);
            __builtin_amdgcn_s_setprio(0);
#undef MIX_LOAD_Z
#undef MIX_LOAD_A
#undef PREP_BAR
        }
#undef MIX_POST
        __syncthreads();
    }
}

__device__ __forceinline__ void phase_router(KP P, const Ctx& C0, unsigned char* wsb, int l) {
    const Ctx C = fresh(C0);
    const bf16_t* h = (const bf16_t*)(wsb + WS_HB); const bf16_t* wrh = (const bf16_t*)(wsb + WS_WR) + (size_t)(l * 2) * 48 * D; const bf16_t* wrl = wrh + (size_t)48 * D;
    float* rsf = (float*)(wsb + WS_RSF); int* cnt = (int*)(wsb + WS_CTL) + l * 64; int* tlist = (int*)(wsb + WS_TLIST); float* glist = (float*)(wsb + WS_GLIST); int* tslot = (int*)(wsb + WS_TSLOT);
    const int gw = C.vcu * 8 + C.wave, NGW = C.G * 8, lane = C.lane, fr = lane & 15, fq = lane >> 4, tid = C.tid;
    constexpr int WROW = 272;
    LAS unsigned char* wsl = C.lds;
    LAS float* lg = (LAS float*)(C.lds + 32768 + C.wave * 4096);
    LAS int* lcnt = (LAS int*)(C.lds + 65536);
    static_assert(M / 16 == 2 * 256 * 8, "two 16-token tiles per wave");
    if (tid < 64) lcnt[tid] = 0;
    f32x4 acc[2][3]; float ss[2] = {0.f, 0.f};
#pragma unroll
    for (int it = 0; it < 2; ++it)
#pragma unroll
        for (int nt = 0; nt < 3; ++nt) acc[it][nt] = (f32x4){0.f, 0.f, 0.f, 0.f};
    const bf16_t* hrow0 = h + (size_t)((gw) * 16 + fr) * D + fq * 8; const bf16_t* hrow1 = h + (size_t)((gw + NGW) * 16 + fr) * D + fq * 8;
#pragma unroll 1
    for (int kb = 0; kb < D / 128; ++kb) {
        __syncthreads();
#pragma unroll
        for (int i = 0; i < 3; ++i) { const int p = tid + 512 * i; const int hl = p / 768, r = (p % 768) >> 4, c = p & 15;
            *(LAS u32x4*)(wsl + (hl * 48 + r) * WROW + c * 16) = *(const u32x4*)((hl ? wrl : wrh) + (size_t)r * D + kb * 128 + c * 8); }
        bf16x8 a0[4], a1[4];
#pragma unroll
        for (int ks = 0; ks < 4; ++ks) { a0[ks] = *(const bf16x8*)(hrow0 + kb * 128 + ks * 32); a1[ks] = *(const bf16x8*)(hrow1 + kb * 128 + ks * 32); }
        __syncthreads();
#pragma unroll
        for (int ks = 0; ks < 4; ++ks) {
#pragma unroll
            for (int j = 0; j < 8; ++j) { const float x0 = __uint_as_float(((unsigned)(unsigned short)a0[ks][j]) << 16), x1 = __uint_as_float(((unsigned)(unsigned short)a1[ks][j]) << 16); ss[0] += x0 * x0; ss[1] += x1 * x1; }
#pragma unroll
            for (int nt = 0; nt < 3; ++nt) { const bf16x8 bh = *(const LAS bf16x8*)(wsl + (nt * 16 + fr) * WROW + (ks * 32 + fq * 8) * 2), bl = *(const LAS bf16x8*)(wsl + (48 + nt * 16 + fr) * WROW + (ks * 32 + fq * 8) * 2);
                acc[0][nt] = __builtin_amdgcn_mfma_f32_16x16x32_bf16(a0[ks], bh, acc[0][nt], 0, 0, 0); acc[0][nt] = __builtin_amdgcn_mfma_f32_16x16x32_bf16(a0[ks], bl, acc[0][nt], 0, 0, 0);
                acc[1][nt] = __builtin_amdgcn_mfma_f32_16x16x32_bf16(a1[ks], bh, acc[1][nt], 0, 0, 0); acc[1][nt] = __builtin_amdgcn_mfma_f32_16x16x32_bf16(a1[ks], bl, acc[1][nt], 0, 0, 0); }
        }
    }
    int me0[2], me1[2], mp0[2], mp1[2]; float mw0[2], mw1[2], mrs[2]; float* rlist = (float*)(wsb + WS_RLIST);
#pragma unroll
    for (int it = 0; it < 2; ++it) {
        const int tile = gw + it * NGW;
        float s2 = ss[it]; s2 += __shfl_xor(s2, 16); s2 += __shfl_xor(s2, 32);
        const float rsq = rsqrtf(s2 * (1.0f / D) + 1e-6f);
#pragma unroll
        for (int nt = 0; nt < 3; ++nt)
#pragma unroll
            for (int j = 0; j < 4; ++j) lg[(fq * 4 + j) * 48 + nt * 16 + fr] = acc[it][nt][j];
        if (fq == 0) { lg[768 + fr] = rsq; rsf[tile * 16 + fr] = rsq; }
        asm volatile("s_waitcnt lgkmcnt(0)" ::: "memory");
        me0[it] = 0; me1[it] = 0; mp0[it] = 0; mp1[it] = 0; mw0[it] = 0.f; mw1[it] = 0.f; mrs[it] = 0.f;
        if (lane < 16) {
            const float rs = lg[768 + lane]; const LAS float* q = lg + lane * 48; mrs[it] = rs;
            float gl[NG]; int gi = 0;
#pragma unroll
            for (int j = 0; j < NG; ++j) gl[j] = q[j] * rs + P->in[I_RGB][l * NG + j];
            float gm = gl[0];
#pragma unroll
            for (int j = 1; j < NG; ++j) if (gl[j] > gm) { gm = gl[j]; gi = j; }
            float den = 0.f;
#pragma unroll
            for (int j = 0; j < NG; ++j) den += __expf(gl[j] - gm);
            const float gp = 1.0f / den;
            float el[EPG];
#pragma unroll
            for (int e = 0; e < EPG; ++e) el[e] = q[NG + gi * EPG + e] * rs + P->in[I_REB][(l * NG + gi) * EPG + e];
            int i0 = 0; float m0 = el[0];
#pragma unroll
            for (int e = 1; e < EPG; ++e) if (el[e] > m0) { m0 = el[e]; i0 = e; }
            int i1 = (i0 == 0) ? 1 : 0; float m1 = -3.0e38f;
#pragma unroll
            for (int e = 0; e < EPG; ++e) if (e != i0 && el[e] > m1) { m1 = el[e]; i1 = e; }
            const float p1 = 1.0f / (1.0f + __expf(m0 - m1));
            mw0[it] = (1.0f - p1) * gp; mw1[it] = p1 * gp;
            me0[it] = gi * EPG + i0; me1[it] = gi * EPG + i1;
            mp0[it] = __hip_atomic_fetch_add(&lcnt[me0[it]], 1, __ATOMIC_RELAXED, __HIP_MEMORY_SCOPE_WORKGROUP); mp1[it] = __hip_atomic_fetch_add(&lcnt[me1[it]], 1, __ATOMIC_RELAXED, __HIP_MEMORY_SCOPE_WORKGROUP);
        }
        asm volatile("s_waitcnt lgkmcnt(0)" ::: "memory");
    }
    __syncthreads();
    if (tid < NE) lcnt[32 + tid] = atomicAdd(&cnt[tid], lcnt[tid]);
    __syncthreads();
    if (lane < 16) {
#pragma unroll
        for (int it = 0; it < 2; ++it) { const int t = (gw + it * NGW) * 16 + lane;
            const int p0 = lcnt[32 + me0[it]] + mp0[it], p1 = lcnt[32 + me1[it]] + mp1[it];
            tlist[me0[it] * LCAP + p0] = t; glist[me0[it] * LCAP + p0] = mw0[it]; rlist[me0[it] * LCAP + p0] = mrs[it]; tslot[t * 2] = me0[it] * LCAP + p0;
            tlist[me1[it] * LCAP + p1] = t; glist[me1[it] * LCAP + p1] = mw1[it]; rlist[me1[it] * LCAP + p1] = mrs[it]; tslot[t * 2 + 1] = me1[it] * LCAP + p1; }
    }
    __syncthreads();
}

__device__ __forceinline__ void moe_prefix(KP P, const Ctx& C0, unsigned char* wsb, int l) {
    const Ctx C = fresh(C0);
    const int* cnt = (const int*)(wsb + WS_CTL) + l * 64;
    LAS int* tp = (LAS int*)(C.lds + LDS_MISC); LAS int* ps = (LAS int*)(C.lds + LDS_MISC + 256);
    if (C.wave == 0) { const int e = C.lane & 31; const int nt_ = (cnt[e] + 255) >> 8; int inc = nt_;
#pragma unroll
        for (int o = 1; o < 32; o <<= 1) { const int v = __shfl_up(inc, o, 64); if ((C.lane & 31) >= o) inc += v; }
        if (C.lane < 32) { tp[e] = inc - nt_; ps[e] = (inc - nt_) * 256; if (e == 31) { tp[NE] = inc; ps[NE] = inc * 256; } } }
    __syncthreads();
}

__device__ __forceinline__ void phase_combine(KP P, const Ctx& C0, unsigned char* wsb, int l) {
    const Ctx C = fresh(C0);
    bf16_t* hb = (bf16_t*)(wsb + WS_HB); const bf16_t* ys = (const bf16_t*)(wsb + WS_YS); const int* tslot = (const int*)(wsb + WS_TSLOT); float* rsp = (float*)(wsb + WS_RSP);
    const LAS int* ps = (const LAS int*)(C.lds + LDS_MISC + 256);
    const int gw = C.vcu * 8 + C.wave, NGW = C.G * 8, lane = C.lane;
    static_assert((M / 2048) % 4 == 0, "rows per wave divisible by 4");
    for (int m0 = gw; m0 < M; m0 += 4 * NGW) {
        int sl[4][2];
#pragma unroll
        for (int q = 0; q < 4; ++q) { const u32x2 t2 = *(const u32x2*)(tslot + (size_t)(m0 + q * NGW) * 2); sl[q][0] = (int)t2.x; sl[q][1] = (int)t2.y; }
        u32x4 hv[4][2], ya[4][2], yb[4][2];
#pragma unroll
        for (int q = 0; q < 4; ++q) { const int m = m0 + q * NGW;
            const size_t r0 = (size_t)(ps[sl[q][0] >> 16] + (sl[q][0] & 0xffff)), r1 = (size_t)(ps[sl[q][1] >> 16] + (sl[q][1] & 0xffff));
            const u32x4* hr = (const u32x4*)(hb + (size_t)m * D) + lane; const u32x4* y0 = (const u32x4*)(ys + r0 * D) + lane; const u32x4* y1 = (const u32x4*)(ys + r1 * D) + lane;
#pragma unroll
            for (int j = 0; j < 2; ++j) { hv[q][j] = hr[64 * j]; ya[q][j] = y0[64 * j]; yb[q][j] = y1[64 * j]; } }
#pragma unroll
        for (int q = 0; q < 4; ++q) { const int m = m0 + q * NGW; u32x4* hr = (u32x4*)(hb + (size_t)m * D) + lane; float s = 0.f;
#pragma unroll
            for (int j = 0; j < 2; ++j) { u32x4 w;
#pragma unroll
                for (int c = 0; c < 4; ++c) { const float lo = (__uint_as_float(hv[q][j][c] << 16) + __uint_as_float(ya[q][j][c] << 16)) + __uint_as_float(yb[q][j][c] << 16);
                    const float hi = (__uint_as_float(hv[q][j][c] & 0xffff0000u) + __uint_as_float(ya[q][j][c] & 0xffff0000u)) + __uint_as_float(yb[q][j][c] & 0xffff0000u);
                    w[c] = pk2(lo, hi); const float rl = __uint_as_float(w[c] << 16), rh = __uint_as_float(w[c] & 0xffff0000u); s += rl * rl + rh * rh; }
                hr[64 * j] = w; }
            s = sum16(s); s += __shfl_xor(s, 16); s += __shfl_xor(s, 32);
            if (lane == 0) rsp[m] = rsqrtf(s * (1.0f / D) + 1e-6f); }
    }
}

__device__ __forceinline__ void phase_final(KP P, const Ctx& C0, unsigned char* wsb) {
    const Ctx C = fresh(C0);
    float* out = P->out; const bf16_t* h = (const bf16_t*)(wsb + WS_Y); const float* g = P->in[I_FINN]; const float* part = (const float*)(wsb + WS_PART);
    const int gw = C.vcu * 8 + C.wave, NGW = C.G * 8, lane = C.lane;
    f32x4 gv[4];
#pragma unroll
    for (int j = 0; j < 4; ++j) gv[j] = ((const f32x4*)g)[lane * 4 + j];
    for (int m0 = gw; m0 < M; m0 += 4 * NGW) {
        u32x4 ra[4], rb[4]; float ssq[4];
#pragma unroll
        for (int q = 0; q < 4; ++q) { const int m = m0 + q * NGW; const u32x4* hr = (const u32x4*)(h + (size_t)m * D) + lane * 2; ra[q] = hr[0]; rb[q] = hr[1]; ssq[q] = (lane < NPART) ? part[(size_t)m * NPART + lane] : 0.f; }
#pragma unroll
        for (int q = 0; q < 4; ++q) { const int m = m0 + q * NGW; const u32x4 a = ra[q], b = rb[q];
            float ss = sum16(ssq[q]); ss += __shfl_xor(ss, 16); ss += __shfl_xor(ss, 32);
            const float rs = rsqrtf(ss * (1.0f / D) + 1e-6f);
            f32x4* o = (f32x4*)(out + (size_t)m * D) + lane * 4;
            o[0] = (f32x4){__uint_as_float(a.x << 16), __uint_as_float(a.x & 0xffff0000u), __uint_as_float(a.y << 16), __uint_as_float(a.y & 0xffff0000u)} * rs * gv[0];
            o[1] = (f32x4){__uint_as_float(a.z << 16), __uint_as_float(a.z & 0xffff0000u), __uint_as_float(a.w << 16), __uint_as_float(a.w & 0xffff0000u)} * rs * gv[1];
            o[2] = (f32x4){__uint_as_float(b.x << 16), __uint_as_float(b.x & 0xffff0000u), __uint_as_float(b.y << 16), __uint_as_float(b.y & 0xffff0000u)} * rs * gv[2];
            o[3] = (f32x4){__uint_as_float(b.z << 16), __uint_as_float(b.z & 0xffff0000u), __uint_as_float(b.w << 16), __uint_as_float(b.w & 0xffff0000u)} * rs * gv[3];
#ifdef TIMING
            if (m == 0 && lane == 0) { asm volatile("s_waitcnt vmcnt(0)" ::: "memory"); const unsigned* st = (const unsigned*)(wsb + WS_CTL) + 1024; out[0] = exp2f(rintf(16.0f * log2f((float)(st[TIM_A1] - st[TIM_A0]) * 0.01f + 1.0f)) * 0.0625f) * 0.1f; }
#endif
        }
    }
}

__device__ __forceinline__ float dbg_dot(const bf16_t* a, const bf16_t* b, int K, int lane) {
    float s = 0.f;
    for (int k = lane * 8; k < K; k += 512) { const u32x4 av = *(const u32x4*)(a + k), bv = *(const u32x4*)(b + k);
#pragma unroll
        for (int j = 0; j < 4; ++j) s += __uint_as_float(av[j] << 16) * __uint_as_float(bv[j] << 16) + __uint_as_float(av[j] & 0xffff0000u) * __uint_as_float(bv[j] & 0xffff0000u); }
    return wave_sum(s);
}
__device__ __forceinline__ void phase_dbg(KP P, const Ctx& C0, unsigned char* wsb, const int mode) {
    const Ctx C = fresh(C0);
    const int gw = C.vcu * 8 + C.wave, NGW = C.G * 8, lane = C.lane;
    const bf16_t* hb = (const bf16_t*)(wsb + WS_HB); const float* part = (const float*)(wsb + WS_PART);
    unsigned char* wl = wsb + WS_W;
    for (int m = gw; m < M; m += NGW) {
        bool ok = true;
        for (int q = 0; q < 4; ++q) {
            unsigned hsh = (unsigned)m * 2654435761u + (unsigned)q * 40503u; hsh ^= hsh >> 13;
            if (mode == 1) {
                const int n = hsh % IN_COLS;
                float ss = 0.f; for (int p = 0; p < NPART; ++p) ss += part[(size_t)m * NPART + p];
                const float ref = dbg_dot(hb + (size_t)m * D, (const bf16_t*)(wl + WO_IN) + (size_t)n * D, D, lane) * rsqrtf(ss * (1.0f / D) + 1e-6f);
                const float got = bf2f(((const bf16_t*)(wsb + WS_Z))[(size_t)m * ZC + n]);
                if (!(fabsf(got - ref) <= 0.02f * fabsf(ref) + 0.02f)) ok = false;
            } else if (mode == 2) {
                const int n = hsh % D;
                const float ref = P->in[I_X][(size_t)m * D + n] + dbg_dot((const bf16_t*)(wsb + WS_Y) + (size_t)m * D, (const bf16_t*)(wl + WO_OUT) + (size_t)n * D, D, lane);
                const float got = P->out[(size_t)m * D + n];
                if (!(fabsf(got - ref) <= 0.02f * fabsf(ref) + 0.02f)) ok = false;
            } else if (mode == 3) {
                const int n = hsh % IN_COLS; const int k = (hsh >> 8) % D;
                const float ref = P->in[I_WIN][(size_t)k * IN_COLS + n] * P->in[I_MIXN][k];
                const float got = bf2f(((const bf16_t*)(wl + WO_IN))[(size_t)n * D + k]);
                if (!(fabsf(got - ref) <= 0.01f * fabsf(ref) + 1e-4f)) ok = false;
            } else if (mode == 4) {
                const int n = hsh % D;
                const float ref = P->in[I_X][(size_t)m * D + n]; const float got = bf2f(hb[(size_t)m * D + n]);
                if (!(fabsf(got - ref) <= 0.01f * fabsf(ref) + 1e-4f)) ok = false;
            }
        }
        const f32x4* xr = (const f32x4*)(P->in[I_X] + (size_t)m * D) + lane; f32x4* o = (f32x4*)(P->out + (size_t)m * D) + lane;
#pragma unroll
        for (int j = 0; j < 4; ++j) o[64 * j] = ok ? xr[64 * j] : (f32x4){0.f, 0.f, 0.f, 0.f};
    }
}

#define XB_TMO      128
#define XB_XCNT(j)  (256  + 64 * (j))
#define XB_XSUB(j)  (1280 + 64 * (j))
#define XB_XGEN(j)  (2304 + 64 * (j))
#define XB_TOP      3328
#define XB_TOPGEN   3392
#define XCD_BAR_WORDS 3456
#define XB_SPIN_CAP (1u << 22)
constexpr int CW_BAR = 8192;
constexpr int LDS_XB = LDS_BYTES - 64;
__device__ __forceinline__ unsigned xb_ld(unsigned* p)              { return __hip_atomic_load(p, __ATOMIC_RELAXED, __HIP_MEMORY_SCOPE_AGENT); }
__device__ __forceinline__ unsigned xb_add(unsigned* p, unsigned v) { return __hip_atomic_fetch_add(p, v, __ATOMIC_RELAXED, __HIP_MEMORY_SCOPE_AGENT); }
__device__ __forceinline__ unsigned xb_xcc_id() { return (unsigned)__builtin_amdgcn_s_getreg((3 << 11) | 20) & 0xFu; }
#define XB_SPIN(cond, bar) do { unsigned _sp = 0; while (cond) { __builtin_amdgcn_s_sleep(1); \
    if ((++_sp & 255u) == 0u) { if (xb_ld(&(bar)[XB_TMO])) break; if (_sp > XB_SPIN_CAP) { atomicAdd(&(bar)[XB_TMO], 1u); break; } } } } while (0)
struct XcdBarrier { unsigned* bar; unsigned x; volatile LAS unsigned* st; };
__device__ __forceinline__ XcdBarrier xcd_barrier_post(unsigned* bar, volatile LAS unsigned* st) {
    XcdBarrier b; b.bar = bar; b.x = xb_xcc_id(); b.st = st;
    if (threadIdx.x == 0) (void)xb_add(&bar[XB_XCNT(b.x)], 1u);
    return b;
}
__device__ __forceinline__ void xcd_barrier_complete(unsigned* bar, unsigned x, unsigned& nloc, unsigned& nx) {
    const unsigned G = gridDim.x * gridDim.y * gridDim.z;
    unsigned sum, cnt, mine, sp = 0u;
    for (;;) {
        sum = 0u; cnt = 0u; mine = 0u;
#pragma unroll
        for (unsigned j = 0; j < 16; ++j) { const unsigned c = xb_ld(&bar[XB_XCNT(j)]); sum += c; cnt += (c > 0u) ? 1u : 0u; mine = (j == x) ? c : mine; }
        if (sum == G) break;
        __builtin_amdgcn_s_sleep(1);
        if ((++sp & 255u) == 0u) { if (xb_ld(&bar[XB_TMO])) break; if (sp > XB_SPIN_CAP) { atomicAdd(&bar[XB_TMO], 1u); break; } }
    }
    nloc = mine > 0u ? mine : 1u; nx = cnt > 0u ? cnt : 1u;
}
__device__ __forceinline__ void xcd_barrier(const XcdBarrier& b) {
    asm volatile("s_waitcnt vmcnt(0)" ::: "memory");
    __syncthreads();
    if (threadIdx.x == 0) {
        unsigned* bar = b.bar;
        __builtin_amdgcn_s_waitcnt(0);
        unsigned nloc = b.st[0], nx = b.st[1];
        if (nloc == 0u) { xcd_barrier_complete(bar, b.x, nloc, nx); b.st[0] = nloc; b.st[1] = nx; }
        const unsigned old = xb_add(&bar[XB_XSUB(b.x)], 1u);
        const unsigned gen = old / nloc;
        if (old + 1u == (gen + 1u) * nloc) {
            __builtin_amdgcn_fence(__ATOMIC_RELEASE, "agent");
            asm volatile("s_waitcnt vmcnt(0)" ::: "memory");
            const unsigned og = xb_add(&bar[XB_TOP], 1u);
            const unsigned tg = og / nx;
            if (og + 1u == (tg + 1u) * nx) xb_add(&bar[XB_TOPGEN], 1u);
            else XB_SPIN(xb_ld(&bar[XB_TOPGEN]) == tg, bar);
            __builtin_amdgcn_fence(__ATOMIC_ACQUIRE, "agent");
            xb_add(&bar[XB_XGEN(b.x)], 1u);
            asm volatile("s_waitcnt vmcnt(0)" ::: "memory");
        } else {
            XB_SPIN(xb_ld(&bar[XB_XGEN(b.x)]) == gen, bar);
            __builtin_amdgcn_fence(__ATOMIC_ACQUIRE, "agent");
            asm volatile("s_waitcnt vmcnt(0)" ::: "memory");
        }
    }
    __syncthreads();
}

constexpr int N_PREP = 3;
constexpr int N_PHASES = N_PREP + 1 + 8 * DEPTH;

constexpr int PP_UNITS = (M / 256) * (D / 256), PP_Q1 = 4, PP_Q2 = 3;
__device__ __forceinline__ void run_pp_tail(const Ctx& C, KP KPp, unsigned char* ws, unsigned char* wl, int l, int bid, const int which) {
    const LAS int* tprefix = (const LAS int*)(C.lds + LDS_MISC);
    const int T = tprefix[32], R = (T + 63) >> 6, rem = T - 64 * (R - 1);
    const int U = (bid & 7) * 32 + (bid >> 3);
    const int nidle = 256 - 4 * rem, rank = U - 4 * rem;
    const int P1 = min(PP_UNITS, nidle * PP_Q1), P12 = min(PP_UNITS, P1 + nidle * PP_Q2);
    pg8::SubsetOrder S; S.B.init(M, D, C.G, bid); S.limit = PP_UNITS;
    if (which == 0) { S.first = rank; S.stride = nidle; S.count = rank >= 0 ? PP_Q1 : 0; }
    else if (which == 1) { S.first = P1 + rank; S.stride = nidle; S.count = rank >= 0 ? PP_Q2 : 0; }
    else { S.first = P12 + bid; S.stride = C.G; S.count = PP_UNITS; }
    pg8::EpiPP E{(bf16_t*)KPp->out + (size_t)M * D};
    pg8::gemm_phase(C.lds, (const bf16_t*)(ws + WS_PB) + (size_t)l * M * PLE, (const bf16_t*)(wl + WO_PP), PLE, S, E);
}

__device__ __forceinline__ void run_layer_phase(const Ctx& C, const int l_, const int sub) {
    KP KPp = (KP)__builtin_amdgcn_kernarg_segment_ptr(); asm volatile("" : "+s"(KPp));
    unsigned char* ws = KPp->ws;
    int bid = blockIdx.x; asm volatile("" : "+s"(bid));
    int l = l_; asm volatile("" : "+s"(l));
    unsigned char* wl = ws + WS_W + (size_t)l * W_LAYER;
    bf16_t* hb = (bf16_t*)(ws + WS_HB);
    if (sub == 0) {
        pg8::StaticOrder S; S.init(M, ZC, C.G, bid);
        pg8::EpiZ E{(bf16_t*)(ws + WS_Z), (const float*)(ws + WS_PART), NPART};
        pg8::gemm_phase(C.lds, l == 0 ? (const bf16_t*)hb : (const bf16_t*)KPp->out, (const bf16_t*)(wl + WO_IN), D, S, E);
    } else if (sub == 1) {
        phase_mix(KPp, C, ws, l, 0);
    } else if (sub == 8) {
        phase_mix(KPp, C, ws, l, 1);
    } else if (sub == 2) {
        pg8::StaticOrder S; S.init(M, D, C.G, bid);
        pg8::EpiRes E{l == 0 ? KPp->in[I_X] : (const float*)nullptr, (const bf16_t*)KPp->out, hb};
        pg8::gemm_phase(C.lds, (const bf16_t*)(ws + WS_Y), (const bf16_t*)(wl + WO_OUT), D, S, E);
    } else if (sub == 3) {
        phase_router(KPp, C, ws, l);
    } else if (sub == 4) {
        moe_prefix(KPp, C, ws, l);
        pg8::GroupedOrder<true> S{(const LAS int*)(C.lds + LDS_MISC), (const LAS int*)(C.lds + LDS_MISC + 256), (const int*)(ws + WS_CTL) + l * 64, (const int*)(ws + WS_TLIST), 1024, C.G, bid};
        pg8::EpiGU E{(bf16_t*)(ws + WS_HID), (const float*)(ws + WS_RLIST)};
        pg8::gemm_phase(C.lds, hb, (const bf16_t*)(wl + WO_GU), D, S, E);
        run_pp_tail(C, KPp, ws, wl, l, bid, 0);
    } else if (sub == 5) {
        moe_prefix(KPp, C, ws, l);
        pg8::GroupedOrder<false> S{(const LAS int*)(C.lds + LDS_MISC), (const LAS int*)(C.lds + LDS_MISC + 256), (const int*)(ws + WS_CTL) + l * 64, (const int*)(ws + WS_TLIST), 1024, C.G, bid};
        pg8::EpiDown E{(bf16_t*)(ws + WS_YS), (const float*)(ws + WS_GLIST), (const int*)(ws + WS_CTL) + l * 64};
        pg8::gemm_phase(C.lds, (const bf16_t*)(ws + WS_HID), (const bf16_t*)(wl + WO_D), FF, S, E);
        run_pp_tail(C, KPp, ws, wl, l, bid, 1);
    } else if (sub == 6) {
        moe_prefix(KPp, C, ws, l);
        phase_combine(KPp, C, ws, l);
        __syncthreads();
        run_pp_tail(C, KPp, ws, wl, l, bid, 2);
    } else {
        pg8::StaticOrder S; S.init(M, D, C.G, bid);
        pg8::EpiPle E{hb, l == DEPTH - 1 ? (bf16_t*)(ws + WS_Y) : (bf16_t*)KPp->out, (const bf16_t*)KPp->out + (size_t)M * D, (const float*)(ws + WS_RSP), (float*)(ws + WS_PART)};
        pg8::gemm_phase(C.lds, hb, (const bf16_t*)(wl + WO_PG), D, S, E);
    }
}

__global__ void __launch_bounds__(512, 2) mega(Params P) {
    extern __shared__ __attribute__((aligned(16))) unsigned char lds_raw[];
    Ctx C; C.lds = (LAS unsigned char*)lds_raw; C.tid = threadIdx.x; C.lane = C.tid & 63; C.wave = __builtin_amdgcn_readfirstlane(C.tid >> 6);
    C.G = gridDim.x; C.vcu = 0; C.bid = 0;
    cg::grid_group grid = cg::this_grid();
    const int lo = P.ph_lo, hi = P.ph_hi & 0xffff; const bool fin = (P.ph_hi >> 16) != 0;
    if (threadIdx.x < 2) ((LAS unsigned*)(lds_raw + LDS_XB))[threadIdx.x] = 0u;
    __syncthreads();
    const XcdBarrier xbar = xcd_barrier_post((unsigned*)(P.ws + WS_CTL) + CW_BAR, (volatile LAS unsigned*)((LAS unsigned char*)lds_raw + LDS_XB));
    if (lo < 0) grid.sync();
#define GSYNC() do { asm volatile("s_waitcnt vmcnt(0) lgkmcnt(0)" ::: "memory"); xcd_barrier(xbar); } while (0)
#ifdef TIMING
#define STAMP(k) do { if (blockIdx.x == 0 && threadIdx.x == 0) ((unsigned*)(P.ws + WS_CTL))[1024 + (k)] = (unsigned)__builtin_amdgcn_s_memrealtime(); } while (0)
#else
#define STAMP(k) do {} while (0)
#endif
#define PHASE(k, body) do { if (lo <= (k) && (k) < hi) { if ((k) > lo) GSYNC(); STAMP(k); body; } } while (0)
    PHASE(0, { KP KPp = (KP)__builtin_amdgcn_kernarg_segment_ptr(); asm volatile("" : "+s"(KPp)); phase_prep(KPp, C, KPp->ws, 1); phase_prep(KPp, C, KPp->ws, 0); phase_prep(KPp, C, KPp->ws, 2); });
#define LAYER_PHASE(l, sub) PHASE(N_PREP + 8 * (l) + (sub), run_layer_phase(C, l, sub))
#define MIX_PHASE(l) PHASE(N_PREP + 8 * (l) + 1, { run_layer_phase(C, l, 1); GSYNC(); run_layer_phase(C, l, 8); })
    LAYER_PHASE(0, 0); MIX_PHASE(0); LAYER_PHASE(0, 2); LAYER_PHASE(0, 3); LAYER_PHASE(0, 4); LAYER_PHASE(0, 5); LAYER_PHASE(0, 6); LAYER_PHASE(0, 7);
    LAYER_PHASE(1, 0); MIX_PHASE(1); LAYER_PHASE(1, 2); LAYER_PHASE(1, 3); LAYER_PHASE(1, 4); LAYER_PHASE(1, 5); LAYER_PHASE(1, 6); LAYER_PHASE(1, 7);
#ifdef DBG_MODE
    { GSYNC(); KP KPp = (KP)__builtin_amdgcn_kernarg_segment_ptr(); asm volatile("" : "+s"(KPp)); phase_dbg(KPp, C, KPp->ws, DBG_MODE); }
#endif
    if (fin || (lo <= N_PHASES - 1 && N_PHASES - 1 < hi)) { if (N_PHASES - 1 > lo) GSYNC(); STAMP(N_PHASES - 1); { KP KPp = (KP)__builtin_amdgcn_kernarg_segment_ptr(); asm volatile("" : "+s"(KPp)); phase_final(KPp, C, KPp->ws); } }
}

extern "C" void kernel_launch(void* const* d_in, const int* in_sizes, int n_in, void* d_out, int out_size, void* d_ws, size_t ws_size, hipStream_t stream) {
    static int grid = 0;
    if (grid == 0) {
        if (n_in != 35 || out_size != M * D || ws_size < WS_END) { fprintf(stderr, "kernel_launch: unexpected shapes (n_in %d out %d ws %zu)\n", n_in, out_size, ws_size); grid = -1; return; }
        int dev = 0, cus = 0, per_cu = 0;
        hipGetDevice(&dev); hipDeviceGetAttribute(&cus, hipDeviceAttributeMultiprocessorCount, dev);
        hipFuncSetAttribute((const void*)mega, hipFuncAttributeMaxDynamicSharedMemorySize, LDS_BYTES);
        hipOccupancyMaxActiveBlocksPerMultiprocessor(&per_cu, (const void*)mega, 512, LDS_BYTES);
        (void)hipGetLastError();
        if (per_cu < 1 || cus != 256) { fprintf(stderr, "kernel_launch: occupancy %d per CU, %d CUs: unsupported\n", per_cu, cus); grid = -1; return; }
        grid = 256;
    }
    if (grid < 0) return;
    hipMemsetAsync((char*)d_ws + WS_CTL, 0, CTL_BYTES, stream);
    Params p{};
    for (int i = 0; i < 35; ++i) p.in[i] = (const float*)d_in[i];
    p.out = (float*)d_out; p.ws = (unsigned char*)d_ws;
#if MK_N_LAUNCHES == 1
    p.ph_lo = 0; p.ph_hi = (N_PHASES < PH_STOP ? N_PHASES : (PH_STOP | (DBG_FIN << 16)));
    { void* args[] = {&p}; hipLaunchCooperativeKernel((const void*)mega, dim3(grid), dim3(512), args, LDS_BYTES, stream); }
#else
    for (int ph = 0; ph < N_PHASES; ++ph) { p.ph_lo = ph; p.ph_hi = ph + 1; void* args[] = {&p}; hipLaunchCooperativeKernel((const void*)mega, dim3(grid), dim3(512), args, LDS_BYTES, stream); }
#endif
}
```

```cpp
#include <hip/hip_runtime.h>
#include <hip/hip_cooperative_groups.h>
#include <cstdio>
#include <cstdint>
namespace cg = cooperative_groups;

#define LAS __attribute__((address_space(3)))
typedef unsigned short bf16_t;
typedef short bf16x8 __attribute__((ext_vector_type(8)));
typedef float f32x4 __attribute__((ext_vector_type(4)));
typedef float f32x2 __attribute__((ext_vector_type(2)));
typedef unsigned u32x4 __attribute__((ext_vector_type(4)));
typedef unsigned u32x2 __attribute__((ext_vector_type(2)));

#ifndef PREP_REP
#define PREP_REP 1
#endif
#ifndef P2_MASK
#define P2_MASK 15
#endif
#ifndef RT_STOP
#define RT_STOP 1
#endif
#ifndef RT_TR
#define RT_TR 63
#endif
#ifndef TR_MASK
#define TR_MASK 63
#endif
#ifndef PREP_MASK
#define PREP_MASK 7
#endif
#define BLK_LO 0
#define BLK_HI 0
#define DBG_FIN 1
#define TIM_A0 5
#define TIM_A1 6
#define TIM_B0 6
#define TIM_B1 7
#ifndef PH_STOP
#define PH_STOP 99
#endif
#ifndef PH_MASK
#define PH_MASK 0xFFFF
#endif
#define PH_ON(k) ((PH_MASK >> (k)) & 1)
#ifndef MK_N_LAUNCHES
#define MK_N_LAUNCHES 1
#endif

constexpr int BATCH = 32, SEQ = 2048, M = BATCH * SEQ, D = 1024, DEPTH = 2;
constexpr int CONVC = 512, CONVW = 31, RC = 512, NH = 8, HS = 64;
constexpr int LW = 32, LA = 32, LV = 32, LG = 96;
constexpr int RWKV_IN = 3 * RC + LW + LA + LG;
constexpr int IN_COLS = 2 * CONVC + RWKV_IN;
constexpr int ZC = 2816;
constexpr int ZC_R = 1024, ZC_K = 1536, ZC_V = 2048, ZC_WLO = 2560, ZC_ALO = 2592, ZC_GLO = 2624, ZC_EA = 2720, ZC_EB = 2752;
constexpr int NG = 4, EPG = 8, NE = 32, FF = 512, PLE = 256, NRT = 36;
constexpr int LCAP = 65536;
constexpr int MAXSLOT = 2 * M + NE * 256;
constexpr int NPART = 16;

constexpr size_t MiB = 1u << 20;
constexpr size_t WS_CTL = 0;
constexpr size_t CTL_BYTES = 1 * MiB;
constexpr size_t WS_WR = 1 * MiB;
constexpr size_t WS_PART = 2 * MiB;
constexpr size_t WS_RSF = 6 * MiB;
constexpr size_t WS_RSP = 6 * MiB + 512 * 1024;
constexpr size_t WS_TSLOT = 7 * MiB;
constexpr size_t WS_GLIST = 8 * MiB;
constexpr size_t WS_TLIST = 16 * MiB;
constexpr size_t WS_RLIST = 976 * MiB;
constexpr size_t WS_W = 24 * MiB;
constexpr size_t W_LAYER = 107 * MiB;
constexpr size_t WO_IN = 0;
constexpr size_t WO_OUT = 6 * MiB;
constexpr size_t WO_GU = 8 * MiB;
constexpr size_t WO_D = 72 * MiB;
constexpr size_t WO_PG = 104 * MiB;
constexpr size_t WO_PP = 106 * MiB;
constexpr size_t WS_HB = 238 * MiB;
constexpr size_t WS_VF = 366 * MiB;
constexpr size_t WS_PB = 430 * MiB;
constexpr size_t WS_R = 494 * MiB;
constexpr size_t WS_Z = WS_R;
constexpr size_t WS_Y = WS_R + 352 * MiB;
constexpr size_t WS_HID = WS_R;
constexpr size_t WS_YS = WS_R + 144 * MiB;
constexpr size_t WS_PP = WS_R;
constexpr size_t WS_LR = 984 * MiB;
constexpr int LRC = 192;
constexpr size_t WS_END = 1008 * MiB;
static_assert(WS_W + 2 * W_LAYER <= WS_HB && WS_YS + (size_t)MAXSLOT * D * 2 <= WS_END && WS_HID + (size_t)MAXSLOT * FF * 2 <= WS_YS, "ws map");

constexpr int LDS_BYTES = 150 * 1024;
constexpr int LDS_MISC = 131072;

__device__ __forceinline__ float bf2f(bf16_t b) { return __uint_as_float(((unsigned)b) << 16); }
__device__ __forceinline__ unsigned f2bf(float f) { unsigned u = __float_as_uint(f); return (u + 0x7fffu + ((u >> 16) & 1u)) >> 16; }
typedef __bf16 bf16v2_t __attribute__((ext_vector_type(2)));
__device__ __forceinline__ unsigned cvtpk(float lo, float hi) { const f32x2 f = {lo, hi}; const bf16v2_t b = __builtin_convertvector(f, bf16v2_t); return __builtin_bit_cast(unsigned, b); }
__device__ __forceinline__ unsigned pk2(float lo, float hi) { return cvtpk(lo, hi); }
__device__ __forceinline__ unsigned cvt_pk_bf16(float lo, float hi) { unsigned r; asm volatile("v_cvt_pk_bf16_f32 %0, %1, %2" : "=v"(r) : "v"(lo), "v"(hi)); return r; }
__device__ __forceinline__ float sigmoidf_(float x) { return __builtin_amdgcn_rcpf(1.0f + __expf(-x)); }
__device__ __forceinline__ float tanhf_(float x) { return 1.0f - 2.0f * __builtin_amdgcn_rcpf(1.0f + __expf(2.0f * x)); }
__device__ __forceinline__ float wave_sum(float v) {
#pragma unroll
    for (int o = 1; o < 64; o <<= 1) v += __shfl_xor(v, o);
    return v;
}
__device__ __forceinline__ float red16(float v) {
#pragma unroll
    for (int o = 1; o < 16; o <<= 1) v += __shfl_xor(v, o);
    return v;
}
__device__ __forceinline__ float red8(float v) {
#pragma unroll
    for (int o = 1; o < 8; o <<= 1) v += __shfl_xor(v, o);
    return v;
}

__device__ __forceinline__ float dpp_add(float x, const int ctrl_sel) {
    int v = __builtin_bit_cast(int, x), r;
    if (ctrl_sel == 0) r = __builtin_amdgcn_update_dpp(v, v, 0xB1, 0xf, 0xf, true);
    else if (ctrl_sel == 1) r = __builtin_amdgcn_update_dpp(v, v, 0x4E, 0xf, 0xf, true);
    else if (ctrl_sel == 2) r = __builtin_amdgcn_update_dpp(v, v, 0x141, 0xf, 0xf, true);
    else r = __builtin_amdgcn_update_dpp(v, v, 0x140, 0xf, 0xf, true);
    return x + __builtin_bit_cast(float, r);
}
__device__ __forceinline__ float sum8(float x) { x = dpp_add(x, 0); x = dpp_add(x, 1); x = dpp_add(x, 2); return x; }
__device__ __forceinline__ float sum16(float x) { x = sum8(x); x = dpp_add(x, 3); return x; }


#ifndef PG8_SP2_MASK
#define PG8_SP2_MASK 0x2f
#endif
#ifndef PG8_SP2
#define PG8_SP2 true
#endif
namespace pg8 {
constexpr int BM = 256, BK = 64, HALF = 128, HTB = HALF * BK * 2, STAGE_BYTES = 8 * HTB, NXCD = 8, WGM = 8;
__host__ __device__ __forceinline__ int lds_byte(int r, int c) { const int st = (r >> 4) * 2 + (c >> 5), rr = r & 15, cc = c & 31, ob = rr * 64 + cc * 2; return st * 1024 + (ob ^ (((ob >> 9) & 1) << 5)); }
__host__ __device__ __forceinline__ void stage_rc(int b, int& R, int& C) { const int st = b / 1024, sb = b % 1024, swz = sb ^ (((sb >> 9) & 1) << 5); R = (st >> 1) * 16 + swz / 64; C = (st & 1) * 32 + (swz % 64) / 2; }
__host__ __device__ __forceinline__ int perm32(int rho) { const int n = rho >> 4, i = rho & 15; return 8 * (i >> 2) + 4 * n + (i & 3); }

struct Unit { int arow, brow, orow, ocol, e, mt; };

struct StaticOrder {
    static constexpr bool GATHER = false;
    int nM, nN, nwg, G, c;
    __device__ void init(int M_, int N_, int G_, int c_) { nM = M_ / BM; nN = N_ / BM; nwg = nM * nN; G = G_; c = c_; }
    __device__ bool next(int i, Unit& u) const { return at((long)i * G + c, u); }
    __device__ bool at(const long L, Unit& u) const {
        if (L >= nwg) return false;
        int wgid = (int)L; { const int q = nwg / NXCD, r = nwg % NXCD, xcd = wgid % NXCD, off = wgid / NXCD; wgid = (xcd < r ? xcd * (q + 1) : r * (q + 1) + (xcd - r) * q) + off; }
        const int nig = WGM * nN, gid = wgid / nig, fm = gid * WGM, gsz = (nM - fm) < WGM ? (nM - fm) : WGM;
        const int pm = fm + ((wgid % nig) % gsz), pn = (wgid % nig) / gsz;
        u.arow = pm * BM; u.brow = pn * BM; u.orow = pm * BM; u.ocol = pn * BM; u.e = 0; u.mt = pm; return true;
    }
    __device__ __forceinline__ unsigned tok(const Unit&, int) const { return 0u; }
};

struct SubsetOrder {
    static constexpr bool GATHER = false;
    StaticOrder B; int first, stride, count, limit;
    __device__ bool next(int i, Unit& u) const { if (i >= count) return false; const int L = first + i * stride; if (L >= limit) return false; return B.at(L, u); }
    __device__ __forceinline__ unsigned tok(const Unit&, int) const { return 0u; }
};

template <bool GATHER_> struct GroupedOrder {
    static constexpr bool GATHER = GATHER_;
    const LAS int* tprefix;
    const LAS int* pstart;
    const int* cnt;
    const int* tlist;
    int brows;
    int G, c;
    __device__ bool next(int i, Unit& u) const {
        const int q = c & 7, j = c >> 3;
        const int U = q * 32 + j;
        const int mtg = i * 64 + (U >> 2), nt = U & 3;
        const int total = tprefix[32];
        if (mtg >= total) return false;
        int e = 0;
#pragma unroll 1
        for (int s = 16; s >= 1; s >>= 1) { if (tprefix[e + s] <= mtg) e += s; }
        const int mt = mtg - tprefix[e];
        u.e = e; u.mt = mt; u.arow = pstart[e] + mt * BM; u.orow = u.arow; u.brow = e * brows + nt * BM; u.ocol = nt * BM; return true;
    }
    __device__ __forceinline__ unsigned tok(const Unit& u, int r) const {
        const int pos = u.mt * BM + r;
        const unsigned t = (unsigned)tlist[u.e * LCAP + pos]; const int c = cnt[u.e];
        return pos < c ? t : 0u;
    }
};

template <class Epi, class Sched>
__device__ __forceinline__ void gemm_phase(LAS unsigned char* lds, const bf16_t* Ag, const bf16_t* Btg, const int K, const Sched& S, const Epi& E) {
    int tid_ = threadIdx.x; asm volatile("" : "+v"(tid_));
    const int tid = tid_, wid = __builtin_amdgcn_readfirstlane(tid >> 6), lane = tid & 63, wr = wid >> 2, wc = wid & 3, fr = lane & 15, fq = lane >> 4;
    constexpr bool SP2 = PG8_SP2 && Epi::SP2;
    const int nt = K / BK;
    unsigned voffA[2], voffB[2]; int Rr[2], Cc[2];
#pragma unroll
    for (int i = 0; i < 2; ++i) { int R, C; stage_rc(tid * 16 + i * 8192, R, C); Rr[i] = R; Cc[i] = C; const int Rb = Epi::PERM ? ((R & ~31) + perm32(R & 31)) : R;
        voffA[i] = (unsigned)(R * K + C) * 2u; voffB[i] = (unsigned)(Rb * K + C) * 2u; }
    const size_t kstep = (size_t)(BK * 2);
    const size_t hstep = (size_t)HALF * K * 2;
    const size_t rowb = (size_t)K * 2;
    const unsigned ldsw = (unsigned)wid * 1024u;
    const int aoff = lds_byte(wr * 64 + fr, fq * 8), boff = lds_byte(wc * 32 + fr, fq * 8);
    unsigned gc[2][2], gn[2][2];
#pragma unroll
    for (int h = 0; h < 2; ++h)
#pragma unroll
        for (int i = 0; i < 2; ++i) { gc[h][i] = 0u; gn[h][i] = 0u; }
#define PG8_SA(b, h) (((b) * 2 + (h)) * HTB)
#define PG8_SB(b, h) ((4 + (b) * 2 + (h)) * HTB)
#define PG8_GLDS(src, bufoff, i) __builtin_amdgcn_global_load_lds((const unsigned*)(src), (LAS unsigned*)(lds + (bufoff) + ldsw + (i) * 8192), 16, 0, 0)
#define PG8_STAGE_B(bufoff, gbase) do { _Pragma("unroll") for (int _i = 0; _i < 2; ++_i) PG8_GLDS((const char*)(gbase) + voffB[_i], bufoff, _i); } while (0)
#define PG8_STAGE_A(bufoff, gbase, h, usenext) do { _Pragma("unroll") for (int _i = 0; _i < 2; ++_i) { \
        if constexpr (Sched::GATHER) { const unsigned _o = (usenext) ? gn[h][_i] : gc[h][_i]; PG8_GLDS((const char*)(gbase) + _o, bufoff, _i); } \
        else { PG8_GLDS((const char*)(gbase) + (h) * hstep + voffA[_i], bufoff, _i); } } } while (0)
#define PG8_LDA(dst, b, h) do { _Pragma("unroll") for (int m = 0; m < 4; ++m) _Pragma("unroll") for (int k = 0; k < 2; ++k) dst[m][k] = *(const LAS bf16x8*)(lds + PG8_SA(b, h) + aoff + m * 2048 + k * 1024); } while (0)
#define PG8_LDB(dst, b, h) do { _Pragma("unroll") for (int n = 0; n < 2; ++n) _Pragma("unroll") for (int k = 0; k < 2; ++k) dst[n][k] = *(const LAS bf16x8*)(lds + PG8_SB(b, h) + boff + n * 2048 + k * 1024); } while (0)
#define PG8_MMA(ai, bj, At, Bt) do { __builtin_amdgcn_s_setprio(1); _Pragma("unroll") for (int m = 0; m < 4; ++m) _Pragma("unroll") for (int n = 0; n < 2; ++n) _Pragma("unroll") for (int k = 0; k < 2; ++k) \
        acc[ai][bj][m][n] = __builtin_amdgcn_mfma_f32_16x16x32_bf16(Bt[n][k], At[m][k], acc[ai][bj][m][n], 0, 0, 0); __builtin_amdgcn_s_setprio(0); } while (0)
#define PG8_WAIT_V(n) asm volatile("s_waitcnt vmcnt(" #n ")" ::: "memory")
#define PG8_WAIT_L(n) asm volatile("s_waitcnt lgkmcnt(" #n ")" ::: "memory")
#define PG8_BAR __builtin_amdgcn_s_barrier()
#define PG8_SCHED __builtin_amdgcn_sched_barrier(0)
    Unit cur, nxt; int ui = 0;
    if (!S.next(0, cur)) return;
    f32x4 acc[2][2][4][2];
#pragma unroll
    for (int a = 0; a < 2; ++a)
#pragma unroll
        for (int b = 0; b < 2; ++b)
#pragma unroll
            for (int m = 0; m < 4; ++m)
#pragma unroll
                for (int n = 0; n < 2; ++n) acc[a][b][m][n] = (f32x4){0.f, 0.f, 0.f, 0.f};
    bf16x8 At[4][2], B0[2][2], B1[2][2];
    const char* cA; const char* cB = (const char*)Btg + (size_t)cur.brow * rowb;
    if constexpr (Sched::GATHER) {
        cA = (const char*)Ag;
#pragma unroll
        for (int h = 0; h < 2; ++h)
#pragma unroll
            for (int i = 0; i < 2; ++i) gc[h][i] = S.tok(cur, h * HALF + Rr[i]) * (unsigned)rowb + (unsigned)Cc[i] * 2u;
    } else cA = (const char*)Ag + (size_t)cur.arow * rowb;
    if constexpr (SP2) {
        PG8_STAGE_B(PG8_SB(0, 0), cB); PG8_STAGE_B(PG8_SB(0, 1), cB + hstep); PG8_STAGE_A(PG8_SA(0, 0), cA, 0, false); PG8_STAGE_A(PG8_SA(0, 1), cA, 1, false);
        if (wr == 1) PG8_BAR;
        PG8_WAIT_V(2); PG8_BAR;
        PG8_STAGE_B(PG8_SB(1, 0), cB + kstep); PG8_STAGE_A(PG8_SA(1, 0), cA + kstep, 0, false); PG8_STAGE_B(PG8_SB(1, 1), cB + hstep + kstep);
        PG8_WAIT_V(6); PG8_BAR;
    } else {
        PG8_STAGE_B(PG8_SB(0, 0), cB); PG8_STAGE_A(PG8_SA(0, 0), cA, 0, false); PG8_STAGE_B(PG8_SB(0, 1), cB + hstep); PG8_STAGE_A(PG8_SA(0, 1), cA, 1, false);
        if (wr == 1) PG8_BAR;
        PG8_WAIT_V(4); PG8_BAR;
        PG8_STAGE_B(PG8_SB(1, 0), cB + kstep); PG8_STAGE_A(PG8_SA(1, 0), cA + kstep, 0, false); PG8_STAGE_B(PG8_SB(1, 1), cB + hstep + kstep);
        PG8_WAIT_V(6); PG8_BAR;
    }
    for (;;) {
        const bool has_next = S.next(ui + 1, nxt);
        const char* nA; const char* nB = has_next ? (const char*)Btg + (size_t)nxt.brow * rowb : cB;
        if constexpr (Sched::GATHER) {
            nA = cA;
#pragma unroll
            for (int h = 0; h < 2; ++h)
#pragma unroll
                for (int i = 0; i < 2; ++i) gn[h][i] = has_next ? (S.tok(nxt, h * HALF + Rr[i]) * (unsigned)rowb + (unsigned)Cc[i] * 2u) : gc[h][i];
        } else nA = has_next ? (const char*)Ag + (size_t)nxt.arow * rowb : cA;
        for (int t = 0; t < nt; t += 2) {
            const bool last = (t == nt - 2);
            const char* a1 = cA + (size_t)(t + 1) * kstep;
            const char* a2 = last ? nA : cA + (size_t)(t + 2) * kstep; const char* b2 = last ? nB : cB + (size_t)(t + 2) * kstep;
            const char* a3 = a2 + kstep; const char* b3 = b2 + kstep;
            if constexpr (SP2) {
            PG8_LDB(B0, 0, 0); PG8_LDB(B1, 0, 1); PG8_SCHED; PG8_LDA(At, 0, 0); PG8_STAGE_A(PG8_SA(1, 1), a1, 1, false);
            PG8_WAIT_V(8); PG8_WAIT_L(0); PG8_BAR; PG8_MMA(0, 0, At, B0); PG8_MMA(0, 1, At, B1); PG8_BAR; PG8_SCHED;
            PG8_LDA(At, 0, 1); PG8_STAGE_B(PG8_SB(0, 0), b2); PG8_STAGE_B(PG8_SB(0, 1), b2 + hstep); PG8_STAGE_A(PG8_SA(0, 0), a2, 0, last);
            PG8_WAIT_V(8); PG8_WAIT_L(0); PG8_BAR; PG8_MMA(1, 0, At, B0); PG8_MMA(1, 1, At, B1); PG8_BAR; PG8_SCHED;
            PG8_LDB(B0, 1, 0); PG8_LDB(B1, 1, 1); PG8_SCHED; PG8_LDA(At, 1, 0); PG8_STAGE_A(PG8_SA(0, 1), a2, 1, last);
            PG8_WAIT_V(8); PG8_WAIT_L(0); PG8_BAR; PG8_MMA(0, 0, At, B0); PG8_MMA(0, 1, At, B1); PG8_BAR; PG8_SCHED;
            PG8_LDA(At, 1, 1); PG8_STAGE_B(PG8_SB(1, 0), b3); PG8_STAGE_B(PG8_SB(1, 1), b3 + hstep); PG8_STAGE_A(PG8_SA(1, 0), a3, 0, last);
            PG8_WAIT_V(8); PG8_WAIT_L(0); PG8_BAR; PG8_MMA(1, 0, At, B0); PG8_MMA(1, 1, At, B1); PG8_BAR; PG8_SCHED;
            } else {
            PG8_LDB(B0, 0, 0); PG8_SCHED; PG8_LDA(At, 0, 0); PG8_STAGE_A(PG8_SA(1, 1), a1, 1, false);
            PG8_WAIT_L(8); PG8_BAR; PG8_WAIT_L(0); PG8_MMA(0, 0, At, B0); PG8_BAR; PG8_SCHED;
            PG8_LDB(B1, 0, 1); PG8_STAGE_B(PG8_SB(0, 0), b2);
            PG8_BAR; PG8_WAIT_L(0); PG8_MMA(0, 1, At, B1); PG8_BAR;
            PG8_LDA(At, 0, 1); PG8_STAGE_A(PG8_SA(0, 0), a2, 0, last);
            PG8_BAR; PG8_WAIT_L(0); PG8_MMA(1, 0, At, B0); PG8_BAR; PG8_SCHED;
            PG8_STAGE_B(PG8_SB(0, 1), b2 + hstep);
            PG8_WAIT_V(6); PG8_BAR; PG8_MMA(1, 1, At, B1); PG8_BAR;
            PG8_LDB(B0, 1, 0); PG8_SCHED; PG8_LDA(At, 1, 0); PG8_STAGE_A(PG8_SA(0, 1), a2, 1, last);
            PG8_WAIT_L(8); PG8_BAR; PG8_WAIT_L(0); PG8_MMA(0, 0, At, B0); PG8_BAR; PG8_SCHED;
            PG8_LDB(B1, 1, 1); PG8_STAGE_B(PG8_SB(1, 0), b3);
            PG8_BAR; PG8_WAIT_L(0); PG8_MMA(0, 1, At, B1); PG8_BAR;
            PG8_LDA(At, 1, 1); PG8_STAGE_A(PG8_SA(1, 0), a3, 0, last);
            PG8_BAR; PG8_WAIT_L(0); PG8_MMA(1, 0, At, B0); PG8_BAR; PG8_SCHED;
            PG8_STAGE_B(PG8_SB(1, 1), b3 + hstep);
            PG8_WAIT_V(6); PG8_BAR; PG8_MMA(1, 1, At, B1); PG8_BAR;
            }
        }
        if (wr == 0) PG8_BAR;
        E(acc, cur, S, wr, wc, fr, fq);
        if (!has_next) break;
#pragma unroll
        for (int a = 0; a < 2; ++a)
#pragma unroll
            for (int b = 0; b < 2; ++b)
#pragma unroll
                for (int m = 0; m < 4; ++m)
#pragma unroll
                    for (int n = 0; n < 2; ++n) acc[a][b][m][n] = (f32x4){0.f, 0.f, 0.f, 0.f};
        cur = nxt; cA = nA; cB = nB; ++ui;
        if (wr == 1) PG8_BAR;
        if constexpr (Sched::GATHER) {
#pragma unroll
            for (int h = 0; h < 2; ++h)
#pragma unroll
                for (int i = 0; i < 2; ++i) gc[h][i] = gn[h][i];
        }
    }
    PG8_WAIT_V(0);
    PG8_BAR;
#undef PG8_SA
#undef PG8_SB
#undef PG8_GLDS
#undef PG8_STAGE_A
#undef PG8_STAGE_B
#undef PG8_LDA
#undef PG8_LDB
#undef PG8_MMA
#undef PG8_WAIT_V
#undef PG8_WAIT_L
#undef PG8_BAR
#undef PG8_SCHED
}


struct EpiZ {
    static constexpr bool PERM = true;
    static constexpr bool SP2 = ((PG8_SP2_MASK) >> 0) & 1;
    bf16_t* Z; const float* part; int npart;
    template <class S_> __device__ __forceinline__ void operator()(const f32x4 (&acc)[2][2][4][2], const Unit& u, const S_&, int wr, int wc, int fr, int fq) const {
        const int row0 = u.orow + wr * 64 + fr, col0 = u.ocol + wc * 32 + 8 * fq;
        float rs8[8];
#pragma unroll
        for (int r = 0; r < 8; ++r) { const int row = row0 + (r >> 2) * HALF + (r & 3) * 16;
            const f32x4* pp4 = (const f32x4*)(part + (size_t)row * NPART); const f32x4 p0 = pp4[0], p1 = pp4[1], p2 = pp4[2], p3 = pp4[3];
            const float ss = ((p0[0] + p0[1]) + (p0[2] + p0[3])) + ((p1[0] + p1[1]) + (p1[2] + p1[3])) + ((p2[0] + p2[1]) + (p2[2] + p2[3])) + ((p3[0] + p3[1]) + (p3[2] + p3[3]));
            rs8[r] = rsqrtf(ss * (1.0f / D) + 1e-6f); }
        if (u.ocol < 2 * CONVC) {
            const int ch0 = (u.ocol >> 8) * 128 + wc * 32 + 8 * fq;
#pragma unroll
            for (int ai = 0; ai < 2; ++ai)
#pragma unroll
                for (int m = 0; m < 4; ++m) {
                    const int row = row0 + ai * HALF + m * 16; const float rs = rs8[ai * 4 + m];
                    const f32x4 v0 = acc[ai][0][m][0] * rs, v1 = acc[ai][0][m][1] * rs, g0 = acc[ai][1][m][0] * rs, g1 = acc[ai][1][m][1] * rs;
                    float o[8];
#pragma unroll
                    for (int j = 0; j < 4; ++j) { o[j] = v0[j] * sigmoidf_(g0[j]); o[4 + j] = v1[j] * sigmoidf_(g1[j]); }
                    u32x4 w; w.x = cvt_pk_bf16(o[0], o[1]); w.y = cvt_pk_bf16(o[2], o[3]); w.z = cvt_pk_bf16(o[4], o[5]); w.w = cvt_pk_bf16(o[6], o[7]);
                    *(u32x4*)(Z + (size_t)row * ZC + ch0) = w; }
            return;
        }
#pragma unroll
        for (int ai = 0; ai < 2; ++ai)
#pragma unroll
            for (int m = 0; m < 4; ++m) {
                const int row = row0 + ai * HALF + m * 16; const float rs = rs8[ai * 4 + m];
                bf16_t* rowp = Z + (size_t)row * ZC + col0;
#pragma unroll
                for (int bj = 0; bj < 2; ++bj) { const f32x4 v0 = acc[ai][bj][m][0] * rs, v1 = acc[ai][bj][m][1] * rs;
                    u32x4 w; w.x = cvt_pk_bf16(v0[0], v0[1]); w.y = cvt_pk_bf16(v0[2], v0[3]); w.z = cvt_pk_bf16(v1[0], v1[1]); w.w = cvt_pk_bf16(v1[2], v1[3]);
                    *(u32x4*)(rowp + bj * HALF) = w; } }
    }
};
struct EpiRes {
    static constexpr bool PERM = true;
    static constexpr bool SP2 = ((PG8_SP2_MASK) >> 1) & 1;
    const float* hin32; const bf16_t* hin16; bf16_t* hb;
    template <class S_> __device__ __forceinline__ void operator()(const f32x4 (&acc)[2][2][4][2], const Unit& u, const S_&, int wr, int wc, int fr, int fq) const {
        const int row0 = u.orow + wr * 64 + fr, col0 = u.ocol + wc * 32 + 8 * fq;
        if (hin32) {
#pragma unroll
            for (int ai = 0; ai < 2; ++ai) {
                f32x4 r[4][2][2];
#pragma unroll
                for (int m = 0; m < 4; ++m)
#pragma unroll
                    for (int bj = 0; bj < 2; ++bj) { const size_t off = (size_t)(row0 + ai * HALF + m * 16) * D + col0 + bj * HALF; r[m][bj][0] = *(const f32x4*)(hin32 + off); r[m][bj][1] = *(const f32x4*)(hin32 + off + 4); }
#pragma unroll
                for (int m = 0; m < 4; ++m)
#pragma unroll
                    for (int bj = 0; bj < 2; ++bj) { const size_t off = (size_t)(row0 + ai * HALF + m * 16) * D + col0 + bj * HALF;
                        const f32x4 v0 = acc[ai][bj][m][0] + r[m][bj][0], v1 = acc[ai][bj][m][1] + r[m][bj][1];
                        u32x4 w; w.x = cvt_pk_bf16(v0[0], v0[1]); w.y = cvt_pk_bf16(v0[2], v0[3]); w.z = cvt_pk_bf16(v1[0], v1[1]); w.w = cvt_pk_bf16(v1[2], v1[3]);
                        *(u32x4*)(hb + off) = w; }
            }
        } else {
            u32x4 pw[2][4][2];
#pragma unroll
            for (int ai = 0; ai < 2; ++ai)
#pragma unroll
                for (int m = 0; m < 4; ++m)
#pragma unroll
                    for (int bj = 0; bj < 2; ++bj) pw[ai][m][bj] = *(const u32x4*)(hin16 + (size_t)(row0 + ai * HALF + m * 16) * D + col0 + bj * HALF);
#pragma unroll
            for (int ai = 0; ai < 2; ++ai)
#pragma unroll
                for (int m = 0; m < 4; ++m)
#pragma unroll
                    for (int bj = 0; bj < 2; ++bj) { const u32x4 p = pw[ai][m][bj];
                        const f32x4 r0 = (f32x4){__uint_as_float(p.x << 16), __uint_as_float(p.x & 0xffff0000u), __uint_as_float(p.y << 16), __uint_as_float(p.y & 0xffff0000u)};
                        const f32x4 r1 = (f32x4){__uint_as_float(p.z << 16), __uint_as_float(p.z & 0xffff0000u), __uint_as_float(p.w << 16), __uint_as_float(p.w & 0xffff0000u)};
                        const f32x4 v0 = acc[ai][bj][m][0] + r0, v1 = acc[ai][bj][m][1] + r1;
                        u32x4 w; w.x = cvt_pk_bf16(v0[0], v0[1]); w.y = cvt_pk_bf16(v0[2], v0[3]); w.z = cvt_pk_bf16(v1[0], v1[1]); w.w = cvt_pk_bf16(v1[2], v1[3]);
                        *(u32x4*)(hb + (size_t)(row0 + ai * HALF + m * 16) * D + col0 + bj * HALF) = w; }
        }
    }
};
struct EpiGU {
    static constexpr bool PERM = true;
    static constexpr bool SP2 = ((PG8_SP2_MASK) >> 2) & 1;
    bf16_t* hid; const float* rlist;
    template <class S_> __device__ __forceinline__ void operator()(const f32x4 (&acc)[2][2][4][2], const Unit& u, const S_& S, int wr, int wc, int fr, int fq) const {
        const int rl0 = wr * 64 + fr, col0 = (u.ocol >> 1) + wc * 32 + 8 * fq;
        float rs8[8];
#pragma unroll
        for (int r = 0; r < 8; ++r) rs8[r] = rlist[u.e * LCAP + u.mt * BM + rl0 + (r >> 2) * HALF + (r & 3) * 16];
#pragma unroll
        for (int ai = 0; ai < 2; ++ai)
#pragma unroll
            for (int m = 0; m < 4; ++m) {
                const int rl = rl0 + ai * HALF + m * 16;
                const float rs = rs8[ai * 4 + m];
                const f32x4 g0 = acc[ai][0][m][0] * rs, g1 = acc[ai][0][m][1] * rs, u0 = acc[ai][1][m][0] * rs, u1 = acc[ai][1][m][1] * rs;
                float o[8];
#pragma unroll
                for (int j = 0; j < 4; ++j) { o[j] = g0[j] * sigmoidf_(g0[j]) * u0[j]; o[4 + j] = g1[j] * sigmoidf_(g1[j]) * u1[j]; }
                u32x4 w; w.x = cvt_pk_bf16(o[0], o[1]); w.y = cvt_pk_bf16(o[2], o[3]); w.z = cvt_pk_bf16(o[4], o[5]); w.w = cvt_pk_bf16(o[6], o[7]);
                *(u32x4*)(hid + (size_t)(u.orow + rl) * FF + col0) = w; }
    }
};
struct EpiDown {
    static constexpr bool PERM = true;
    static constexpr bool SP2 = ((PG8_SP2_MASK) >> 3) & 1;
    bf16_t* ys; const float* glist; const int* cnt;
    template <class S_> __device__ __forceinline__ void operator()(const f32x4 (&acc)[2][2][4][2], const Unit& u, const S_&, int wr, int wc, int fr, int fq) const {
        const int rl0 = wr * 64 + fr, col0 = u.ocol + wc * 32 + 8 * fq; const int ce = cnt[u.e];
        float g8[8];
#pragma unroll
        for (int r = 0; r < 8; ++r) { const int pos = u.mt * BM + rl0 + (r >> 2) * HALF + (r & 3) * 16; g8[r] = glist[u.e * LCAP + pos]; if (pos >= ce) g8[r] = 0.f; }
#pragma unroll
        for (int ai = 0; ai < 2; ++ai)
#pragma unroll
            for (int m = 0; m < 4; ++m) {
                const int rl = rl0 + ai * HALF + m * 16;
                const float g = g8[ai * 4 + m];
                bf16_t* rowp = ys + (size_t)(u.orow + rl) * D + col0;
#pragma unroll
                for (int bj = 0; bj < 2; ++bj) { const f32x4 v0 = acc[ai][bj][m][0] * g, v1 = acc[ai][bj][m][1] * g;
                    u32x4 w; w.x = cvt_pk_bf16(v0[0], v0[1]); w.y = cvt_pk_bf16(v0[2], v0[3]); w.z = cvt_pk_bf16(v1[0], v1[1]); w.w = cvt_pk_bf16(v1[2], v1[3]);
                    *(u32x4*)(rowp + bj * HALF) = w; } }
    }
};
struct EpiPP {
    static constexpr bool PERM = true;
    static constexpr bool SP2 = ((PG8_SP2_MASK) >> 4) & 1;
    bf16_t* O;
    template <class S_> __device__ __forceinline__ void operator()(const f32x4 (&acc)[2][2][4][2], const Unit& u, const S_&, int wr, int wc, int fr, int fq) const {
        const int row0 = u.orow + wr * 64 + fr, col0 = u.ocol + wc * 32 + 8 * fq;
#pragma unroll
        for (int ai = 0; ai < 2; ++ai)
#pragma unroll
            for (int m = 0; m < 4; ++m) { bf16_t* rowp = O + (size_t)(row0 + ai * HALF + m * 16) * D + col0;
#pragma unroll
                for (int bj = 0; bj < 2; ++bj) { const f32x4 v0 = acc[ai][bj][m][0], v1 = acc[ai][bj][m][1];
                    u32x4 w; w.x = cvt_pk_bf16(v0[0], v0[1]); w.y = cvt_pk_bf16(v0[2], v0[3]); w.z = cvt_pk_bf16(v1[0], v1[1]); w.w = cvt_pk_bf16(v1[2], v1[3]);
                    *(u32x4*)(rowp + bj * HALF) = w; } }
    }
};
struct EpiPle {
    static constexpr bool PERM = true;
    static constexpr bool SP2 = ((PG8_SP2_MASK) >> 5) & 1;
    const bf16_t* hb; bf16_t* dst; const bf16_t* pp; const float* rsp; float* part;
    template <class S_> __device__ __forceinline__ void operator()(const f32x4 (&acc)[2][2][4][2], const Unit& u, const S_&, int wr, int wc, int fr, int fq) const {
        const int row0 = u.orow + wr * 64 + fr, col0 = u.ocol + wc * 32 + 8 * fq;
        float* pout = part + ((u.ocol >> 8) * 4 + wc);
        float rs8[8];
#pragma unroll
        for (int r = 0; r < 8; ++r) rs8[r] = rsp[row0 + (r >> 2) * HALF + (r & 3) * 16];
#pragma unroll
        for (int ai = 0; ai < 2; ++ai) {
            u32x4 hw[4][2], pw[4][2];
#pragma unroll
            for (int m = 0; m < 4; ++m)
#pragma unroll
                for (int bj = 0; bj < 2; ++bj) { const size_t off = (size_t)(row0 + ai * HALF + m * 16) * D + col0 + bj * HALF; hw[m][bj] = *(const u32x4*)(hb + off); pw[m][bj] = *(const u32x4*)(pp + off); }
#pragma unroll
            for (int m = 0; m < 4; ++m) {
                const int row = row0 + ai * HALF + m * 16; const float rs = rs8[ai * 4 + m]; float ss = 0.f;
#pragma unroll
                for (int bj = 0; bj < 2; ++bj) {
                    float hv[8], pv[8], o[8];
#pragma unroll
                    for (int j = 0; j < 4; ++j) { hv[2 * j] = __uint_as_float(hw[m][bj][j] << 16); hv[2 * j + 1] = __uint_as_float(hw[m][bj][j] & 0xffff0000u); pv[2 * j] = __uint_as_float(pw[m][bj][j] << 16); pv[2 * j + 1] = __uint_as_float(pw[m][bj][j] & 0xffff0000u); }
#pragma unroll
                    for (int j = 0; j < 4; ++j) { o[j] = hv[j] + sigmoidf_(acc[ai][bj][m][0][j] * rs) * pv[j]; o[4 + j] = hv[4 + j] + sigmoidf_(acc[ai][bj][m][1][j] * rs) * pv[4 + j]; }
                    u32x4 w; w.x = cvt_pk_bf16(o[0], o[1]); w.y = cvt_pk_bf16(o[2], o[3]); w.z = cvt_pk_bf16(o[4], o[5]); w.w = cvt_pk_bf16(o[6], o[7]);
#pragma unroll
                    for (int j = 0; j < 4; ++j) { const float a0 = __uint_as_float(w[j] << 16), a1 = __uint_as_float(w[j] & 0xffff0000u); ss += a0 * a0 + a1 * a1; }
                    *(u32x4*)(dst + (size_t)row * D + col0 + bj * HALF) = w; }
                ss += __shfl_xor(ss, 16); ss += __shfl_xor(ss, 32);
                if (fq == 0) pout[(size_t)row * NPART] = ss; }
        }
    }
};
}

struct Params {
    const float* in[35];
    float* out;
    unsigned char* ws;
    int ph_lo, ph_hi;
};
enum { I_X = 0, I_P, I_MIXN, I_WIN, I_CONVW, I_CONVB, I_CLNG, I_CLNB, I_MU, I_W0, I_W2, I_A0, I_A2, I_G2, I_KK, I_KA, I_RK, I_GNG, I_GNB, I_V0, I_V1, I_V2,
       I_WOUT, I_FFNN, I_RGW, I_RGB, I_REW, I_REB, I_EWG, I_EWU, I_EWD, I_PLEN, I_PLEG, I_PLEP, I_FINN };

typedef const Params __attribute__((address_space(4)))* KP;
struct Ctx {
    LAS unsigned char* lds;
    int tid, lane, wave, vcu, G, bid;
};

__device__ __forceinline__ Ctx fresh(const Ctx& C0) { Ctx C = C0; int t = threadIdx.x; asm volatile("" : "+v"(t)); C.tid = t; C.lane = t & 63; C.wave = __builtin_amdgcn_readfirstlane(t >> 6);
    int bx = blockIdx.x; asm volatile("" : "+s"(bx)); C.bid = bx; C.vcu = (C.G % 8 == 0) ? (bx % 8) * (C.G / 8) + bx / 8 : bx; return C; }

struct TrItem { const float* src; const float* gain; bf16_t* dst; int ldw, ldt, k0, n0, drow; };
__device__ __forceinline__ void tr_load(const TrItem& t, int lane, float (&v)[32]) {
    const float* src = t.src + (size_t)(t.k0 + (lane >> 5)) * t.ldw + t.n0 + (lane & 31);
#pragma unroll
    for (int i = 0; i < 32; ++i) v[i] = src[(size_t)(2 * i) * t.ldw];
}
__device__ __forceinline__ void tr_store(const TrItem& t, const float (&v)[32], LAS float* scr, int lane) {
    const int c = lane & 7;
    f32x4 g0 = (f32x4){1.f, 1.f, 1.f, 1.f}, g1 = g0;
    if (t.gain) { g0 = *(const f32x4*)(t.gain + t.k0 + 8 * c); g1 = *(const f32x4*)(t.gain + t.k0 + 8 * c + 4); }
#pragma unroll
    for (int i = 0; i < 32; ++i) scr[(2 * i + (lane >> 5)) * 33 + (lane & 31)] = v[i];
    asm volatile("s_waitcnt lgkmcnt(0)" ::: "memory");
#pragma unroll
    for (int j = 0; j < 4; ++j) { const int n = (lane >> 3) + 8 * j; const LAS float* s = scr + (8 * c) * 33 + n;
        u32x4 o; o.x = pk2(s[0 * 33] * g0[0], s[1 * 33] * g0[1]); o.y = pk2(s[2 * 33] * g0[2], s[3 * 33] * g0[3]); o.z = pk2(s[4 * 33] * g1[0], s[5 * 33] * g1[1]); o.w = pk2(s[6 * 33] * g1[2], s[7 * 33] * g1[3]);
        *(u32x4*)(t.dst + (size_t)(t.drow + n) * t.ldt + t.k0 + 8 * c) = o; }
    asm volatile("s_waitcnt lgkmcnt(0)" ::: "memory");
}

__device__ __forceinline__ void phase_prep(KP P, const Ctx& C0, unsigned char* wsb, const int part) {
    const Ctx C = fresh(C0);
    LAS float* scr = (LAS float*)(C.lds + C.wave * 16384);
    const int gw = C.vcu * 8 + C.wave, NGW = C.G * 8;
    const int lane = C.lane;
    constexpr int IT_IN = 16 * 85, IT_OUT = 16 * 32, IT_GU = 2 * NE * 16 * 16, IT_D = NE * 8 * 32, IT_PG = 16 * 32, IT_PP = 4 * 32;
    constexpr int IT_LAYER = IT_IN + IT_OUT + IT_GU + IT_D + IT_PG + IT_PP, IT_L = IT_LAYER - IT_GU - IT_D, IT_TOTAL = DEPTH * IT_L;
    if (part == 0) {
        auto decode = [&](int it) -> TrItem {
            TrItem t; t.gain = nullptr;
            const int l = it / IT_L; int r = it % IT_L; if (r >= IT_IN + IT_OUT) r += IT_GU + IT_D;
            unsigned char* wl = wsb + WS_W + (size_t)l * W_LAYER;
            if (r < IT_IN) { const int kb = r / 85, nb = r % 85;
                t.src = P->in[I_WIN] + (size_t)l * D * IN_COLS; t.ldw = IN_COLS; t.k0 = kb * 64; t.n0 = nb * 32; t.gain = P->in[I_MIXN] + l * D; t.dst = (bf16_t*)(wl + WO_IN); t.ldt = D;
                t.drow = (t.n0 < 2 * CONVC) ? (((t.n0 & (CONVC - 1)) >> 7) * 256 + (t.n0 >= CONVC ? 128 : 0) + (t.n0 & 127)) : t.n0;
            } else if (r < IT_IN + IT_OUT) { r -= IT_IN; const int kb = r / 32, nb = r % 32;
                t.src = P->in[I_WOUT] + (size_t)l * D * D; t.ldw = D; t.k0 = kb * 64; t.n0 = nb * 32; t.dst = (bf16_t*)(wl + WO_OUT); t.ldt = D; t.drow = t.n0;
            } else if (r < IT_IN + IT_OUT + IT_GU) { r -= IT_IN + IT_OUT; const int half = r / (NE * 256), r2 = r % (NE * 256), e = r2 / 256, kb = (r2 % 256) / 16, nb = r2 % 16;
                t.src = (half ? P->in[I_EWU] : P->in[I_EWG]) + ((size_t)l * NE + e) * D * FF; t.ldw = FF; t.k0 = kb * 64; t.n0 = nb * 32; t.gain = P->in[I_FFNN] + l * D; t.dst = (bf16_t*)(wl + WO_GU); t.ldt = D;
                t.drow = e * 1024 + (t.n0 >> 7) * 256 + half * 128 + (t.n0 & 127);
            } else if (r < IT_IN + IT_OUT + IT_GU + IT_D) { r -= IT_IN + IT_OUT + IT_GU; const int e = r / 256, kb = (r % 256) / 32, nb = r % 32;
                t.src = P->in[I_EWD] + ((size_t)l * NE + e) * FF * D; t.ldw = D; t.k0 = kb * 64; t.n0 = nb * 32; t.dst = (bf16_t*)(wl + WO_D); t.ldt = FF; t.drow = e * 1024 + t.n0;
            } else if (r < IT_IN + IT_OUT + IT_GU + IT_D + IT_PG) { r -= IT_IN + IT_OUT + IT_GU + IT_D; const int kb = r / 32, nb = r % 32;
                t.src = P->in[I_PLEG] + (size_t)l * D * D; t.ldw = D; t.k0 = kb * 64; t.n0 = nb * 32; t.gain = P->in[I_PLEN] + l * D; t.dst = (bf16_t*)(wl + WO_PG); t.ldt = D; t.drow = t.n0;
            } else { r -= IT_IN + IT_OUT + IT_GU + IT_D + IT_PG; const int kb = r / 32, nb = r % 32;
                t.src = P->in[I_PLEP] + (size_t)l * PLE * D; t.ldw = D; t.k0 = kb * 64; t.n0 = nb * 32; t.dst = (bf16_t*)(wl + WO_PP); t.ldt = PLE; t.drow = t.n0; }
            return t; };
        int it = gw;
        if (it < IT_TOTAL) {
            TrItem cur = decode(it); float v[32]; tr_load(cur, lane, v);
            for (;;) {
                const int nx = it + NGW; const bool has = nx < IT_TOTAL;
                TrItem nxt = cur; float vn[32];
                if (has) { nxt = decode(nx); tr_load(nxt, lane, vn); }
                tr_store(cur, v, scr, lane);
                if (!has) break;
                cur = nxt; it = nx;
#pragma unroll
                for (int i = 0; i < 32; ++i) v[i] = vn[i];
            }
        }
    }
    if (part == 1) {
        const int gt = gw * 64 + lane, NGT = NGW * 64;
        bf16_t* w0 = (bf16_t*)(wsb + WS_W + WO_IN); bf16_t* w1 = (bf16_t*)(wsb + WS_W + W_LAYER + WO_IN);
        for (int i = gt; i < 96 * D / 8; i += NGT) *(u32x4*)(w0 + (size_t)IN_COLS * D + (size_t)i * 8) = (u32x4){0u, 0u, 0u, 0u};
        for (int i = gt; i < 32 * D / 8; i += NGT) *(u32x4*)(w1 + (size_t)(ZC_EB + 32) * D + (size_t)i * 8) = (u32x4){0u, 0u, 0u, 0u};
        const float* win1 = P->in[I_WIN] + (size_t)D * IN_COLS; const float* mu1 = P->in[I_MU] + RWKV_IN + 2 * RC; const float* v1 = P->in[I_V1]; const float* g1 = P->in[I_MIXN] + D;
        static_assert(D == 256 * 4, "fold row distribution");
        if (C.wave < 4) { const int k = C.vcu * 4 + C.wave;
            const float* wr_ = win1 + (size_t)k * IN_COLS + ZC_V; float s = 0.f; const int j = lane & 31; const bool hi = lane >= 32;
            float s2 = 0.f, s3 = 0.f, s4 = 0.f;
#pragma unroll 8
            for (int c = 0; c < RC; c += 4) { const f32x4 m4 = *(const f32x4*)(mu1 + c), w4 = *(const f32x4*)(wr_ + c);
                s += w4[0] * (hi ? m4[0] : 1.0f - m4[0]) * v1[(c + 0) * LV + j]; s2 += w4[1] * (hi ? m4[1] : 1.0f - m4[1]) * v1[(c + 1) * LV + j];
                s3 += w4[2] * (hi ? m4[2] : 1.0f - m4[2]) * v1[(c + 2) * LV + j]; s4 += w4[3] * (hi ? m4[3] : 1.0f - m4[3]) * v1[(c + 3) * LV + j]; }
            s = (s + s2) + (s3 + s4);
            w1[(size_t)(ZC_EA + lane) * D + k] = (bf16_t)f2bf(s * g1[k]);
        }
        bf16_t* wrt = (bf16_t*)(wsb + WS_WR);
        for (int i = gt; i < DEPTH * 48 * D; i += NGT) { const int l = i / (48 * D), j = (i / D) % 48, k = i % D; float v = 0.f;
            if (j < NG) v = P->in[I_RGW][((size_t)l * D + k) * NG + j]; else if (j < NRT) { const int g = (j - NG) / EPG, e = (j - NG) % EPG; v = P->in[I_REW][(((size_t)l * NG + g) * D + k) * EPG + e]; }
            v *= P->in[I_FFNN][l * D + k];
            const unsigned hi = f2bf(v); const float lo = v - __uint_as_float(hi << 16);
            wrt[((size_t)(l * 2 + 0) * 48 + j) * D + k] = (bf16_t)hi; wrt[((size_t)(l * 2 + 1) * 48 + j) * D + k] = (bf16_t)f2bf(lo); }
    }
    if (part == 2) {
        bf16_t* hb = (bf16_t*)(wsb + WS_HB); float* part = (float*)(wsb + WS_PART);
        for (int m0 = gw; m0 < M; m0 += 4 * NGW) {
            f32x4 xv[4][4];
#pragma unroll
            for (int q = 0; q < 4; ++q) { const f32x4* xr = (const f32x4*)(P->in[I_X] + (size_t)(m0 + q * NGW) * D) + lane;
#pragma unroll
                for (int j = 0; j < 4; ++j) xv[q][j] = xr[64 * j]; }
#pragma unroll
            for (int q = 0; q < 4; ++q) { const int m = m0 + q * NGW; u32x2* o = (u32x2*)(hb + (size_t)m * D) + lane; float sq = 0.f;
#pragma unroll
                for (int j = 0; j < 4; ++j) { const f32x4 v = xv[q][j]; sq += (v[0] * v[0] + v[1] * v[1]) + (v[2] * v[2] + v[3] * v[3]); u32x2 w; w.x = pk2(v[0], v[1]); w.y = pk2(v[2], v[3]); o[64 * j] = w; }
                sq = sum16(sq); sq += __shfl_xor(sq, 16); sq += __shfl_xor(sq, 32);
                if (lane < NPART) part[(size_t)m * NPART + lane] = lane == 0 ? sq : 0.f; }
        }
    }
}

__device__ __forceinline__ float xsum16(float x) { float a = x, b = x; asm volatile("s_nop 1\n\tv_permlane16_swap_b32 %0, %1" : "+v"(a), "+v"(b)); return a + b; }
__device__ __forceinline__ float xsum32(float x) { float a = x, b = x; asm volatile("s_nop 1\n\tv_permlane32_swap_b32 %0, %1" : "+v"(a), "+v"(b)); return a + b; }

constexpr int CH = 32;
constexpr int AB_K = 0, AB_W = 8192, AB_R = 16384, AB_A = 24576, AB_V = 32768, AB_Y = 40960, AB_G = 49152, AB_BON = 57344, AB_SET = 57472;
constexpr int XROW = 144;
constexpr int PS_X = 2 * AB_SET;
constexpr int XS_A = 0, XS_B = 4608, XS_K = 9216, XS_R = 13824, XS_V = 18432;
constexpr int PS_GAM = PS_X + 23040;
constexpr int PS_CON = PS_GAM + 256;
constexpr int PS_FLAG = PS_CON + 2688;
constexpr int PS_END = PS_FLAG + 64;
static_assert(PS_END <= LDS_BYTES - 64, "RWKV LDS map");
constexpr int LDS_SPIN_CAP = 1 << 20;
__device__ __forceinline__ void lds_wait_ge(LAS int* cnt, int target) {
    int sp = 0; while (__hip_atomic_load(cnt, __ATOMIC_RELAXED, __HIP_MEMORY_SCOPE_WORKGROUP) < target) { __builtin_amdgcn_s_sleep(1); if (++sp > LDS_SPIN_CAP) break; }
    __builtin_amdgcn_fence(__ATOMIC_ACQUIRE, "workgroup");
}
__device__ __forceinline__ void lds_signal(LAS int* cnt, int lane) {
    __builtin_amdgcn_fence(__ATOMIC_RELEASE, "workgroup"); asm volatile("s_waitcnt lgkmcnt(0)" ::: "memory");
    if (lane == 0) __hip_atomic_fetch_add(cnt, 1, __ATOMIC_RELAXED, __HIP_MEMORY_SCOPE_WORKGROUP);
}

#ifdef TIMING
#define TP_DECL() unsigned tacc[10] = {0u, 0u, 0u, 0u, 0u, 0u, 0u, 0u, 0u, 0u}; unsigned tlast = (unsigned)__builtin_amdgcn_s_memrealtime()
#define TP_ACC(i) do { const unsigned n_ = (unsigned)__builtin_amdgcn_s_memrealtime(); tacc[i] += n_ - tlast; tlast = n_; } while (0)
#define TP_OUT(i) do { ((unsigned*)(wsb + WS_CTL))[1024 + 40 + 2 * (i)] = 0u; ((unsigned*)(wsb + WS_CTL))[1024 + 41 + 2 * (i)] = tacc[i]; } while (0)
#else
#define TP_DECL() do {} while (0)
#define TP_ACC(i) do {} while (0)
#define TP_OUT(i) do {} while (0)
#endif
__device__ __forceinline__ void phase_mix(KP P, const Ctx& C0, unsigned char* wsb, int l, const int part) {
    const Ctx C = fresh(C0);
    const bf16_t* Z = (const bf16_t*)(wsb + WS_Z); bf16_t* Y = (bf16_t*)(wsb + WS_Y); bf16_t* VF = (bf16_t*)(wsb + WS_VF);
    const int tid = C.tid, lane = C.lane, wave = C.wave;
    if (part == 0) {
    {
        constexpr int CT = 32, UT = CT + 30;
        LAS bf16_t* ut = (LAS bf16_t*)C.lds;
        LAS float* co = (LAS float*)(C.lds + 65536);
        const int cp = tid & 255, th = tid >> 8;
        f32x2 cw[CONVW];
#pragma unroll
        for (int j = 0; j < CONVW; ++j) cw[j] = *(const f32x2*)(P->in[I_CONVW] + ((size_t)l * CONVW + j) * CONVC + 2 * cp);
        const f32x2 cb = *(const f32x2*)(P->in[I_CONVB] + l * CONVC + 2 * cp);
        const f32x4 lg0 = *(const f32x4*)(P->in[I_CLNG] + l * CONVC + lane * 8), lg1 = *(const f32x4*)(P->in[I_CLNG] + l * CONVC + lane * 8 + 4);
        const f32x4 lb0 = *(const f32x4*)(P->in[I_CLNB] + l * CONVC + lane * 8), lb1 = *(const f32x4*)(P->in[I_CLNB] + l * CONVC + lane * 8 + 4);
        u32x4 gv_[8], q_lc, q_lp; unsigned q_l2c, q_l2p, q_ea, q_eb;
        const int cgL = tid & 15, tokL = tid >> 4;
        const float* muL = P->in[I_MU] + (size_t)l * RWKV_IN + 3 * RC;
        const f32x4 ml0 = *(const f32x4*)(muL + cgL * 8), ml1 = *(const f32x4*)(muL + cgL * 8 + 4); const f32x2 ml2 = *(const f32x2*)(muL + 128 + cgL * 2);
        bf16_t* LR = (bf16_t*)(wsb + WS_LR);
#define CONV_LOAD(item_) do { const int b_ = (item_) >> 6, t0_ = ((item_) & 63) * CT; _Pragma("unroll") for (int i = 0; i < 8; ++i) { const int p = tid + 512 * i; const int row = p >> 6, g8 = p & 63; const int t = t0_ - 30 + row; \
            gv_[i] = (u32x4){0u, 0u, 0u, 0u}; if (p < UT * 64 && t >= 0) gv_[i] = *(const u32x4*)(Z + (size_t)(b_ * SEQ + t) * ZC + g8 * 8); } \
            { const int tq_ = t0_ + tokL; const bf16_t* rc_ = Z + (size_t)(b_ * SEQ + tq_) * ZC; const bf16_t* rp_ = rc_ - ZC; const bool hp_ = tq_ > 0; \
              q_lc = *(const u32x4*)(rc_ + ZC_WLO + cgL * 8); q_l2c = *(const unsigned*)(rc_ + ZC_WLO + 128 + cgL * 2); q_ea = *(const unsigned*)(rc_ + ZC_EA + cgL * 2); \
              q_lp = hp_ ? *(const u32x4*)(rp_ + ZC_WLO + cgL * 8) : (u32x4){0u, 0u, 0u, 0u}; q_l2p = hp_ ? *(const unsigned*)(rp_ + ZC_WLO + 128 + cgL * 2) : 0u; q_eb = hp_ ? *(const unsigned*)(rp_ + ZC_EB + cgL * 2) : 0u; } } while (0)
#ifndef MIXSKIP_CONV
        if (C.bid < M / CT) CONV_LOAD(C.bid);
        for (int item = C.bid; item < M / CT; item += C.G) {
#else
        for (int item = C.bid; item < 0; item += C.G) {
#endif
            const int b = item >> 6, t0 = (item & 63) * CT;
#pragma unroll
            for (int i = 0; i < 8; ++i) { const int p = tid + 512 * i; const int row = p >> 6, g8 = p & 63;
                if (p < UT * 64) *(LAS u32x4*)(ut + row * CONVC + g8 * 8) = gv_[i]; }
            {
#define LERP2(dst, wc_, wp_, m0, m1) do { const float c0_ = __uint_as_float((wc_) << 16), c1_ = __uint_as_float((wc_) & 0xffff0000u), p0_ = __uint_as_float((wp_) << 16), p1_ = __uint_as_float((wp_) & 0xffff0000u); \
                    (dst)[0] = c0_ + (p0_ - c0_) * (m0); (dst)[1] = c1_ + (p1_ - c1_) * (m1); } while (0)
                float zl[8], t2[2];
                LERP2(zl + 0, q_lc.x, q_lp.x, ml0[0], ml0[1]); LERP2(zl + 2, q_lc.y, q_lp.y, ml0[2], ml0[3]); LERP2(zl + 4, q_lc.z, q_lp.z, ml1[0], ml1[1]); LERP2(zl + 6, q_lc.w, q_lp.w, ml1[2], ml1[3]);
                const float am_ = (cgL < 4) ? 2.885390082f : -1.442695041f, as_ = (cgL < 4) ? -2.0f : 1.0f, ao_ = (cgL < 4) ? 1.0f : 0.0f; const bool aid_ = (cgL >= 4) && (cgL < 8);
#pragma unroll
                for (int j = 0; j < 8; ++j) { const float y_ = as_ * __builtin_amdgcn_rcpf(1.0f + __builtin_amdgcn_exp2f(zl[j] * am_)) + ao_; zl[j] = aid_ ? zl[j] : y_; }
                u32x4 pk; pk.x = pk2(zl[0], zl[1]); pk.y = pk2(zl[2], zl[3]); pk.z = pk2(zl[4], zl[5]); pk.w = pk2(zl[6], zl[7]);
                bf16_t* lrow = LR + (size_t)(b * SEQ + t0 + tokL) * LRC;
                *(u32x4*)(lrow + cgL * 8) = pk;
                LERP2(t2, q_l2c, q_l2p, ml2[0], ml2[1]);
                *(unsigned*)(lrow + 128 + cgL * 2) = pk2(sigmoidf_(t2[0]), sigmoidf_(t2[1]));
                *(unsigned*)(lrow + 160 + cgL * 2) = pk2(__uint_as_float(q_ea << 16) + __uint_as_float(q_eb << 16), __uint_as_float(q_ea & 0xffff0000u) + __uint_as_float(q_eb & 0xffff0000u));
#undef LERP2
            }
            __syncthreads();
            if (item + C.G < M / CT) CONV_LOAD(item + C.G);
#pragma unroll 1
            for (int blk = 0; blk < 2; ++blk) { const int tb = th * 16 + blk * 8;
                f32x2 u2[38];
#pragma unroll
                for (int i = 0; i < 38; ++i) { const unsigned w = *(const LAS unsigned*)(ut + (tb + i) * CONVC + 2 * cp); u2[i] = (f32x2){__uint_as_float(w << 16), __uint_as_float(w & 0xffff0000u)}; }
#pragma unroll
                for (int tt = 0; tt < 8; ++tt) { f32x2 a = cb;
#pragma unroll
                    for (int j = 0; j < CONVW; ++j) a += u2[tt + j] * cw[j];
                    *(LAS f32x2*)(co + (tb + tt) * CONVC + 2 * cp) = a; } }
            __syncthreads();
#pragma unroll 2
            for (int q = 0; q < CT / 8; ++q) { const int tt = wave * (CT / 8) + q;
                const f32x4 a0 = *(const LAS f32x4*)(co + tt * CONVC + lane * 8), a1 = *(const LAS f32x4*)(co + tt * CONVC + lane * 8 + 4);
                float s = (a0[0] + a0[1]) + (a0[2] + a0[3]) + (a1[0] + a1[1]) + (a1[2] + a1[3]);
                s = sum16(s); s += __shfl_xor(s, 16); s += __shfl_xor(s, 32);
                const float mean = s * (1.0f / CONVC);
                float d[8]; float q2 = 0.f;
#pragma unroll
                for (int j = 0; j < 4; ++j) { d[j] = a0[j] - mean; d[4 + j] = a1[j] - mean; }
#pragma unroll
                for (int j = 0; j < 8; ++j) q2 += d[j] * d[j];
                q2 = sum16(q2); q2 += __shfl_xor(q2, 16); q2 += __shfl_xor(q2, 32);
                const float rstd = rsqrtf(q2 * (1.0f / CONVC) + 1e-5f);
                float o[8];
#pragma unroll
                for (int j = 0; j < 4; ++j) { const float x0 = d[j] * rstd * lg0[j] + lb0[j], x1 = d[4 + j] * rstd * lg1[j] + lb1[j]; o[j] = x0 * sigmoidf_(x0); o[4 + j] = x1 * sigmoidf_(x1); }
                u32x4 w; w.x = pk2(o[0], o[1]); w.y = pk2(o[2], o[3]); w.z = pk2(o[4], o[5]); w.w = pk2(o[6], o[7]);
                *(u32x4*)(Y + (size_t)(b * SEQ + t0 + tt) * D + lane * 8) = w; }
            __syncthreads();
        }
    }
#undef CONV_LOAD
#ifdef TIMING
    if (C.bid == 0 && tid == 0 && l == 0) ((unsigned*)(wsb + WS_CTL))[1024 + 60] = (unsigned)__builtin_amdgcn_s_memrealtime();
#endif
    }
#ifdef TIMING
    if (part == 1 && C.bid == 0 && tid == 0 && l == 0) ((unsigned*)(wsb + WS_CTL))[1024 + 61] = (unsigned)__builtin_amdgcn_s_memrealtime();
#endif
    if (part == 1)
    {
        const int b = C.bid >> 3, h = C.bid & 7;
        LAS unsigned char* L = C.lds;
        LAS float* sCon = (LAS float*)(L + PS_CON); LAS int* flg = (LAS int*)(L + PS_FLAG);
        {
            const float* mu = P->in[I_MU] + (size_t)l * RWKV_IN;
            for (int i = tid; i < 672; i += 512) { float v;
                if (i < 192) v = mu[(i >> 6) * RC + h * HS + (i & 63)]; else if (i < 352) v = mu[3 * RC + i - 192];
                else { const int q = (i - 352) >> 6, c = h * HS + ((i - 352) & 63); const float* src = q == 0 ? P->in[I_KK] : q == 1 ? P->in[I_KA] : q == 2 ? P->in[I_RK] : q == 3 ? P->in[I_GNG] : P->in[I_GNB]; v = src[l * RC + c]; }
                sCon[i] = v; }
            if (tid < 16) flg[tid] = 0;
        }
        __syncthreads();
#define MIX_POST(cq_) do { LAS unsigned char* Sq_ = L + ((cq_) & 1) * AB_SET; _Pragma("unroll") for (int s_ = 0; s_ < 2; ++s_) { const int tk_ = tok0 + 16 * s_; const int t_ = (cq_) * CH + tk_; \
            const f32x4 y4 = *(const LAS f32x4*)((const LAS float*)(Sq_ + AB_Y) + tk_ * 64 + cgE * 4), v4 = *(const LAS f32x4*)((const LAS float*)(Sq_ + AB_V) + tk_ * 64 + cgE * 4), g4 = *(const LAS f32x4*)((const LAS float*)(Sq_ + AB_G) + tk_ * 64 + cgE * 4); \
            const float mean = sum16((y4[0] + y4[1]) + (y4[2] + y4[3])) * (1.0f / HS); const f32x4 d = y4 - mean; \
            const float var = sum16((d[0] * d[0] + d[1] * d[1]) + (d[2] * d[2] + d[3] * d[3])) * (1.0f / HS); \
            const float rstd = rsqrtf(var + 64e-5f); const float bon = ((const LAS float*)(Sq_ + AB_BON))[tk_]; float o[4]; \
            _Pragma("unroll") for (int j = 0; j < 4; ++j) o[j] = (d[j] * rstd * gngv[j] + gnbv[j] + bon * v4[j]) * g4[j]; \
            u32x2 w; w.x = pk2(o[0], o[1]); w.y = pk2(o[2], o[3]); *(u32x2*)(Y + (size_t)(b * SEQ + t_) * D + CONVC + hc) = w; } } while (0)
        if (wave < 4) {
            const int x = lane & 15, g = lane >> 4, ws = wave;
            const int tok0 = tid >> 4, cgE = tid & 15, hc = h * HS + cgE * 4;
            f32x4 mlt, mgt, mle, iac; u32x4 sel0, sel1;
#pragma unroll
            for (int r = 0; r < 4; ++r) { const int m = 4 * g + r; mlt[r] = (m < x) ? 1.f : 0.f; mgt[r] = (x < m) ? 1.f : 0.f; mle[r] = (m <= x) ? 1.f : 0.f; iac[r] = (m == x) ? 1.f : 0.f;
                const unsigned one = 0x3F80u << (16 * (x & 1)); const bool hit = (((x & 7) >> 1) == r);
                sel0[r] = (hit && g == (x >> 3)) ? one : 0u; sel1[r] = (hit && g == 2 + (x >> 3)) ? one : 0u; }
            const bf16x8 Sel0 = __builtin_bit_cast(bf16x8, sel0), Sel1 = __builtin_bit_cast(bf16x8, sel1);
            const f32x4 z4 = (f32x4){0.f, 0.f, 0.f, 0.f};
#define MF(a_, b_, c_) __builtin_amdgcn_mfma_f32_16x16x32_bf16(a_, b_, c_, 0, 0, 0)
#define CVP(a_) __builtin_bit_cast(bf16x8, (u32x4){cvtpk((a_)[0], (a_)[1]), cvtpk((a_)[2], (a_)[3]), 0u, 0u})
#define PK8(a_, b_) __builtin_bit_cast(bf16x8, (u32x4){cvtpk((a_)[0], (a_)[1]), cvtpk((a_)[2], (a_)[3]), cvtpk((b_)[0], (b_)[1]), cvtpk((b_)[2], (b_)[3])})
            f32x4 T[4];
#pragma unroll
            for (int i = 0; i < 4; ++i) T[i] = z4;
            u32x2 n_vf[2];
#define VF_LOAD(ch_) do { _Pragma("unroll") for (int s_ = 0; s_ < 2; ++s_) n_vf[s_] = (l > 0) ? *(const u32x2*)(VF + (size_t)(b * SEQ + (ch_) * CH + tok0 + 16 * s_) * RC + hc) : (u32x2){0u, 0u}; } while (0)
            VF_LOAD(0);
            const f32x4* p4l = (const f32x4*)P->in[I_P] + (size_t)l * (M / 4) * PLE + (size_t)C.bid * (SEQ / CH) * 256 + tid; u32x2* pbl = (u32x2*)(wsb + WS_PB) + (size_t)l * (M / 4) * PLE + (size_t)C.bid * (SEQ / CH) * 256 + tid; f32x4 n_pq;
            static_assert((M / 4) * PLE == 256 * (SEQ / CH) * 256, "p conversion tiling");
            n_pq = p4l[0];
#ifdef TIMING
            if (C.bid == 0 && tid == 0 && l == 0) ((unsigned*)(wsb + WS_CTL))[1024 + 63] = (unsigned)__builtin_amdgcn_s_memrealtime();
#endif
            const f32x4 kkv = *(const LAS f32x4*)(sCon + 352 + cgE * 4), kav = *(const LAS f32x4*)(sCon + 416 + cgE * 4), rkv = *(const LAS f32x4*)(sCon + 480 + cgE * 4);
            TP_DECL();
#pragma unroll 1
            for (int ch = 0; ch < SEQ / CH; ++ch) {
                LAS unsigned char* Sa = L + (ch & 1) * AB_SET; LAS unsigned char* St = L + PS_X;
                u32x2 vfc[2];
#pragma unroll
                for (int s_ = 0; s_ < 2; ++s_) vfc[s_] = n_vf[s_];
                { u32x2 w; w.x = pk2(n_pq[0], n_pq[1]); w.y = pk2(n_pq[2], n_pq[3]); pbl[(size_t)ch * 256] = w; }
                if (ch + 1 < SEQ / CH) { VF_LOAD(ch + 1); n_pq = p4l[(size_t)(ch + 1) * 256]; }
                TP_ACC(6);
                lds_wait_ge(flg + 0, ch + 1); lds_wait_ge(flg + 1, ch + 1); lds_wait_ge(flg + 2, ch + 1); lds_wait_ge(flg + 3, ch + 1);
                TP_ACC(0);
                {
                    LAS float* sR = (LAS float*)(Sa + AB_R); LAS float* sK = (LAS float*)(Sa + AB_K); LAS float* sW = (LAS float*)(Sa + AB_W); LAS float* sA = (LAS float*)(Sa + AB_A);
                    LAS float* sV = (LAS float*)(Sa + AB_V); LAS float* sY = (LAS float*)(Sa + AB_Y);
#pragma unroll
                    for (int s_ = 0; s_ < 2; ++s_) {
                        const int tok = tok0 + 16 * s_; const int t = ch * CH + tok;
                        const f32x4 r4 = *(const LAS f32x4*)(sR + tok * 64 + cgE * 4), k4 = *(const LAS f32x4*)(sK + tok * 64 + cgE * 4), cs = *(const LAS f32x4*)(sW + tok * 64 + cgE * 4), as4 = *(const LAS f32x4*)(sA + tok * 64 + cgE * 4);
                        f32x4 v4 = *(const LAS f32x4*)(sV + tok * 64 + cgE * 4);
                        f32x4 cp = (f32x4){1.f, 1.f, 1.f, 1.f}; if (tok > 0) cp = *(const LAS f32x4*)(sW + (tok - 1) * 64 + cgE * 4);
                        if (l == 0) { u32x2 w; w.x = cvtpk(v4[0], v4[1]); w.y = cvtpk(v4[2], v4[3]); *(u32x2*)(VF + (size_t)(b * SEQ + t) * RC + hc) = w; }
                        else { const f32x4 vg = *(const LAS f32x4*)(sY + tok * 64 + cgE * 4);
                            const float f0 = __uint_as_float(vfc[s_].x << 16), f1 = __uint_as_float(vfc[s_].x & 0xffff0000u), f2 = __uint_as_float(vfc[s_].y << 16), f3 = __uint_as_float(vfc[s_].y & 0xffff0000u);
                            v4[0] += (f0 - v4[0]) * vg[0]; v4[1] += (f1 - v4[1]) * vg[1]; v4[2] += (f2 - v4[2]) * vg[2]; v4[3] += (f3 - v4[3]) * vg[3]; }
                        f32x4 kk4, k2, bb, rt, gm4; float ssq = 0.f, rk = 0.f;
#pragma unroll
                        for (int j = 0; j < 4; ++j) { kk4[j] = k4[j] * kkv[j]; ssq += kk4[j] * kk4[j]; k2[j] = k4[j] * (1.0f + (as4[j] - 1.0f) * kav[j]); rk += r4[j] * k2[j] * rkv[j]; }
                        ssq = sum16(ssq);
                        const float inv = rsqrtf(fmaxf(ssq, 1e-24f));
                        rk = sum16(rk);
#pragma unroll
                        for (int j = 0; j < 4; ++j) { const float gm = cs[j], gi = __builtin_amdgcn_rcpf(gm), gp = cp[j]; gm4[j] = gm;
                            kk4[j] *= inv; bb[j] = kk4[j] * as4[j] * gi; kk4[j] = -kk4[j] * gp; k2[j] *= gi; rt[j] = r4[j] * gm; }
#define XST(off_, v_) *(LAS u32x2*)(St + (off_) + tok * XROW + cgE * 8) = (u32x2){cvtpk((v_)[0], (v_)[1]), cvtpk((v_)[2], (v_)[3])}
                        XST(XS_A, kk4); XST(XS_B, bb); XST(XS_K, k2); XST(XS_R, rt); XST(XS_V, v4);
#undef XST
                        *(LAS f32x4*)(sV + tok * 64 + cgE * 4) = v4;
                        if (cgE == 0) ((LAS float*)(Sa + AB_BON))[tok] = rk;
                        if (tok == CH - 1) *(LAS f32x4*)((LAS float*)(L + PS_GAM) + cgE * 4) = gm4;
                    }
                }
                TP_ACC(2);
                lds_signal(flg + 14, lane); lds_wait_ge(flg + 14, 4 * (ch + 1));
                TP_ACC(4);
#ifndef MIXSKIP_SCAN
#pragma unroll
                for (int sc = 0; sc < 2; ++sc) {
                    const LAS unsigned char* rowp = St + (16 * sc + x) * XROW + g * 16;
                    bf16x8 oA[2], oB[2], oK[2], oR[2];
#pragma unroll
                    for (int kp = 0; kp < 2; ++kp) { oA[kp] = *(const LAS bf16x8*)(rowp + XS_A + kp * 64); oB[kp] = *(const LAS bf16x8*)(rowp + XS_B + kp * 64);
                        oK[kp] = *(const LAS bf16x8*)(rowp + XS_K + kp * 64); oR[kp] = *(const LAS bf16x8*)(rowp + XS_R + kp * 64); }
                    const bf16x8 oV = *(const LAS bf16x8*)(St + XS_V + (16 * sc + x) * XROW + ((16 * ws + 8 * g) & 63) * 2);
                    const f32x4 aL = MF(oB[1], oA[1], MF(oB[0], oA[0], z4)) * mlt;
                    const f32x4 aLT = MF(oA[1], oB[1], MF(oA[0], oB[0], z4)) * mgt;
                    const f32x4 aKT = MF(oA[1], oK[1], MF(oA[0], oK[0], z4)) * mgt;
                    const f32x4 aMb = MF(oB[1], oR[1], MF(oB[0], oR[0], z4)) * mle;
                    const f32x4 aMk = MF(oK[1], oR[1], MF(oK[0], oR[0], z4)) * mle;
                    const bf16x8 pl = CVP(aL), plt = CVP(aLT);
                    const f32x4 l2 = MF(plt, pl, z4), l2t = MF(pl, plt, z4);
                    const bf16x8 pl2 = CVP(l2), pl2t = CVP(l2t);
                    const f32x4 l4 = MF(pl2t, pl2, z4), l4t = MF(pl2, pl2t, z4), l3t = MF(pl2, plt, z4);
                    const bf16x8 pl4 = CVP(l4), pl4t = CVP(l4t);
                    const f32x4 l8 = MF(pl4t, pl4, z4);
                    const f32x4 l12 = MF(pl4t, CVP(l8), z4);
                    const f32x4 q1t = iac + aLT + l2t + l3t, q2 = iac + l4 + l8 + l12;
                    const bf16x8 pq1t = CVP(q1t), pq2 = CVP(q2);
                    const f32x4 nn = MF(pq1t, pq2, z4), nnt = MF(pq2, pq1t, z4);
                    const bf16x8 pn = CVP(nn), pmb = CVP(aMb), pkt = CVP(aKT);
                    const f32x4 p2 = MF(CVP(nnt), pmb, z4);
                    const f32x4 p3 = MF(pkt, pn, z4), p3t = MF(pn, pkt, z4);
                    const f32x4 p4 = MF(CVP(p3t), pmb, aMk);
                    bf16x8 ARk[4], BKk[4];
#pragma unroll
                    for (int kt = 0; kt < 4; ++kt) { const bf16x8 se = (kt & 1) ? Sel1 : Sel0;
                        const f32x4 ta = MF(oA[kt >> 1], se, z4), tr = MF(oR[kt >> 1], se, z4), tb = MF(oB[kt >> 1], se, z4), tk = MF(oK[kt >> 1], se, z4);
                        ARk[kt] = PK8(ta, tr); BKk[kt] = PK8(tb, tk); }
                    const f32x4 trV = MF(oV, Sel0, z4);
                    const bf16x8 bN0 = PK8(nn, z4), bP2I = PK8(p2, iac);
                    f32x4 apT[4], rpT[4];
#pragma unroll
                    for (int kt = 0; kt < 4; ++kt) { apT[kt] = MF(ARk[kt], bN0, z4); rpT[kt] = MF(ARk[kt], bP2I, z4); }
                    const bf16x8 ApOp0 = PK8(apT[0], apT[1]), ApOp1 = PK8(apT[2], apT[3]), RpOp0 = PK8(rpT[0], rpT[1]), RpOp1 = PK8(rpT[2], rpT[3]);
                    const bf16x8 vOp = PK8(trV, z4);
                    f32x4 uT = MF(CVP(p3), vOp, z4), yT = MF(CVP(p4), vOp, z4);
                    const bf16x8 SOp0 = PK8(T[0], T[1]), SOp1 = PK8(T[2], T[3]);
                    uT = MF(ApOp0, SOp0, uT); uT = MF(ApOp1, SOp1, uT);
                    yT = MF(RpOp0, SOp0, yT); yT = MF(RpOp1, SOp1, yT);
                    const bf16x8 UV = PK8(uT, trV);
#pragma unroll
                    for (int kt = 0; kt < 4; ++kt) T[kt] = MF(BKk[kt], UV, T[kt]);
                    LAS float* yp = (LAS float*)(Sa + AB_Y) + (16 * sc + 4 * g) * 64 + 16 * ws + x;
#pragma unroll
                    for (int r = 0; r < 4; ++r) yp[r * 64] = yT[r];
                }
#endif
#pragma unroll
                for (int kt = 0; kt < 4; ++kt) T[kt] = T[kt] * *(const LAS f32x4*)((const LAS float*)(L + PS_GAM) + 16 * kt + 4 * g);
                TP_ACC(3);
                lds_signal(flg + 12, lane); lds_wait_ge(flg + 12, 4 * (ch + 1));
                TP_ACC(4);
            }
#undef MF
#undef CVP
#undef PK8
#undef VF_LOAD
#ifdef TIMING
            if (C.bid == 0 && tid == 0 && l == 0) ((unsigned*)(wsb + WS_CTL))[1024 + 62] = (unsigned)__builtin_amdgcn_s_memrealtime();
#endif
            if (C.bid == 0 && tid == 0 && l == 0) { TP_OUT(0); TP_OUT(2); TP_OUT(3); TP_OUT(4); TP_OUT(5); TP_OUT(6); }
        } else {
            const int ptid = tid - 256, pw = wave - 4, tok0 = ptid >> 4, cgE = ptid & 15, hc = h * HS + cgE * 4;
            __builtin_amdgcn_s_setprio(1);
            int pbar_epoch = 0;
#define PREP_BAR() do { ++pbar_epoch; lds_signal(flg + 8, lane); lds_wait_ge(flg + 8, 4 * pbar_epoch); } while (0)
            const int nt = pw, fr = lane & 15, fq = lane >> 4;
            bf16x8 Bw, Ba, Bv, Bg[3];
            {
                const int n = h * HS + nt * 16 + fr;
#pragma unroll
                for (int j = 0; j < 8; ++j) { const int k = 8 * fq + j;
                    Bw[j] = (short)f2bf(P->in[I_W2][((size_t)l * LW + k) * RC + n]); Ba[j] = (short)f2bf(P->in[I_A2][((size_t)l * LA + k) * RC + n]);
                    Bv[j] = (l > 0) ? (short)f2bf(P->in[I_V2][((size_t)(l - 1) * LV + k) * RC + n]) : (short)0;
#pragma unroll
                    for (int s3 = 0; s3 < 3; ++s3) Bg[s3][j] = (short)f2bf(P->in[I_G2][((size_t)l * LG + 32 * s3 + k) * RC + n]); }
            }
            const int ncol = h * HS + nt * 16 + fr;
            const float w0c = P->in[I_W0][l * RC + ncol], a0c = P->in[I_A0][l * RC + ncol], v0c = (l > 0) ? P->in[I_V0][(l - 1) * RC + ncol] : 0.f;
            const bf16_t* Zb = Z + (size_t)b * SEQ * ZC;
            u32x2 n_rc[2], n_rp[2], n_kc[2], n_kp[2], n_vc[2], n_vp[2]; bf16x8 n_Aw[2], n_Aa[2], n_Av[2], n_Ag[2][3];
            const unsigned vo_b = (unsigned)((tok0 * ZC + ZC_R + hc) * 2);
            const unsigned vo_a = (unsigned)((fr * LRC + fq * 8) * 2);
            const bf16_t* LRb = (const bf16_t*)(wsb + WS_LR) + (size_t)b * SEQ * LRC;
            struct W1 { const float* src; int ldw; bf16_t* dst; const float* gain; };
            auto w1 = [&](int ch_) -> W1 {
                const int sidx = (C.bid * 48 + ch_) * 4 + pw; const int type = sidx >> 14, r_ = sidx & 16383, e = r_ >> 9, q = r_ & 511;
                W1 t;
                if (type < 2) { const int ks = ((q >> 5) << 2) | (q & 3), ns = (q >> 2) & 7, n = 64 * ns + lane;
                    t.src = (type ? P->in[I_EWU] : P->in[I_EWG]) + ((size_t)(l * NE + e) * D + 16 * ks) * FF + 64 * ns; t.ldw = FF;
                    t.dst = (bf16_t*)(wsb + WS_W + (size_t)l * W_LAYER + WO_GU) + (size_t)(e * 1024 + (n >> 7) * 256 + type * 128 + (n & 127)) * D + 16 * ks; t.gain = P->in[I_FFNN] + l * D + 16 * ks;
                } else { const int ks = ((q >> 6) << 2) | (q & 3), ns = (q >> 2) & 15, n = 64 * ns + lane;
                    t.src = P->in[I_EWD] + ((size_t)(l * NE + e) * FF + 16 * ks) * D + 64 * ns; t.ldw = D;
                    t.dst = (bf16_t*)(wsb + WS_W + (size_t)l * W_LAYER + WO_D) + (size_t)(e * 1024 + n) * FF + 16 * ks; t.gain = nullptr; }
                return t; };
            float wq[16]; const unsigned lane4 = (unsigned)lane * 4u;
#define W1_LOAD(ch_) do { const W1 t_ = w1(ch_); _Pragma("unroll") for (int j = 0; j < 16; ++j) wq[j] = *(const float*)((const char*)(t_.src + (size_t)j * t_.ldw) + (size_t)lane4); } while (0)
            static_assert(3 * NE * (D / 16) * (FF / 64) == 256 * 48 * 4, "expert weight strips");
            W1_LOAD(0);
#define MIX_LOAD_Z(ch_, CHK_) do { _Pragma("unroll") for (int s_ = 0; s_ < 2; ++s_) { const char* bc_ = (const char*)(Zb + (size_t)((ch_) * CH + 16 * s_) * ZC); const char* bp_ = bc_ - ZC * 2; \
            const bool hp_ = !(CHK_) || ((ch_) * CH + 16 * s_ + tok0 > 0); const u32x2 z2_ = (u32x2){0u, 0u}; \
            n_rc[s_] = *(const u32x2*)(bc_ + (size_t)vo_b); n_kc[s_] = *(const u32x2*)(bc_ + (size_t)vo_b + 1024); n_vc[s_] = *(const u32x2*)(bc_ + (size_t)vo_b + 2048); \
            n_rp[s_] = hp_ ? *(const u32x2*)(bp_ + (size_t)vo_b) : z2_; n_kp[s_] = hp_ ? *(const u32x2*)(bp_ + (size_t)vo_b + 1024) : z2_; n_vp[s_] = hp_ ? *(const u32x2*)(bp_ + (size_t)vo_b + 2048) : z2_; } } while (0)
#define MIX_LOAD_A(ch_) do { _Pragma("unroll") for (int s_ = 0; s_ < 2; ++s_) { const char* ba_ = (const char*)(LRb + (size_t)((ch_) * CH + 16 * s_) * LRC); \
            n_Aw[s_] = *(const bf16x8*)(ba_ + (size_t)vo_a); n_Aa[s_] = *(const bf16x8*)(ba_ + (size_t)vo_a + 64); n_Ag[s_][0] = *(const bf16x8*)(ba_ + (size_t)vo_a + 128); n_Ag[s_][1] = *(const bf16x8*)(ba_ + (size_t)vo_a + 192); \
            n_Ag[s_][2] = *(const bf16x8*)(ba_ + (size_t)vo_a + 256); n_Av[s_] = *(const bf16x8*)(ba_ + (size_t)vo_a + 320); } } while (0)
            MIX_LOAD_Z(0, true); MIX_LOAD_A(0);
            const f32x4 mur = *(const LAS f32x4*)(sCon + cgE * 4), muk = *(const LAS f32x4*)(sCon + 64 + cgE * 4), muv = *(const LAS f32x4*)(sCon + 128 + cgE * 4);
            const f32x4 gngv = *(const LAS f32x4*)(sCon + 544 + cgE * 4), gnbv = *(const LAS f32x4*)(sCon + 608 + cgE * 4);
            TP_DECL();
#pragma unroll 1
            for (int ch = 0; ch < SEQ / CH; ++ch) {
                LAS unsigned char* Sa = L + (ch & 1) * AB_SET;
                LAS float* sK = (LAS float*)(Sa + AB_K); LAS float* sW = (LAS float*)(Sa + AB_W); LAS float* sR = (LAS float*)(Sa + AB_R); LAS float* sA = (LAS float*)(Sa + AB_A);
                LAS float* sV = (LAS float*)(Sa + AB_V); LAS float* sY = (LAS float*)(Sa + AB_Y); LAS float* sG = (LAS float*)(Sa + AB_G);
                TP_ACC(9);
                if (ch >= 2) { lds_wait_ge(flg + 12, 4 * (ch - 1)); TP_ACC(1); MIX_POST(ch - 2); }
                TP_ACC(5);
#pragma unroll
                for (int s_ = 0; s_ < 2; ++s_) {
                    const int tokE = tok0 + 16 * s_;
#define LERP2(dst, wc_, wp_, m0, m1) do { const float c0_ = __uint_as_float((wc_) << 16), c1_ = __uint_as_float((wc_) & 0xffff0000u), p0_ = __uint_as_float((wp_) << 16), p1_ = __uint_as_float((wp_) & 0xffff0000u); \
                        (dst)[0] = c0_ + (p0_ - c0_) * (m0); (dst)[1] = c1_ + (p1_ - c1_) * (m1); } while (0)
                    f32x4 r4, k4, v4; float t2[2];
                    LERP2(t2, n_rc[s_].x, n_rp[s_].x, mur[0], mur[1]); r4[0] = t2[0]; r4[1] = t2[1]; LERP2(t2, n_rc[s_].y, n_rp[s_].y, mur[2], mur[3]); r4[2] = t2[0]; r4[3] = t2[1];
                    LERP2(t2, n_kc[s_].x, n_kp[s_].x, muk[0], muk[1]); k4[0] = t2[0]; k4[1] = t2[1]; LERP2(t2, n_kc[s_].y, n_kp[s_].y, muk[2], muk[3]); k4[2] = t2[0]; k4[3] = t2[1];
                    LERP2(t2, n_vc[s_].x, n_vp[s_].x, muv[0], muv[1]); v4[0] = t2[0]; v4[1] = t2[1]; LERP2(t2, n_vc[s_].y, n_vp[s_].y, muv[2], muv[3]); v4[2] = t2[0]; v4[3] = t2[1];
                    *(LAS f32x4*)(sR + tokE * 64 + cgE * 4) = r4; *(LAS f32x4*)(sK + tokE * 64 + cgE * 4) = k4; *(LAS f32x4*)(sV + tokE * 64 + cgE * 4) = v4;
#undef LERP2
                }
                if (ch < 48) { const W1 t_ = w1(ch); float gq[16];
#pragma unroll
                    for (int j = 0; j < 16; ++j) gq[j] = t_.gain ? t_.gain[j] : 1.0f;
                    u32x4 o0, o1;
                    o0.x = pk2(wq[0] * gq[0], wq[1] * gq[1]); o0.y = pk2(wq[2] * gq[2], wq[3] * gq[3]); o0.z = pk2(wq[4] * gq[4], wq[5] * gq[5]); o0.w = pk2(wq[6] * gq[6], wq[7] * gq[7]);
                    o1.x = pk2(wq[8] * gq[8], wq[9] * gq[9]); o1.y = pk2(wq[10] * gq[10], wq[11] * gq[11]); o1.z = pk2(wq[12] * gq[12], wq[13] * gq[13]); o1.w = pk2(wq[14] * gq[14], wq[15] * gq[15]);
                    *(u32x4*)t_.dst = o0; *(u32x4*)(t_.dst + 8) = o1;
                    if (ch + 1 < 48) W1_LOAD(ch + 1); }
                if (ch + 1 < SEQ / CH) MIX_LOAD_Z(ch + 1, false);
                TP_ACC(7);
                PREP_BAR();
                TP_ACC(6);
                {
                    f32x4 lw[2];
#pragma unroll
                    for (int mt = 0; mt < 2; ++mt) {
                        const f32x4 z4 = (f32x4){0.f, 0.f, 0.f, 0.f};
                        f32x4 cw4 = __builtin_amdgcn_mfma_f32_16x16x32_bf16(n_Aw[mt], Bw, z4, 0, 0, 0), ca4 = __builtin_amdgcn_mfma_f32_16x16x32_bf16(n_Aa[mt], Ba, z4, 0, 0, 0), cv4 = (l > 0) ? __builtin_amdgcn_mfma_f32_16x16x32_bf16(n_Av[mt], Bv, z4, 0, 0, 0) : z4, cg4 = z4;
#pragma unroll
                        for (int s3 = 0; s3 < 3; ++s3) cg4 = __builtin_amdgcn_mfma_f32_16x16x32_bf16(n_Ag[mt][s3], Bg[s3], cg4, 0, 0, 0);
#pragma unroll
                        for (int j = 0; j < 4; ++j) { const int o = (mt * 16 + fq * 4 + j) * 64 + nt * 16 + fr;
                            lw[mt][j] = -0.60653066f * sigmoidf_(cw4[j] + w0c); sA[o] = sigmoidf_(ca4[j] + a0c); sG[o] = cg4[j]; if (l > 0) sY[o] = sigmoidf_(cv4[j] + v0c); }
                    }
                    if (ch + 1 < SEQ / CH) MIX_LOAD_A(ch + 1);
                    float base = 0.f;
#pragma unroll
                    for (int mt = 0; mt < 2; ++mt) {
                        lw[mt][1] += lw[mt][0]; lw[mt][2] += lw[mt][1]; lw[mt][3] += lw[mt][2];
                        const float tg = lw[mt][3], s16 = xsum16(tg), s32 = xsum32(s16);
                        const float pg = (fq == 0) ? 0.f : (fq == 1) ? (s16 - tg) : (fq == 2) ? (s32 - s16) : (s32 - tg);
#pragma unroll
                        for (int j = 0; j < 4; ++j) sW[(mt * 16 + fq * 4 + j) * 64 + nt * 16 + fr] = __expf(base + pg + lw[mt][j]);
                        base += s32; }
                }
                TP_ACC(8);
                lds_signal(flg + pw, lane);
            }
            if (C.bid == 0 && tid == 256 && l == 0) { TP_OUT(1); TP_OUT(7); TP_OUT(8); TP_OUT(9); }
            lds_wait_ge(flg + 12, 4 * (SEQ / CH - 1)); MIX_POST(SEQ / CH - 2);
            lds_wait_ge(flg + 12, 4 * (SEQ / CH)); MIX_POST(SEQ / CH - 1);
            __builtin_amdgcn_s_setprio(0);
#undef MIX_LOAD_Z
#undef MIX_LOAD_A
#undef W1_LOAD
#undef PREP_BAR
        }
#undef MIX_POST
        __syncthreads();
    }
}

__device__ __forceinline__ void phase_router(KP P, const Ctx& C0, unsigned char* wsb, int l) {
    const Ctx C = fresh(C0);
    const bf16_t* h = (const bf16_t*)(wsb + WS_HB); const bf16_t* wrh = (const bf16_t*)(wsb + WS_WR) + (size_t)(l * 2) * 48 * D; const bf16_t* wrl = wrh + (size_t)48 * D;
    float* rsf = (float*)(wsb + WS_RSF); int* cnt = (int*)(wsb + WS_CTL) + l * 64; int* tlist = (int*)(wsb + WS_TLIST); float* glist = (float*)(wsb + WS_GLIST); int* tslot = (int*)(wsb + WS_TSLOT);
    const int gw = C.vcu * 8 + C.wave, NGW = C.G * 8, lane = C.lane, fr = lane & 15, fq = lane >> 4, tid = C.tid;
    constexpr int WROW = 272;
    LAS unsigned char* wsl = C.lds;
    LAS float* lg = (LAS float*)(C.lds + 32768 + C.wave * 4096);
    LAS int* lcnt = (LAS int*)(C.lds + 65536);
    static_assert(M / 16 == 2 * 256 * 8, "two 16-token tiles per wave");
    if (tid < 64) lcnt[tid] = 0;
    f32x4 acc[2][3]; float ss[2] = {0.f, 0.f};
#pragma unroll
    for (int it = 0; it < 2; ++it)
#pragma unroll
        for (int nt = 0; nt < 3; ++nt) acc[it][nt] = (f32x4){0.f, 0.f, 0.f, 0.f};
    const bf16_t* hrow0 = h + (size_t)((gw) * 16 + fr) * D + fq * 8; const bf16_t* hrow1 = h + (size_t)((gw + NGW) * 16 + fr) * D + fq * 8;
#pragma unroll 1
    for (int kb = 0; kb < D / 128; ++kb) {
        __syncthreads();
#pragma unroll
        for (int i = 0; i < 3; ++i) { const int p = tid + 512 * i; const int hl = p / 768, r = (p % 768) >> 4, c = p & 15;
            *(LAS u32x4*)(wsl + (hl * 48 + r) * WROW + c * 16) = *(const u32x4*)((hl ? wrl : wrh) + (size_t)r * D + kb * 128 + c * 8); }
        bf16x8 a0[4], a1[4];
#pragma unroll
        for (int ks = 0; ks < 4; ++ks) { a0[ks] = *(const bf16x8*)(hrow0 + kb * 128 + ks * 32); a1[ks] = *(const bf16x8*)(hrow1 + kb * 128 + ks * 32); }
        __syncthreads();
#pragma unroll
        for (int ks = 0; ks < 4; ++ks) {
#pragma unroll
            for (int j = 0; j < 8; ++j) { const float x0 = __uint_as_float(((unsigned)(unsigned short)a0[ks][j]) << 16), x1 = __uint_as_float(((unsigned)(unsigned short)a1[ks][j]) << 16); ss[0] += x0 * x0; ss[1] += x1 * x1; }
#pragma unroll
            for (int nt = 0; nt < 3; ++nt) { const bf16x8 bh = *(const LAS bf16x8*)(wsl + (nt * 16 + fr) * WROW + (ks * 32 + fq * 8) * 2), bl = *(const LAS bf16x8*)(wsl + (48 + nt * 16 + fr) * WROW + (ks * 32 + fq * 8) * 2);
                acc[0][nt] = __builtin_amdgcn_mfma_f32_16x16x32_bf16(a0[ks], bh, acc[0][nt], 0, 0, 0); acc[0][nt] = __builtin_amdgcn_mfma_f32_16x16x32_bf16(a0[ks], bl, acc[0][nt], 0, 0, 0);
                acc[1][nt] = __builtin_amdgcn_mfma_f32_16x16x32_bf16(a1[ks], bh, acc[1][nt], 0, 0, 0); acc[1][nt] = __builtin_amdgcn_mfma_f32_16x16x32_bf16(a1[ks], bl, acc[1][nt], 0, 0, 0); }
        }
    }
    int me0[2], me1[2], mp0[2], mp1[2]; float mw0[2], mw1[2], mrs[2]; float* rlist = (float*)(wsb + WS_RLIST);
#pragma unroll
    for (int it = 0; it < 2; ++it) {
        const int tile = gw + it * NGW;
        float s2 = ss[it]; s2 += __shfl_xor(s2, 16); s2 += __shfl_xor(s2, 32);
        const float rsq = rsqrtf(s2 * (1.0f / D) + 1e-6f);
#pragma unroll
        for (int nt = 0; nt < 3; ++nt)
#pragma unroll
            for (int j = 0; j < 4; ++j) lg[(fq * 4 + j) * 48 + nt * 16 + fr] = acc[it][nt][j];
        if (fq == 0) { lg[768 + fr] = rsq; rsf[tile * 16 + fr] = rsq; }
        asm volatile("s_waitcnt lgkmcnt(0)" ::: "memory");
        me0[it] = 0; me1[it] = 0; mp0[it] = 0; mp1[it] = 0; mw0[it] = 0.f; mw1[it] = 0.f; mrs[it] = 0.f;
        if (lane < 16) {
            const float rs = lg[768 + lane]; const LAS float* q = lg + lane * 48; mrs[it] = rs;
            float gl[NG]; int gi = 0;
#pragma unroll
            for (int j = 0; j < NG; ++j) gl[j] = q[j] * rs + P->in[I_RGB][l * NG + j];
            float gm = gl[0];
#pragma unroll
            for (int j = 1; j < NG; ++j) if (gl[j] > gm) { gm = gl[j]; gi = j; }
            float den = 0.f;
#pragma unroll
            for (int j = 0; j < NG; ++j) den += __expf(gl[j] - gm);
            const float gp = 1.0f / den;
            float el[EPG];
#pragma unroll
            for (int e = 0; e < EPG; ++e) el[e] = q[NG + gi * EPG + e] * rs + P->in[I_REB][(l * NG + gi) * EPG + e];
            int i0 = 0; float m0 = el[0];
#pragma unroll
            for (int e = 1; e < EPG; ++e) if (el[e] > m0) { m0 = el[e]; i0 = e; }
            int i1 = (i0 == 0) ? 1 : 0; float m1 = -3.0e38f;
#pragma unroll
            for (int e = 0; e < EPG; ++e) if (e != i0 && el[e] > m1) { m1 = el[e]; i1 = e; }
            const float p1 = 1.0f / (1.0f + __expf(m0 - m1));
            mw0[it] = (1.0f - p1) * gp; mw1[it] = p1 * gp;
            me0[it] = gi * EPG + i0; me1[it] = gi * EPG + i1;
            mp0[it] = __hip_atomic_fetch_add(&lcnt[me0[it]], 1, __ATOMIC_RELAXED, __HIP_MEMORY_SCOPE_WORKGROUP); mp1[it] = __hip_atomic_fetch_add(&lcnt[me1[it]], 1, __ATOMIC_RELAXED, __HIP_MEMORY_SCOPE_WORKGROUP);
        }
        asm volatile("s_waitcnt lgkmcnt(0)" ::: "memory");
    }
    __syncthreads();
    if (tid < NE) lcnt[32 + tid] = atomicAdd(&cnt[tid], lcnt[tid]);
    __syncthreads();
    if (lane < 16) {
#pragma unroll
        for (int it = 0; it < 2; ++it) { const int t = (gw + it * NGW) * 16 + lane;
            const int p0 = lcnt[32 + me0[it]] + mp0[it], p1 = lcnt[32 + me1[it]] + mp1[it];
            tlist[me0[it] * LCAP + p0] = t; glist[me0[it] * LCAP + p0] = mw0[it]; rlist[me0[it] * LCAP + p0] = mrs[it]; tslot[t * 2] = me0[it] * LCAP + p0;
            tlist[me1[it] * LCAP + p1] = t; glist[me1[it] * LCAP + p1] = mw1[it]; rlist[me1[it] * LCAP + p1] = mrs[it]; tslot[t * 2 + 1] = me1[it] * LCAP + p1; }
    }
    __syncthreads();
}

__device__ __forceinline__ void moe_prefix(KP P, const Ctx& C0, unsigned char* wsb, int l) {
    const Ctx C = fresh(C0);
    const int* cnt = (const int*)(wsb + WS_CTL) + l * 64;
    LAS int* tp = (LAS int*)(C.lds + LDS_MISC); LAS int* ps = (LAS int*)(C.lds + LDS_MISC + 256);
    if (C.wave == 0) { const int e = C.lane & 31; const int nt_ = (cnt[e] + 255) >> 8; int inc = nt_;
#pragma unroll
        for (int o = 1; o < 32; o <<= 1) { const int v = __shfl_up(inc, o, 64); if ((C.lane & 31) >= o) inc += v; }
        if (C.lane < 32) { tp[e] = inc - nt_; ps[e] = (inc - nt_) * 256; if (e == 31) { tp[NE] = inc; ps[NE] = inc * 256; } } }
    __syncthreads();
}

__device__ __forceinline__ void phase_combine(KP P, const Ctx& C0, unsigned char* wsb, int l) {
    const Ctx C = fresh(C0);
    bf16_t* hb = (bf16_t*)(wsb + WS_HB); const bf16_t* ys = (const bf16_t*)(wsb + WS_YS); const int* tslot = (const int*)(wsb + WS_TSLOT); float* rsp = (float*)(wsb + WS_RSP);
    const LAS int* ps = (const LAS int*)(C.lds + LDS_MISC + 256);
    const int gw = C.vcu * 8 + C.wave, NGW = C.G * 8, lane = C.lane;
    static_assert((M / 2048) % 4 == 0, "rows per wave divisible by 4");
    for (int m0 = gw; m0 < M; m0 += 4 * NGW) {
        int sl[4][2];
#pragma unroll
        for (int q = 0; q < 4; ++q) { const u32x2 t2 = *(const u32x2*)(tslot + (size_t)(m0 + q * NGW) * 2); sl[q][0] = (int)t2.x; sl[q][1] = (int)t2.y; }
        u32x4 hv[4][2], ya[4][2], yb[4][2];
#pragma unroll
        for (int q = 0; q < 4; ++q) { const int m = m0 + q * NGW;
            const size_t r0 = (size_t)(ps[sl[q][0] >> 16] + (sl[q][0] & 0xffff)), r1 = (size_t)(ps[sl[q][1] >> 16] + (sl[q][1] & 0xffff));
            const u32x4* hr = (const u32x4*)(hb + (size_t)m * D) + lane; const u32x4* y0 = (const u32x4*)(ys + r0 * D) + lane; const u32x4* y1 = (const u32x4*)(ys + r1 * D) + lane;
#pragma unroll
            for (int j = 0; j < 2; ++j) { hv[q][j] = hr[64 * j]; ya[q][j] = y0[64 * j]; yb[q][j] = y1[64 * j]; } }
#pragma unroll
        for (int q = 0; q < 4; ++q) { const int m = m0 + q * NGW; u32x4* hr = (u32x4*)(hb + (size_t)m * D) + lane; float s = 0.f;
#pragma unroll
            for (int j = 0; j < 2; ++j) { u32x4 w;
#pragma unroll
                for (int c = 0; c < 4; ++c) { const float lo = (__uint_as_float(hv[q][j][c] << 16) + __uint_as_float(ya[q][j][c] << 16)) + __uint_as_float(yb[q][j][c] << 16);
                    const float hi = (__uint_as_float(hv[q][j][c] & 0xffff0000u) + __uint_as_float(ya[q][j][c] & 0xffff0000u)) + __uint_as_float(yb[q][j][c] & 0xffff0000u);
                    w[c] = pk2(lo, hi); const float rl = __uint_as_float(w[c] << 16), rh = __uint_as_float(w[c] & 0xffff0000u); s += rl * rl + rh * rh; }
                hr[64 * j] = w; }
            s = sum16(s); s += __shfl_xor(s, 16); s += __shfl_xor(s, 32);
            if (lane == 0) rsp[m] = rsqrtf(s * (1.0f / D) + 1e-6f); }
    }
}

__device__ __forceinline__ void phase_final(KP P, const Ctx& C0, unsigned char* wsb) {
    const Ctx C = fresh(C0);
    float* out = P->out; const bf16_t* h = (const bf16_t*)(wsb + WS_Y); const float* g = P->in[I_FINN]; const float* part = (const float*)(wsb + WS_PART);
    const int gw = C.vcu * 8 + C.wave, NGW = C.G * 8, lane = C.lane;
    f32x4 gv[4];
#pragma unroll
    for (int j = 0; j < 4; ++j) gv[j] = ((const f32x4*)g)[lane * 4 + j];
    for (int m0 = gw; m0 < M; m0 += 4 * NGW) {
        u32x4 ra[4], rb[4]; float ssq[4];
#pragma unroll
        for (int q = 0; q < 4; ++q) { const int m = m0 + q * NGW; const u32x4* hr = (const u32x4*)(h + (size_t)m * D) + lane * 2; ra[q] = hr[0]; rb[q] = hr[1]; ssq[q] = (lane < NPART) ? part[(size_t)m * NPART + lane] : 0.f; }
#pragma unroll
        for (int q = 0; q < 4; ++q) { const int m = m0 + q * NGW; const u32x4 a = ra[q], b = rb[q];
            float ss = sum16(ssq[q]); ss += __shfl_xor(ss, 16); ss += __shfl_xor(ss, 32);
            const float rs = rsqrtf(ss * (1.0f / D) + 1e-6f);
            f32x4* o = (f32x4*)(out + (size_t)m * D) + lane * 4;
            o[0] = (f32x4){__uint_as_float(a.x << 16), __uint_as_float(a.x & 0xffff0000u), __uint_as_float(a.y << 16), __uint_as_float(a.y & 0xffff0000u)} * rs * gv[0];
            o[1] = (f32x4){__uint_as_float(a.z << 16), __uint_as_float(a.z & 0xffff0000u), __uint_as_float(a.w << 16), __uint_as_float(a.w & 0xffff0000u)} * rs * gv[1];
            o[2] = (f32x4){__uint_as_float(b.x << 16), __uint_as_float(b.x & 0xffff0000u), __uint_as_float(b.y << 16), __uint_as_float(b.y & 0xffff0000u)} * rs * gv[2];
            o[3] = (f32x4){__uint_as_float(b.z << 16), __uint_as_float(b.z & 0xffff0000u), __uint_as_float(b.w << 16), __uint_as_float(b.w & 0xffff0000u)} * rs * gv[3];
#ifdef TIMING
            if (m == 0 && lane == 0) { asm volatile("s_waitcnt vmcnt(0)" ::: "memory"); const unsigned* st = (const unsigned*)(wsb + WS_CTL) + 1024; out[0] = exp2f(rintf(16.0f * log2f((float)(st[TIM_A1] - st[TIM_A0]) * 0.01f + 1.0f)) * 0.0625f) * 0.1f; }
#endif
        }
    }
}

__device__ __forceinline__ float dbg_dot(const bf16_t* a, const bf16_t* b, int K, int lane) {
    float s = 0.f;
    for (int k = lane * 8; k < K; k += 512) { const u32x4 av = *(const u32x4*)(a + k), bv = *(const u32x4*)(b + k);
#pragma unroll
        for (int j = 0; j < 4; ++j) s += __uint_as_float(av[j] << 16) * __uint_as_float(bv[j] << 16) + __uint_as_float(av[j] & 0xffff0000u) * __uint_as_float(bv[j] & 0xffff0000u); }
    return wave_sum(s);
}
__device__ __forceinline__ void phase_dbg(KP P, const Ctx& C0, unsigned char* wsb, const int mode) {
    const Ctx C = fresh(C0);
    const int gw = C.vcu * 8 + C.wave, NGW = C.G * 8, lane = C.lane;
    const bf16_t* hb = (const bf16_t*)(wsb + WS_HB); const float* part = (const float*)(wsb + WS_PART);
    unsigned char* wl = wsb + WS_W;
    for (int m = gw; m < M; m += NGW) {
        bool ok = true;
        for (int q = 0; q < 4; ++q) {
            unsigned hsh = (unsigned)m * 2654435761u + (unsigned)q * 40503u; hsh ^= hsh >> 13;
            if (mode == 1) {
                const int n = hsh % IN_COLS;
                float ss = 0.f; for (int p = 0; p < NPART; ++p) ss += part[(size_t)m * NPART + p];
                const float ref = dbg_dot(hb + (size_t)m * D, (const bf16_t*)(wl + WO_IN) + (size_t)n * D, D, lane) * rsqrtf(ss * (1.0f / D) + 1e-6f);
                const float got = bf2f(((const bf16_t*)(wsb + WS_Z))[(size_t)m * ZC + n]);
                if (!(fabsf(got - ref) <= 0.02f * fabsf(ref) + 0.02f)) ok = false;
            } else if (mode == 2) {
                const int n = hsh % D;
                const float ref = P->in[I_X][(size_t)m * D + n] + dbg_dot((const bf16_t*)(wsb + WS_Y) + (size_t)m * D, (const bf16_t*)(wl + WO_OUT) + (size_t)n * D, D, lane);
                const float got = P->out[(size_t)m * D + n];
                if (!(fabsf(got - ref) <= 0.02f * fabsf(ref) + 0.02f)) ok = false;
            } else if (mode == 3) {
                const int n = hsh % IN_COLS; const int k = (hsh >> 8) % D;
                const float ref = P->in[I_WIN][(size_t)k * IN_COLS + n] * P->in[I_MIXN][k];
                const float got = bf2f(((const bf16_t*)(wl + WO_IN))[(size_t)n * D + k]);
                if (!(fabsf(got - ref) <= 0.01f * fabsf(ref) + 1e-4f)) ok = false;
            } else if (mode == 4) {
                const int n = hsh % D;
                const float ref = P->in[I_X][(size_t)m * D + n]; const float got = bf2f(hb[(size_t)m * D + n]);
                if (!(fabsf(got - ref) <= 0.01f * fabsf(ref) + 1e-4f)) ok = false;
            }
        }
        const f32x4* xr = (const f32x4*)(P->in[I_X] + (size_t)m * D) + lane; f32x4* o = (f32x4*)(P->out + (size_t)m * D) + lane;
#pragma unroll
        for (int j = 0; j < 4; ++j) o[64 * j] = ok ? xr[64 * j] : (f32x4){0.f, 0.f, 0.f, 0.f};
    }
}

#define XB_TMO      128
#define XB_XCNT(j)  (256  + 64 * (j))
#define XB_XSUB(j)  (1280 + 64 * (j))
#define XB_XGEN(j)  (2304 + 64 * (j))
#define XB_TOP      3328
#define XB_TOPGEN   3392
#define XCD_BAR_WORDS 3456
#define XB_SPIN_CAP (1u << 22)
constexpr int CW_BAR = 8192;
constexpr int LDS_XB = LDS_BYTES - 64;
__device__ __forceinline__ unsigned xb_ld(unsigned* p)              { return __hip_atomic_load(p, __ATOMIC_RELAXED, __HIP_MEMORY_SCOPE_AGENT); }
__device__ __forceinline__ unsigned xb_add(unsigned* p, unsigned v) { return __hip_atomic_fetch_add(p, v, __ATOMIC_RELAXED, __HIP_MEMORY_SCOPE_AGENT); }
__device__ __forceinline__ unsigned xb_xcc_id() { return (unsigned)__builtin_amdgcn_s_getreg((3 << 11) | 20) & 0xFu; }
#define XB_SPIN(cond, bar) do { unsigned _sp = 0; while (cond) { __builtin_amdgcn_s_sleep(1); \
    if ((++_sp & 255u) == 0u) { if (xb_ld(&(bar)[XB_TMO])) break; if (_sp > XB_SPIN_CAP) { atomicAdd(&(bar)[XB_TMO], 1u); break; } } } } while (0)
struct XcdBarrier { unsigned* bar; unsigned x; volatile LAS unsigned* st; };
__device__ __forceinline__ XcdBarrier xcd_barrier_post(unsigned* bar, volatile LAS unsigned* st) {
    XcdBarrier b; b.bar = bar; b.x = xb_xcc_id(); b.st = st;
    if (threadIdx.x == 0) (void)xb_add(&bar[XB_XCNT(b.x)], 1u);
    return b;
}
__device__ __forceinline__ void xcd_barrier_complete(unsigned* bar, unsigned x, unsigned& nloc, unsigned& nx) {
    const unsigned G = gridDim.x * gridDim.y * gridDim.z;
    unsigned sum, cnt, mine, sp = 0u;
    for (;;) {
        sum = 0u; cnt = 0u; mine = 0u;
#pragma unroll
        for (unsigned j = 0; j < 16; ++j) { const unsigned c = xb_ld(&bar[XB_XCNT(j)]); sum += c; cnt += (c > 0u) ? 1u : 0u; mine = (j == x) ? c : mine; }
        if (sum == G) break;
        __builtin_amdgcn_s_sleep(1);
        if ((++sp & 255u) == 0u) { if (xb_ld(&bar[XB_TMO])) break; if (sp > XB_SPIN_CAP) { atomicAdd(&bar[XB_TMO], 1u); break; } }
    }
    nloc = mine > 0u ? mine : 1u; nx = cnt > 0u ? cnt : 1u;
}
__device__ __forceinline__ void xcd_barrier(const XcdBarrier& b) {
    asm volatile("s_waitcnt vmcnt(0)" ::: "memory");
    __syncthreads();
    if (threadIdx.x == 0) {
        unsigned* bar = b.bar;
        __builtin_amdgcn_s_waitcnt(0);
        unsigned nloc = b.st[0], nx = b.st[1];
        if (nloc == 0u) { xcd_barrier_complete(bar, b.x, nloc, nx); b.st[0] = nloc; b.st[1] = nx; }
        const unsigned old = xb_add(&bar[XB_XSUB(b.x)], 1u);
        const unsigned gen = old / nloc;
        if (old + 1u == (gen + 1u) * nloc) {
            __builtin_amdgcn_fence(__ATOMIC_RELEASE, "agent");
            asm volatile("s_waitcnt vmcnt(0)" ::: "memory");
            const unsigned og = xb_add(&bar[XB_TOP], 1u);
            const unsigned tg = og / nx;
            if (og + 1u == (tg + 1u) * nx) xb_add(&bar[XB_TOPGEN], 1u);
            else XB_SPIN(xb_ld(&bar[XB_TOPGEN]) == tg, bar);
            __builtin_amdgcn_fence(__ATOMIC_ACQUIRE, "agent");
            xb_add(&bar[XB_XGEN(b.x)], 1u);
            asm volatile("s_waitcnt vmcnt(0)" ::: "memory");
        } else {
            XB_SPIN(xb_ld(&bar[XB_XGEN(b.x)]) == gen, bar);
            __builtin_amdgcn_fence(__ATOMIC_ACQUIRE, "agent");
            asm volatile("s_waitcnt vmcnt(0)" ::: "memory");
        }
    }
    __syncthreads();
}

constexpr int N_PREP = 3;
constexpr int N_PHASES = N_PREP + 1 + 8 * DEPTH;

constexpr int PP_UNITS = (M / 256) * (D / 256), PP_Q1 = 4, PP_Q2 = 3;
__device__ __forceinline__ void run_pp_tail(const Ctx& C, KP KPp, unsigned char* ws, unsigned char* wl, int l, int bid, const int which) {
    const LAS int* tprefix = (const LAS int*)(C.lds + LDS_MISC);
    const int T = tprefix[32], R = (T + 63) >> 6, rem = T - 64 * (R - 1);
    const int U = (bid & 7) * 32 + (bid >> 3);
    const int nidle = 256 - 4 * rem, rank = U - 4 * rem;
    const int P1 = min(PP_UNITS, nidle * PP_Q1), P12 = min(PP_UNITS, P1 + nidle * PP_Q2);
    pg8::SubsetOrder S; S.B.init(M, D, C.G, bid); S.limit = PP_UNITS;
    if (which == 0) { S.first = rank; S.stride = nidle; S.count = rank >= 0 ? PP_Q1 : 0; }
    else if (which == 1) { S.first = P1 + rank; S.stride = nidle; S.count = rank >= 0 ? PP_Q2 : 0; }
    else { S.first = P12 + bid; S.stride = C.G; S.count = PP_UNITS; }
    pg8::EpiPP E{(bf16_t*)KPp->out + (size_t)M * D};
    pg8::gemm_phase(C.lds, (const bf16_t*)(ws + WS_PB) + (size_t)l * M * PLE, (const bf16_t*)(wl + WO_PP), PLE, S, E);
}

__device__ __forceinline__ void run_layer_phase(const Ctx& C, const int l_, const int sub) {
    KP KPp = (KP)__builtin_amdgcn_kernarg_segment_ptr(); asm volatile("" : "+s"(KPp));
    unsigned char* ws = KPp->ws;
    int bid = blockIdx.x; asm volatile("" : "+s"(bid));
    int l = l_; asm volatile("" : "+s"(l));
    unsigned char* wl = ws + WS_W + (size_t)l * W_LAYER;
    bf16_t* hb = (bf16_t*)(ws + WS_HB);
    if (sub == 0) {
        pg8::StaticOrder S; S.init(M, ZC, C.G, bid);
        pg8::EpiZ E{(bf16_t*)(ws + WS_Z), (const float*)(ws + WS_PART), NPART};
        pg8::gemm_phase(C.lds, l == 0 ? (const bf16_t*)hb : (const bf16_t*)KPp->out, (const bf16_t*)(wl + WO_IN), D, S, E);
    } else if (sub == 1) {
        phase_mix(KPp, C, ws, l, 0);
    } else if (sub == 8) {
        phase_mix(KPp, C, ws, l, 1);
    } else if (sub == 2) {
        pg8::StaticOrder S; S.init(M, D, C.G, bid);
        pg8::EpiRes E{l == 0 ? KPp->in[I_X] : (const float*)nullptr, (const bf16_t*)KPp->out, hb};
        pg8::gemm_phase(C.lds, (const bf16_t*)(ws + WS_Y), (const bf16_t*)(wl + WO_OUT), D, S, E);
    } else if (sub == 3) {
        phase_router(KPp, C, ws, l);
    } else if (sub == 4) {
        moe_prefix(KPp, C, ws, l);
        pg8::GroupedOrder<true> S{(const LAS int*)(C.lds + LDS_MISC), (const LAS int*)(C.lds + LDS_MISC + 256), (const int*)(ws + WS_CTL) + l * 64, (const int*)(ws + WS_TLIST), 1024, C.G, bid};
        pg8::EpiGU E{(bf16_t*)(ws + WS_HID), (const float*)(ws + WS_RLIST)};
        pg8::gemm_phase(C.lds, hb, (const bf16_t*)(wl + WO_GU), D, S, E);
        run_pp_tail(C, KPp, ws, wl, l, bid, 0);
    } else if (sub == 5) {
        moe_prefix(KPp, C, ws, l);
        pg8::GroupedOrder<false> S{(const LAS int*)(C.lds + LDS_MISC), (const LAS int*)(C.lds + LDS_MISC + 256), (const int*)(ws + WS_CTL) + l * 64, (const int*)(ws + WS_TLIST), 1024, C.G, bid};
        pg8::EpiDown E{(bf16_t*)(ws + WS_YS), (const float*)(ws + WS_GLIST), (const int*)(ws + WS_CTL) + l * 64};
        pg8::gemm_phase(C.lds, (const bf16_t*)(ws + WS_HID), (const bf16_t*)(wl + WO_D), FF, S, E);
        run_pp_tail(C, KPp, ws, wl, l, bid, 1);
    } else if (sub == 6) {
        moe_prefix(KPp, C, ws, l);
        phase_combine(KPp, C, ws, l);
        __syncthreads();
        run_pp_tail(C, KPp, ws, wl, l, bid, 2);
    } else {
        pg8::StaticOrder S; S.init(M, D, C.G, bid);
        pg8::EpiPle E{hb, l == DEPTH - 1 ? (bf16_t*)(ws + WS_Y) : (bf16_t*)KPp->out, (const bf16_t*)KPp->out + (size_t)M * D, (const float*)(ws + WS_RSP), (float*)(ws + WS_PART)};
        pg8::gemm_phase(C.lds, hb, (const bf16_t*)(wl + WO_PG), D, S, E);
    }
}

__global__ void __launch_bounds__(512, 2) mega(Params P) {
    extern __shared__ __attribute__((aligned(16))) unsigned char lds_raw[];
    Ctx C; C.lds = (LAS unsigned char*)lds_raw; C.tid = threadIdx.x; C.lane = C.tid & 63; C.wave = __builtin_amdgcn_readfirstlane(C.tid >> 6);
    C.G = gridDim.x; C.vcu = 0; C.bid = 0;
    cg::grid_group grid = cg::this_grid();
    const int lo = P.ph_lo, hi = P.ph_hi & 0xffff; const bool fin = (P.ph_hi >> 16) != 0;
    if (threadIdx.x < 2) ((LAS unsigned*)(lds_raw + LDS_XB))[threadIdx.x] = 0u;
    __syncthreads();
    const XcdBarrier xbar = xcd_barrier_post((unsigned*)(P.ws + WS_CTL) + CW_BAR, (volatile LAS unsigned*)((LAS unsigned char*)lds_raw + LDS_XB));
    if (lo < 0) grid.sync();
#define GSYNC() do { asm volatile("s_waitcnt vmcnt(0) lgkmcnt(0)" ::: "memory"); xcd_barrier(xbar); } while (0)
#ifdef TIMING
#define STAMP(k) do { if (blockIdx.x == 0 && threadIdx.x == 0) ((unsigned*)(P.ws + WS_CTL))[1024 + (k)] = (unsigned)__builtin_amdgcn_s_memrealtime(); } while (0)
#else
#define STAMP(k) do {} while (0)
#endif
#define PHASE(k, body) do { if (lo <= (k) && (k) < hi) { if ((k) > lo) GSYNC(); STAMP(k); body; } } while (0)
    PHASE(0, { KP KPp = (KP)__builtin_amdgcn_kernarg_segment_ptr(); asm volatile("" : "+s"(KPp)); phase_prep(KPp, C, KPp->ws, 1); phase_prep(KPp, C, KPp->ws, 0); phase_prep(KPp, C, KPp->ws, 2); });
#define LAYER_PHASE(l, sub) PHASE(N_PREP + 8 * (l) + (sub), run_layer_phase(C, l, sub))
#define MIX_PHASE(l) PHASE(N_PREP + 8 * (l) + 1, { run_layer_phase(C, l, 1); GSYNC(); run_layer_phase(C, l, 8); })
    LAYER_PHASE(0, 0); MIX_PHASE(0); LAYER_PHASE(0, 2); LAYER_PHASE(0, 3); LAYER_PHASE(0, 4); LAYER_PHASE(0, 5); LAYER_PHASE(0, 6); LAYER_PHASE(0, 7);
    LAYER_PHASE(1, 0); MIX_PHASE(1); LAYER_PHASE(1, 2); LAYER_PHASE(1, 3); LAYER_PHASE(1, 4); LAYER_PHASE(1, 5); LAYER_PHASE(1, 6); LAYER_PHASE(1, 7);
#ifdef DBG_MODE
    { GSYNC(); KP KPp = (KP)__builtin_amdgcn_kernarg_segment_ptr(); asm volatile("" : "+s"(KPp)); phase_dbg(KPp, C, KPp->ws, DBG_MODE); }
#endif
    if (fin || (lo <= N_PHASES - 1 && N_PHASES - 1 < hi)) { if (N_PHASES - 1 > lo) GSYNC(); STAMP(N_PHASES - 1); { KP KPp = (KP)__builtin_amdgcn_kernarg_segment_ptr(); asm volatile("" : "+s"(KPp)); phase_final(KPp, C, KPp->ws); } }
}

extern "C" void kernel_launch(void* const* d_in, const int* in_sizes, int n_in, void* d_out, int out_size, void* d_ws, size_t ws_size, hipStream_t stream) {
    static int grid = 0;
    if (grid == 0) {
        if (n_in != 35 || out_size != M * D || ws_size < WS_END) { fprintf(stderr, "kernel_launch: unexpected shapes (n_in %d out %d ws %zu)\n", n_in, out_size, ws_size); grid = -1; return; }
        int dev = 0, cus = 0, per_cu = 0;
        hipGetDevice(&dev); hipDeviceGetAttribute(&cus, hipDeviceAttributeMultiprocessorCount, dev);
        hipFuncSetAttribute((const void*)mega, hipFuncAttributeMaxDynamicSharedMemorySize, LDS_BYTES);
        hipOccupancyMaxActiveBlocksPerMultiprocessor(&per_cu, (const void*)mega, 512, LDS_BYTES);
        (void)hipGetLastError();
        if (per_cu < 1 || cus != 256) { fprintf(stderr, "kernel_launch: occupancy %d per CU, %d CUs: unsupported\n", per_cu, cus); grid = -1; return; }
        grid = 256;
    }
    if (grid < 0) return;
    hipMemsetAsync((char*)d_ws + WS_CTL, 0, CTL_BYTES, stream);
    Params p{};
    for (int i = 0; i < 35; ++i) p.in[i] = (const float*)d_in[i];
    p.out = (float*)d_out; p.ws = (unsigned char*)d_ws;
#if MK_N_LAUNCHES == 1
    p.ph_lo = 0; p.ph_hi = (N_PHASES < PH_STOP ? N_PHASES : (PH_STOP | (DBG_FIN << 16)));
    { void* args[] = {&p}; hipLaunchCooperativeKernel((const void*)mega, dim3(grid), dim3(512), args, LDS_BYTES, stream); }
#else
    for (int ph = 0; ph < N_PHASES; ++ph) { p.ph_lo = ph; p.ph_hi = ph + 1; void* args[] = {&p}; hipLaunchCooperativeKernel((const void*)mega, dim3(grid), dim3(512), args, LDS_BYTES, stream); }
#endif
}
```
